# Optimizing an MI355X kernel written in HIP

```python
import math
import jax, jax.numpy as jnp
from jax import lax
import numpy as np

D_MODEL = 1024
BATCH = 16
SEQ = 2048
DEPTH = 2

CHUNK = 64
Q_BLOCK = 128
D_MIX = D_MODEL
SB_HEADS = 8
SB_HEAD_DIM = 64
DSA_HEADS = 8
DSA_HEAD_DIM = 64
DSA_KV_RANK = 128
IDX_HEADS = 8
IDX_DIM = 64
DSA_MAX_TOPK = 256
D_FF = 4 * D_MODEL
N_BUCKETS = 32
MAX_DISTANCE = 128
EPS = 1e-6

SB_QKV = 3 * SB_HEADS * SB_HEAD_DIM
DSA_Q = DSA_HEADS * DSA_KV_RANK
DSA_KV = DSA_KV_RANK
IDX_Q = IDX_HEADS * IDX_DIM
IDX_K = IDX_DIM
IDX_W = IDX_HEADS
D_IN_PROJ = SB_QKV + DSA_Q + DSA_KV + IDX_Q + IDX_K + IDX_W
SPLITS = [SB_QKV, SB_QKV + DSA_Q, SB_QKV + DSA_Q + DSA_KV,
          SB_QKV + DSA_Q + DSA_KV + IDX_Q, SB_QKV + DSA_Q + DSA_KV + IDX_Q + IDX_K]

kernel_name = "hybrid_stickbreak_dsa_adaln_trunk"


def rmsnorm(x, g):
    xf = x.astype(jnp.float32)
    y = xf * lax.rsqrt(jnp.mean(xf * xf, axis=-1, keepdims=True) + EPS)
    return (y * g.astype(jnp.float32)).astype(x.dtype)


def t5_bucket(rel):
    nb = N_BUCKETS // 2
    max_exact = nb // 2
    base = jnp.where(rel > 0, nb, 0)
    n = jnp.abs(rel)
    nf = jnp.maximum(n, max_exact).astype(jnp.float32)
    large = max_exact + (jnp.log(nf / max_exact) / math.log(MAX_DISTANCE / max_exact)
                         * (nb - max_exact)).astype(jnp.int32)
    large = jnp.minimum(large, nb - 1)
    return base + jnp.where(n < max_exact, n, large)


def stick_breaking_attention(q, k, v):
    B, S, H, Dh = q.shape
    nb = S // Q_BLOCK
    qb = q.reshape(B, nb, Q_BLOCK, H, Dh).transpose(1, 0, 2, 3, 4)
    kpos = jnp.arange(S)
    scale = Dh ** -0.5

    def block(args):
        qi, i = args
        qpos = i * Q_BLOCK + jnp.arange(Q_BLOCK)
        z = jnp.einsum('bqhd,bshd->bhqs', qi, k).astype(jnp.float32) * scale
        causal = (kpos[None, :] < qpos[:, None])[None, None]
        log_beta = jax.nn.log_sigmoid(z)
        log_1m = jnp.where(causal, log_beta - z, 0.0)
        after = lax.cumsum(log_1m, axis=3, reverse=True) - log_1m
        w = jnp.where(causal, jnp.exp(log_beta + after), 0.0)
        return jnp.einsum('bhqs,bshd->bqhd', w.astype(v.dtype), v)

    out = lax.map(block, (qb, jnp.arange(nb)))
    return out.transpose(1, 0, 2, 3, 4).reshape(B, S, H, Dh)


def dsa_attention(q, kv, q_idx, k_idx, w_idx, w_uv, rel_bias):
    B, S, H, R = q.shape
    topk = min(DSA_MAX_TOPK, S // 4)
    nb = S // Q_BLOCK
    kchunk = jnp.arange(S) // CHUNK
    qb = q.reshape(B, nb, Q_BLOCK, H, R).transpose(1, 0, 2, 3, 4)
    qib = q_idx.reshape(B, nb, Q_BLOCK, IDX_HEADS, IDX_DIM).transpose(1, 0, 2, 3, 4)
    wib = w_idx.reshape(B, nb, Q_BLOCK, IDX_HEADS).transpose(1, 0, 2, 3)
    bias_tab = rel_bias.astype(jnp.float32)

    def block(args):
        qi, qii, wi, i = args
        qpos = i * Q_BLOCK + jnp.arange(Q_BLOCK)
        qchunk = qpos // CHUNK
        admissible = kchunk[None, :] <= qchunk[:, None]
        sc = jnp.einsum('bqjd,bsd->bqjs', qii, k_idx).astype(jnp.float32) * (IDX_DIM ** -0.5)
        score = jnp.einsum('bqjs,bqj->bqs', jax.nn.relu(sc),
                           wi.astype(jnp.float32) * (IDX_HEADS ** -0.5))
        score = jnp.where(admissible[None], score, -jnp.inf)
        _, idx = lax.top_k(score, topk)
        kv_sel = jax.vmap(lambda a, ix: a[ix])(kv, idx)
        valid = (idx // CHUNK) <= qchunk[None, :, None]
        bias = bias_tab[t5_bucket(idx - qpos[None, :, None])]
        logits = (jnp.einsum('bqhr,bqkr->bqhk', qi, kv_sel).astype(jnp.float32) * (R ** -0.5)
                  + bias.transpose(0, 1, 3, 2))
        logits = jnp.where(valid[:, :, None, :], logits, -jnp.inf)
        p = jax.nn.softmax(logits, axis=-1)
        o = jnp.einsum('bqhk,bqkr->bqhr', p.astype(kv.dtype), kv_sel)
        return jnp.einsum('bqhr,hrd->bqhd', o, w_uv)

    out = lax.map(block, (qb, qib, wib, jnp.arange(nb)))
    return out.transpose(1, 0, 2, 3, 4).reshape(B, S, H, DSA_HEAD_DIM)


def setup_inputs(seed: int = 0) -> dict:
    key = jax.random.key(seed)
    ks = jax.random.split(key, 20)
    f32 = jnp.float32

    def nrm(k, shape, scale):
        return jax.random.normal(k, shape, f32) * scale

    def gain(k, shape):
        return 1.0 + 0.02 * jax.random.normal(k, shape, f32)

    return {
        "x": nrm(ks[0], (BATCH, SEQ, D_MODEL), 1.0),
        "c": nrm(ks[1], (BATCH, D_MODEL), 1.0),
        "w_mod": nrm(ks[2], (DEPTH, D_MODEL, 6 * D_MODEL), 0.5 * D_MODEL ** -0.5),
        "b_mod": nrm(ks[3], (DEPTH, 6 * D_MODEL), 0.02),
        "g_attn": gain(ks[4], (DEPTH, D_MODEL)),
        "w_in": nrm(ks[5], (DEPTH, D_MODEL, D_IN_PROJ), D_MODEL ** -0.5),
        "kv_norm_g": gain(ks[6], (DEPTH, DSA_KV_RANK)),
        "w_uv": nrm(ks[7], (DEPTH, DSA_HEADS, DSA_KV_RANK, DSA_HEAD_DIM), DSA_KV_RANK ** -0.5),
        "g_out_a": gain(ks[8], (DEPTH, SB_HEADS * SB_HEAD_DIM)),
        "g_out_b": gain(ks[9], (DEPTH, DSA_HEADS * DSA_HEAD_DIM)),
        "w_out": nrm(ks[10], (DEPTH, D_MIX, D_MODEL), D_MIX ** -0.5),
        "g_mlp": gain(ks[11], (DEPTH, D_MODEL)),
        "w_up": nrm(ks[12], (DEPTH, D_MODEL, D_FF), D_MODEL ** -0.5),
        "w_down": nrm(ks[13], (DEPTH, D_FF, D_MODEL), D_FF ** -0.5),
        "rel_bias": nrm(ks[14], (N_BUCKETS, DSA_HEADS), 0.2),
        "g_final": gain(ks[15], (D_MODEL,)),
    }


def reference(x, c, w_mod, b_mod, g_attn, w_in, kv_norm_g, w_uv, g_out_a, g_out_b,
              w_out, g_mlp, w_up, w_down, rel_bias, g_final):
    B, S, D = x.shape
    c_act = jax.nn.silu(c)
    for l in range(DEPTH):
        mod = c_act @ w_mod[l] + b_mod[l]
        sh1, sc1, ga1, sh2, sc2, ga2 = [m[:, None, :] for m in jnp.split(mod, 6, axis=-1)]

        h = rmsnorm(x, g_attn[l]) * (1.0 + sc1) + sh1
        proj = h @ w_in[l]
        sb_qkv, dsa_q, dsa_kv, idx_q, idx_k, idx_w = jnp.split(proj, SPLITS, axis=-1)
        q_a, k_a, v_a = [t.reshape(B, S, SB_HEADS, SB_HEAD_DIM)
                         for t in jnp.split(sb_qkv, 3, axis=-1)]
        o_a = stick_breaking_attention(q_a, k_a, v_a).reshape(B, S, SB_HEADS * SB_HEAD_DIM)

        kv_lat = rmsnorm(dsa_kv, kv_norm_g[l])
        o_b = dsa_attention(dsa_q.reshape(B, S, DSA_HEADS, DSA_KV_RANK), kv_lat,
                            idx_q.reshape(B, S, IDX_HEADS, IDX_DIM), idx_k, idx_w,
                            w_uv[l], rel_bias).reshape(B, S, DSA_HEADS * DSA_HEAD_DIM)

        o = jnp.concatenate([rmsnorm(o_a, g_out_a[l]), rmsnorm(o_b, g_out_b[l])], axis=-1)
        x = x + ga1 * (o @ w_out[l])

        h = rmsnorm(x, g_mlp[l]) * (1.0 + sc2) + sh2
        x = x + ga2 * (jnp.square(jax.nn.relu(h @ w_up[l])) @ w_down[l])
    return rmsnorm(x, g_final)
```

```cpp
#include <hip/hip_runtime.h>
#include <cstdio>
#include <cstdint>

#define LAS __attribute__((address_space(3)))
typedef _Float16 f16;
typedef _Float16 f16x8 __attribute__((ext_vector_type(8)));
typedef _Float16 f16x4 __attribute__((ext_vector_type(4)));
typedef float f32x2 __attribute__((ext_vector_type(2)));
typedef float f32x4 __attribute__((ext_vector_type(4)));
typedef float f32x16 __attribute__((ext_vector_type(16)));
typedef unsigned u32x2 __attribute__((ext_vector_type(2)));
typedef unsigned u32x4 __attribute__((ext_vector_type(4)));

#ifndef N_LAUNCH_MODE
#define N_LAUNCH_MODE 0
#endif
#ifndef ENABLE_SB
#define ENABLE_SB 1
#endif
#ifndef ENABLE_DSA
#define ENABLE_DSA 1
#endif

constexpr int NB = 16, SEQ = 2048, DM = 1024, MT = NB * SEQ, NPJ = 3328, NPJ_VALID = 3272, FF = 4096, NLAYER = 2;
constexpr int C_SBQ = 0, C_SBK = 512, C_SBV = 1024, C_DQ = 1536, C_DKV = 2560, C_IQ = 2688, C_IK = 3200, C_IW = 3264;
constexpr int NWAVES = 8, NTHR = 512;
constexpr float EPS = 1e-6f;
constexpr float LOG2E = 1.4426950408889634f;

constexpr size_t al256(size_t x) { return (x + 255) & ~(size_t)255; }
constexpr size_t WS_CTL = 0;
constexpr size_t CTL_BYTES = 65536;
constexpr size_t WS_MOD = WS_CTL + CTL_BYTES;
constexpr size_t WS_BIAS = WS_MOD + al256((size_t)2 * 16 * 6144 * 4);
constexpr size_t WS_WIN = WS_BIAS + al256((size_t)8 * 2112 * 4);
constexpr size_t WS_WOUT = WS_WIN + (size_t)2 * NPJ * DM * 2;
constexpr size_t WS_WUP = WS_WOUT + (size_t)2 * DM * DM * 2;
constexpr size_t WS_WDN = WS_WUP + (size_t)2 * FF * DM * 2;
constexpr size_t WS_WUV = WS_WDN + (size_t)2 * FF * DM * 2;
constexpr size_t WS_H = WS_WUV + (size_t)2 * 8 * 64 * 128 * 2;
constexpr size_t WS_KV = WS_H + (size_t)MT * DM * 2;
constexpr size_t WS_KVT = WS_KV + (size_t)MT * 128 * 2;
constexpr size_t WS_MASK = WS_KVT + (size_t)MT * 128 * 2;
constexpr size_t WS_PROJ = WS_MASK + (size_t)MT * 64 * 4;
constexpr size_t WS_OBUF = WS_PROJ + (size_t)MT * NPJ * 2;
constexpr size_t WS_HID = WS_PROJ;
constexpr size_t WS_END = WS_OBUF + (size_t)MT * DM * 2;
static_assert((size_t)MT * FF * 2 <= WS_END - WS_PROJ, "HID overlay must fit");

constexpr int LDS_BYTES = 147456;
constexpr int LDS_MISC = 135168;

__device__ __forceinline__ float wave_sum(float v) {
    v += __shfl_xor(v, 32); v += __shfl_xor(v, 16); v += __shfl_xor(v, 8); v += __shfl_xor(v, 4); v += __shfl_xor(v, 2); v += __shfl_xor(v, 1); return v;
}
__device__ __forceinline__ float half_sum(float v) {
    v += __shfl_xor(v, 16); v += __shfl_xor(v, 8); v += __shfl_xor(v, 4); v += __shfl_xor(v, 2); v += __shfl_xor(v, 1); return v;
}

__device__ __forceinline__ int ltid() { int t = threadIdx.x; asm volatile("" : "+v"(t)); return t; }
#define XB_TMO      128
#define XB_XCNT(j)  (256  + 64 * (j))
#define XB_XSUB(j)  (1280 + 64 * (j))
#define XB_XGEN(j)  (2304 + 64 * (j))
#define XB_TOP      3328
#define XB_TOPGEN   3392
#define XCD_BAR_WORDS 3456
#define XB_SPIN_CAP (1u << 18)

__device__ __forceinline__ unsigned xb_ld(unsigned* p)              { return __hip_atomic_load(p, __ATOMIC_RELAXED, __HIP_MEMORY_SCOPE_AGENT); }
__device__ __forceinline__ unsigned xb_add(unsigned* p, unsigned v) { return __hip_atomic_fetch_add(p, v, __ATOMIC_RELAXED, __HIP_MEMORY_SCOPE_AGENT); }
__device__ __forceinline__ unsigned xb_xcc_id() { return (unsigned)__builtin_amdgcn_s_getreg((3 << 11) | 20) & 0xFu; }
#define XB_SPIN(cond, bar) do { unsigned _sp = 0; while (cond) { __builtin_amdgcn_s_sleep(1); \
    if ((++_sp & 255u) == 0u) { if (xb_ld(&(bar)[XB_TMO])) break; if (_sp > XB_SPIN_CAP) { atomicAdd(&(bar)[XB_TMO], 1u); break; } } } } while (0)

struct XcdBarrier {
    unsigned* bar; unsigned x;
    volatile LAS unsigned* st;
};

__device__ __forceinline__ XcdBarrier xcd_barrier_post(unsigned* bar, volatile LAS unsigned* st) {
    XcdBarrier b; b.bar = bar; b.x = xb_xcc_id(); b.st = st;
    if (threadIdx.x == 0) (void)xb_add(&bar[XB_XCNT(b.x)], 1u);
    return b;
}
__device__ __forceinline__ void xcd_barrier_complete(unsigned* bar, unsigned x, unsigned& nloc, unsigned& nx) {
    const unsigned G = gridDim.x * gridDim.y * gridDim.z;
    unsigned sum, cnt, mine, sp = 0u;
    for (;;) {
        sum = 0u; cnt = 0u; mine = 0u;
#pragma unroll
        for (unsigned j = 0; j < 16; ++j) { const unsigned c = xb_ld(&bar[XB_XCNT(j)]); sum += c; cnt += (c > 0u) ? 1u : 0u; mine = (j == x) ? c : mine; }
        if (sum == G) break;
        __builtin_amdgcn_s_sleep(1);
        if ((++sp & 255u) == 0u) { if (xb_ld(&bar[XB_TMO])) break; if (sp > XB_SPIN_CAP) { atomicAdd(&bar[XB_TMO], 1u); break; } }
    }
    nloc = mine > 0u ? mine : 1u; nx = cnt > 0u ? cnt : 1u;
}

__device__ __forceinline__ void xcd_barrier(const XcdBarrier& b) {
    asm volatile("s_waitcnt vmcnt(0)" ::: "memory");
    __syncthreads();
    if (threadIdx.x == 0) {
        unsigned* bar = b.bar;
        __builtin_amdgcn_s_waitcnt(0);
        unsigned nloc = b.st[0], nx = b.st[1];
        if (nloc == 0u) { xcd_barrier_complete(bar, b.x, nloc, nx); b.st[0] = nloc; b.st[1] = nx; }
        const unsigned old = xb_add(&bar[XB_XSUB(b.x)], 1u);
        const unsigned gen = old / nloc;
        if (old + 1u == (gen + 1u) * nloc) {
            __builtin_amdgcn_fence(__ATOMIC_RELEASE, "agent");
            asm volatile("s_waitcnt vmcnt(0)" ::: "memory");
            const unsigned og = xb_add(&bar[XB_TOP], 1u);
            const unsigned tg = og / nx;
            if (og + 1u == (tg + 1u) * nx) xb_add(&bar[XB_TOPGEN], 1u);
            else XB_SPIN(xb_ld(&bar[XB_TOPGEN]) == tg, bar);
            __builtin_amdgcn_fence(__ATOMIC_ACQUIRE, "agent");
            xb_add(&bar[XB_XGEN(b.x)], 1u);
            asm volatile("s_waitcnt vmcnt(0)" ::: "memory");
        } else {
            XB_SPIN(xb_ld(&bar[XB_XGEN(b.x)]) == gen, bar);
            __builtin_amdgcn_fence(__ATOMIC_ACQUIRE, "agent");
            asm volatile("s_waitcnt vmcnt(0)" ::: "memory");
        }
    }
    __syncthreads();
}

namespace pg8 {
constexpr int BM = 256, BK = 64, HALF = 128, HTB = HALF * BK * 2  , STAGE_BYTES = 8 * HTB, NXCD = 8, WGM = 8;

__host__ __device__ __forceinline__ int lds_byte(int r, int c) { const int st = (r >> 4) * 2 + (c >> 5), rr = r & 15, cc = c & 31, ob = rr * 64 + cc * 2; return st * 1024 + (ob ^ (((ob >> 9) & 1) << 5)); }
__host__ __device__ __forceinline__ void stage_rc(int b, int& R, int& C) { const int st = b / 1024, sb = b % 1024, swz = sb ^ (((sb >> 9) & 1) << 5); R = (st >> 1) * 16 + swz / 64; C = (st & 1) * 32 + (swz % 64) / 2; }
__host__ __device__ __forceinline__ int perm32(int rho) { const int n = rho >> 4, i = rho & 15; return 8 * (i >> 2) + 4 * n + (i & 3); }

struct Unit { int pm, pn; };
struct Gemm { const f16* A; const f16* Bt; int M, N, K; };

struct StaticOrder {
    int nM, nN, nwg, G, c;
    __host__ __device__ void init(int M, int N, int G_, int c_) { nM = M / BM; nN = N / BM; nwg = nM * nN; G = G_; c = c_; }
    __host__ __device__ bool next(int i, Unit& u) const {
        const long L = (long)i * G + c; if (L >= nwg) return false;
        int wgid = (int)L; { const int q = nwg / NXCD, r = nwg % NXCD, xcd = wgid % NXCD, off = wgid / NXCD; wgid = (xcd < r ? xcd * (q + 1) : r * (q + 1) + (xcd - r) * q) + off; }
        const int nig = WGM * nN, gid = wgid / nig, fm = gid * WGM, gsz = (nM - fm) < WGM ? (nM - fm) : WGM;
        u.pm = fm + ((wgid % nig) % gsz); u.pn = (wgid % nig) / gsz; return true;
    }
    __device__ __forceinline__ void a_ready(const Unit&) const {}
    __device__ __forceinline__ void done(const Unit&) const {}
};

template <int ACT  > struct EpiF16 {
    static constexpr bool PERM = true, AFTER_DRAIN = false;
    f16* O; int ldc;
    __device__ __forceinline__ void operator()(const f32x4 (&acc)[2][2][4][2], const Unit& u, int wr, int wc, int fr, int fq) const {
        const int row0 = u.pm * BM + wr * 64 + fr; const int col0 = u.pn * BM + wc * 32 + 8 * fq;
#pragma unroll
        for (int ai = 0; ai < 2; ++ai)
#pragma unroll
            for (int m = 0; m < 4; ++m) { f16* rowp = O + (size_t)(row0 + ai * HALF + m * 16) * ldc + col0;
#pragma unroll
                for (int bj = 0; bj < 2; ++bj) { f32x4 v0 = acc[ai][bj][m][0], v1 = acc[ai][bj][m][1];
                    if (ACT == 1) {
#pragma unroll
                        for (int e = 0; e < 4; ++e) { const float a = fmaxf(v0[e], 0.f), b = fmaxf(v1[e], 0.f); v0[e] = a * a; v1[e] = b * b; } }
                    f16x8 w; w[0] = (f16)v0[0]; w[1] = (f16)v0[1]; w[2] = (f16)v0[2]; w[3] = (f16)v0[3]; w[4] = (f16)v1[0]; w[5] = (f16)v1[1]; w[6] = (f16)v1[2]; w[7] = (f16)v1[3];
                    *(f16x8*)(rowp + bj * HALF) = w; } }
    }
};
struct EpiResid {
    static constexpr bool PERM = false, AFTER_DRAIN = false;
    const float* base; float* out; const float* gate;
    __device__ __forceinline__ void operator()(const f32x4 (&acc)[2][2][4][2], const Unit& u, int wr, int wc, int fr, int fq) const {
        const int row0 = u.pm * BM + wr * 64 + fr; const int col0 = u.pn * BM + wc * 32 + 4 * fq;
        const float* gp = gate + (size_t)((u.pm * BM) >> 11) * 6144 + col0;
        f32x4 gv[2][2];
#pragma unroll
        for (int bj = 0; bj < 2; ++bj)
#pragma unroll
            for (int n = 0; n < 2; ++n) gv[bj][n] = *(const f32x4*)(gp + bj * HALF + 16 * n);
#pragma unroll
        for (int ai = 0; ai < 2; ++ai)
#pragma unroll
            for (int m = 0; m < 4; ++m) { const size_t ro = (size_t)(row0 + ai * HALF + m * 16) * DM + col0;
#pragma unroll
                for (int bj = 0; bj < 2; ++bj)
#pragma unroll
                    for (int n = 0; n < 2; ++n) { const f32x4 x = *(const f32x4*)(base + ro + bj * HALF + 16 * n);
                        *(f32x4*)(out + ro + bj * HALF + 16 * n) = x + gv[bj][n] * acc[ai][bj][m][n]; } }
    }
};

template <class Epi, class Sched>
__device__ __forceinline__ void gemm_phase(LAS unsigned char* lds, const Gemm g, const Sched& S, const Epi& E) {
    const int tid = ltid(), wid = __builtin_amdgcn_readfirstlane(tid >> 6), lane = tid & 63, wr = wid >> 2, wc = wid & 3, fr = lane & 15, fq = lane >> 4;
    const int K = g.K, nt = K / BK;
    unsigned voffA[2], voffB[2];
#pragma unroll
    for (int i = 0; i < 2; ++i) { int R, C; stage_rc(tid * 16 + i * 8192, R, C); const int Rb = Epi::PERM ? ((R & ~31) + perm32(R & 31)) : R;
        voffA[i] = (unsigned)(R * K + C) * 2u; voffB[i] = (unsigned)(Rb * K + C) * 2u; }
    const size_t kstep = (size_t)(BK * 2);
    const size_t hstep = (size_t)HALF * K * 2;
    const size_t tstep = 2 * hstep;
    const unsigned ldsw = (unsigned)wid * 1024u;
    const int aoff = lds_byte(wr * 64 + fr, fq * 8), boff = lds_byte(wc * 32 + fr, fq * 8);
#define PG8_SA(b, h) (((b) * 2 + (h)) * HTB)
#define PG8_SB(b, h) ((4 + (b) * 2 + (h)) * HTB)
#define PG8_STAGE(bufoff, gbase, voff) do { _Pragma("unroll") for (int _i = 0; _i < 2; ++_i) \
        __builtin_amdgcn_global_load_lds((const unsigned*)((const char*)(gbase) + (voff)[_i]), (LAS unsigned*)(lds + (bufoff) + ldsw + _i * 8192), 16, 0, 0); } while (0)
#define PG8_LDA(dst, b, h) do { _Pragma("unroll") for (int m = 0; m < 4; ++m) _Pragma("unroll") for (int k = 0; k < 2; ++k) dst[m][k] = *(const LAS f16x8*)(lds + PG8_SA(b, h) + aoff + m * 2048 + k * 1024); } while (0)
#define PG8_LDB(dst, b, h) do { _Pragma("unroll") for (int n = 0; n < 2; ++n) _Pragma("unroll") for (int k = 0; k < 2; ++k) dst[n][k] = *(const LAS f16x8*)(lds + PG8_SB(b, h) + boff + n * 2048 + k * 1024); } while (0)
#define PG8_MMA(ai, bj, At, Bt) do { __builtin_amdgcn_s_setprio(1); _Pragma("unroll") for (int m = 0; m < 4; ++m) _Pragma("unroll") for (int n = 0; n < 2; ++n) _Pragma("unroll") for (int k = 0; k < 2; ++k) \
        acc[ai][bj][m][n] = __builtin_amdgcn_mfma_f32_16x16x32_f16(Bt[n][k], At[m][k], acc[ai][bj][m][n], 0, 0, 0); __builtin_amdgcn_s_setprio(0); } while (0)
#define PG8_WAIT_V(n) asm volatile("s_waitcnt vmcnt(" #n ")" ::: "memory")
#define PG8_WAIT_L(n) asm volatile("s_waitcnt lgkmcnt(" #n ")" ::: "memory")
#define PG8_BAR __builtin_amdgcn_s_barrier()
#define PG8_SCHED __builtin_amdgcn_sched_barrier(0)
    Unit cur, nxt; int ui = 0;
    if (!S.next(0, cur)) return;
    f32x4 acc[2][2][4][2];
#pragma unroll
    for (int a = 0; a < 2; ++a)
#pragma unroll
        for (int b = 0; b < 2; ++b)
#pragma unroll
            for (int m = 0; m < 4; ++m)
#pragma unroll
                for (int n = 0; n < 2; ++n) acc[a][b][m][n] = (f32x4){0.f, 0.f, 0.f, 0.f};
    f16x8 At[4][2], B0[2][2], B1[2][2];
    const char* cA = (const char*)g.A + (size_t)cur.pm * tstep; const char* cB = (const char*)g.Bt + (size_t)cur.pn * tstep;
    S.a_ready(cur);
    PG8_STAGE(PG8_SB(0, 0), cB, voffB); PG8_STAGE(PG8_SB(0, 1), cB + hstep, voffB); PG8_STAGE(PG8_SA(0, 0), cA, voffA); PG8_STAGE(PG8_SA(0, 1), cA + hstep, voffA);
    if (wr == 1) PG8_BAR;
    PG8_WAIT_V(2); PG8_BAR;
    PG8_STAGE(PG8_SB(1, 0), cB + kstep, voffB); PG8_STAGE(PG8_SA(1, 0), cA + kstep, voffA); PG8_STAGE(PG8_SB(1, 1), cB + hstep + kstep, voffB);
    PG8_WAIT_V(6); PG8_BAR;
    for (;;) {
        const bool has_next = S.next(ui + 1, nxt);
        const char* nA = has_next ? (const char*)g.A + (size_t)nxt.pm * tstep : cA; const char* nB = has_next ? (const char*)g.Bt + (size_t)nxt.pn * tstep : cB;
        for (int t = 0; t < nt; t += 2) {
            const bool last = (t == nt - 2);
            const char* a1 = cA + (size_t)(t + 1) * kstep;
            const char* a2 = last ? nA : cA + (size_t)(t + 2) * kstep; const char* b2 = last ? nB : cB + (size_t)(t + 2) * kstep;
            const char* a3 = a2 + kstep; const char* b3 = b2 + kstep;
            if (last && has_next) S.a_ready(nxt);
            PG8_LDB(B0, 0, 0); PG8_LDB(B1, 0, 1); PG8_SCHED; PG8_LDA(At, 0, 0); PG8_STAGE(PG8_SA(1, 1), a1 + hstep, voffA);
            PG8_WAIT_V(8); PG8_WAIT_L(0); PG8_BAR; PG8_MMA(0, 0, At, B0); PG8_MMA(0, 1, At, B1); PG8_BAR; PG8_SCHED;
            PG8_LDA(At, 0, 1); PG8_STAGE(PG8_SB(0, 0), b2, voffB); PG8_STAGE(PG8_SB(0, 1), b2 + hstep, voffB); PG8_STAGE(PG8_SA(0, 0), a2, voffA);
            PG8_WAIT_V(8); PG8_WAIT_L(0); PG8_BAR; PG8_MMA(1, 0, At, B0); PG8_MMA(1, 1, At, B1); PG8_BAR; PG8_SCHED;
            PG8_LDB(B0, 1, 0); PG8_LDB(B1, 1, 1); PG8_SCHED; PG8_LDA(At, 1, 0); PG8_STAGE(PG8_SA(0, 1), a2 + hstep, voffA);
            PG8_WAIT_V(8); PG8_WAIT_L(0); PG8_BAR; PG8_MMA(0, 0, At, B0); PG8_MMA(0, 1, At, B1); PG8_BAR; PG8_SCHED;
            PG8_LDA(At, 1, 1); PG8_STAGE(PG8_SB(1, 0), b3, voffB); PG8_STAGE(PG8_SB(1, 1), b3 + hstep, voffB); PG8_STAGE(PG8_SA(1, 0), a3, voffA);
            PG8_WAIT_V(8); PG8_WAIT_L(0); PG8_BAR; PG8_MMA(1, 0, At, B0); PG8_MMA(1, 1, At, B1); PG8_BAR; PG8_SCHED;
        }
        if (wr == 0) PG8_BAR;
        E(acc, cur, wr, wc, fr, fq); S.done(cur);
        if (!has_next) break;
#pragma unroll
        for (int a = 0; a < 2; ++a)
#pragma unroll
            for (int b = 0; b < 2; ++b)
#pragma unroll
                for (int m = 0; m < 4; ++m)
#pragma unroll
                    for (int n = 0; n < 2; ++n) acc[a][b][m][n] = (f32x4){0.f, 0.f, 0.f, 0.f};
        cur = nxt; cA = nA; cB = nB; ++ui;
        if (wr == 1) PG8_BAR;
    }
    PG8_WAIT_V(0);
    PG8_BAR;
#undef PG8_SA
#undef PG8_SB
#undef PG8_STAGE
#undef PG8_LDA
#undef PG8_LDB
#undef PG8_MMA
#undef PG8_WAIT_V
#undef PG8_WAIT_L
#undef PG8_BAR
#undef PG8_SCHED
}
}
struct Ptrs {
    const float *x, *c, *w_mod, *b_mod, *g_attn, *w_in, *kv_norm_g, *w_uv, *g_out_a, *g_out_b, *w_out, *g_mlp, *w_up, *w_down, *rel_bias, *g_final;
    float* out; unsigned char* ws;
};

__device__ __forceinline__ void conv_tile(float* T  , const float* src, int N, int K, int Nvalid, const float* ks0, const float* ks1, f16* dst, int tn, int tk) {
    const int tid = ltid();
#pragma unroll
    for (int i = 0; i < 8; ++i) {
        const int kk = (tid >> 6) + 8 * i, k = tk * 64 + kk, n = tn * 64 + (tid & 63);
        float v = (n < Nvalid) ? src[(size_t)k * N + n] : 0.f;
        if (ks0) v *= (k < 512 ? ks0[k] : ks1[k - 512]);
        T[kk * 65 + (tid & 63)] = v;
    }
    __syncthreads();
    { const int nn = tid >> 3, kc = (tid & 7) * 8; f16x8 o;
#pragma unroll
      for (int e = 0; e < 8; ++e) o[e] = (f16)T[(kc + e) * 65 + nn];
      *(f16x8*)(dst + (size_t)(tn * 64 + nn) * K + tk * 64 + kc) = o; }
    __syncthreads();
}

__device__ __forceinline__ int t5_bucket_dev(int rel) {
    const int n = rel < 0 ? -rel : rel; int bk;
    if (n < 8) bk = n; else if (n < 12) bk = 8; else if (n < 16) bk = 9; else if (n < 23) bk = 10; else if (n < 32) bk = 11; else if (n < 46) bk = 12; else if (n < 64) bk = 13; else if (n < 91) bk = 14; else bk = 15;
    return (rel > 0 ? 16 : 0) + bk;
}

__device__ __forceinline__ void prologue_phase(unsigned char* lds, const Ptrs& P, int G, int wg) {
    const int tid = ltid(), lane = tid & 63, wv = tid >> 6;
    unsigned char* ws = P.ws;
    float* T = (float*)lds;
    constexpr int T_IN = 52 * 16, T_OUT = 16 * 16, T_UP = 64 * 16, T_DN = 16 * 64, T_UV = 16, T_L = T_IN + T_OUT + T_UP + T_DN + T_UV;
    for (int u = wg; u < 2 * T_L; u += G) {
        const int l = u / T_L; int r = u % T_L;
        if (r < T_IN) { conv_tile(T, P.w_in + (size_t)l * DM * NPJ_VALID, NPJ_VALID, DM, NPJ_VALID, nullptr, nullptr, (f16*)(ws + WS_WIN) + (size_t)l * NPJ * DM, r / 16, r % 16); continue; }
        r -= T_IN;
        if (r < T_OUT) { conv_tile(T, P.w_out + (size_t)l * DM * DM, DM, DM, DM, P.g_out_a + l * 512, P.g_out_b + l * 512, (f16*)(ws + WS_WOUT) + (size_t)l * DM * DM, r / 16, r % 16); continue; }
        r -= T_OUT;
        if (r < T_UP) { conv_tile(T, P.w_up + (size_t)l * DM * FF, FF, DM, FF, nullptr, nullptr, (f16*)(ws + WS_WUP) + (size_t)l * FF * DM, r / 16, r % 16); continue; }
        r -= T_UP;
        if (r < T_DN) { conv_tile(T, P.w_down + (size_t)l * FF * DM, DM, FF, DM, nullptr, nullptr, (f16*)(ws + WS_WDN) + (size_t)l * DM * FF, r / 64, r % 64); continue; }
        r -= T_DN;
        { const int h = r >> 1; conv_tile(T, P.w_uv + ((size_t)l * 8 + h) * 128 * 64, 64, 128, 64, nullptr, nullptr, (f16*)(ws + WS_WUV) + ((size_t)l * 8 + h) * 64 * 128, 0, r & 1); }
    }
    if (wg == G - 1) {
        float* BT = (float*)(ws + WS_BIAS);
        for (int i = tid; i < 8 * 2112; i += NTHR) { const int h = i / 2112, idx = i % 2112; const int bk = t5_bucket_dev(idx - 2047);
            BT[i] = (P.rel_bias[bk * 8 + h] - P.rel_bias[15 * 8 + h]) * LOG2E; }
    }
    __syncthreads();
    if (wg < 192) {
        float* SC = (float*)lds;
        float* RED = (float*)(lds + 65536);
        for (int i = tid; i < 16 * 1024; i += NTHR) { const int b = i >> 10, k = i & 1023; const float cv = P.c[i]; SC[k * 16 + b] = cv / (1.f + __expf(-cv)); }
        __syncthreads();
        for (int u = wg; u < 192; u += G) {
            const int l = u / 96, cb = u % 96, col = cb * 64 + lane;
            const float* wp = P.w_mod + (size_t)l * DM * 6144 + col;
            float acc[16];
#pragma unroll
            for (int b = 0; b < 16; ++b) acc[b] = 0.f;
            for (int k = wv * 128; k < wv * 128 + 128; ++k) {
                const float w = wp[(size_t)k * 6144];
                const f32x4 s0 = *(const f32x4*)(SC + k * 16), s1 = *(const f32x4*)(SC + k * 16 + 4), s2 = *(const f32x4*)(SC + k * 16 + 8), s3 = *(const f32x4*)(SC + k * 16 + 12);
#pragma unroll
                for (int e = 0; e < 4; ++e) { acc[e] += s0[e] * w; acc[4 + e] += s1[e] * w; acc[8 + e] += s2[e] * w; acc[12 + e] += s3[e] * w; }
            }
#pragma unroll
            for (int b = 0; b < 16; ++b) RED[(wv * 16 + b) * 64 + lane] = acc[b];
            __syncthreads();
            for (int i = tid; i < 1024; i += NTHR) { const int b = i >> 6, cc = i & 63; float s = P.b_mod[l * 6144 + cb * 64 + cc];
#pragma unroll
                for (int w8 = 0; w8 < 8; ++w8) s += RED[(w8 * 16 + b) * 64 + cc];
                ((float*)(ws + WS_MOD))[((size_t)l * 16 + b) * 6144 + cb * 64 + cc] = s; }
            __syncthreads();
        }
    }
}

__device__ __forceinline__ void norm_mod_phase(const float* x, const float* gain, const float* sh, const float* sc, f16* H, int G, int wg) {
    const int tid_ = ltid(); const int lane = tid_ & 63, wv = tid_ >> 6;
    for (int row = wg * NWAVES + wv; row < MT; row += G * NWAVES) {
        const int b = row >> 11; const float* xp = x + (size_t)row * DM + lane * 4;
        f32x4 v[4]; float ss = 0.f;
#pragma unroll
        for (int i = 0; i < 4; ++i) { v[i] = *(const f32x4*)(xp + i * 256); ss += v[i][0] * v[i][0] + v[i][1] * v[i][1] + v[i][2] * v[i][2] + v[i][3] * v[i][3]; }
        ss = wave_sum(ss);
        const float rstd = rsqrtf(ss * (1.0f / DM) + EPS);
#pragma unroll
        for (int i = 0; i < 4; ++i) { const int col = i * 256 + lane * 4;
            const f32x4 g4 = *(const f32x4*)(gain + col), s4 = *(const f32x4*)(sc + (size_t)b * 6144 + col), h4 = *(const f32x4*)(sh + (size_t)b * 6144 + col);
            f16x4 o;
#pragma unroll
            for (int e = 0; e < 4; ++e) o[e] = (f16)((v[i][e] * rstd * g4[e]) * (1.f + s4[e]) + h4[e]);
            *(f16x4*)(H + (size_t)row * DM + col) = o; }
    }
}

__device__ __forceinline__ void final_norm_phase(const float* x, const float* gain, float* out, int G, int wg) {
    const int tid_ = ltid(); const int lane = tid_ & 63, wv = tid_ >> 6;
    for (int row = wg * NWAVES + wv; row < MT; row += G * NWAVES) {
        const float* xp = x + (size_t)row * DM + lane * 4;
        f32x4 v[4]; float ss = 0.f;
#pragma unroll
        for (int i = 0; i < 4; ++i) { v[i] = *(const f32x4*)(xp + i * 256); ss += v[i][0] * v[i][0] + v[i][1] * v[i][1] + v[i][2] * v[i][2] + v[i][3] * v[i][3]; }
        ss = wave_sum(ss);
        const float rstd = rsqrtf(ss * (1.0f / DM) + EPS);
#pragma unroll
        for (int i = 0; i < 4; ++i) { const int col = i * 256 + lane * 4; const f32x4 g4 = *(const f32x4*)(gain + col);
            *(f32x4*)(out + (size_t)row * DM + col) = v[i] * rstd * g4; }
    }
}

__device__ __forceinline__ void onorm_phase(f16* O, int G, int wg) {
    const int tid_ = ltid(); const int lane = tid_ & 63, wv = tid_ >> 6;
    for (int row = wg * NWAVES + wv; row < MT; row += G * NWAVES) {
        f16* p = O + (size_t)row * DM + lane * 16;
        f16x8 a = *(const f16x8*)p, b = *(const f16x8*)(p + 8); float ss = 0.f;
#pragma unroll
        for (int e = 0; e < 8; ++e) { const float x = (float)a[e], y = (float)b[e]; ss += x * x + y * y; }
        ss = half_sum(ss);
        const float rstd = rsqrtf(ss * (1.0f / 512.f) + EPS);
#pragma unroll
        for (int e = 0; e < 8; ++e) { a[e] = (f16)((float)a[e] * rstd); b[e] = (f16)((float)b[e] * rstd); }
        *(f16x8*)p = a; *(f16x8*)(p + 8) = b;
    }
}

__device__ __forceinline__ void kvnorm_phase(unsigned char* lds, const f16* PROJ, const float* g, f16* KV, f16* KVT, int G, int wg) {
    const int tid = ltid();
    f16* T = (f16*)lds;
    for (int blk = wg; blk < MT / 64; blk += G) {
        const int tok = tid >> 3, ch = tid & 7; const size_t row = (size_t)blk * 64 + tok;
        const f16* p = PROJ + row * NPJ + C_DKV + ch * 16;
        const f16x8 a = *(const f16x8*)p, b = *(const f16x8*)(p + 8);
        float va[8], vb[8]; float ss = 0.f;
#pragma unroll
        for (int e = 0; e < 8; ++e) { va[e] = (float)a[e]; vb[e] = (float)b[e]; ss += va[e] * va[e] + vb[e] * vb[e]; }
        ss += __shfl_xor(ss, 4); ss += __shfl_xor(ss, 2); ss += __shfl_xor(ss, 1);
        const float rstd = rsqrtf(ss * (1.0f / 128.f) + EPS);
        f16x8 oa, ob;
#pragma unroll
        for (int e = 0; e < 8; ++e) { oa[e] = (f16)(va[e] * rstd * g[ch * 16 + e]); ob[e] = (f16)(vb[e] * rstd * g[ch * 16 + 8 + e]); }
        *(f16x8*)(KV + row * 128 + ch * 16) = oa; *(f16x8*)(KV + row * 128 + ch * 16 + 8) = ob;
#pragma unroll
        for (int e = 0; e < 8; ++e) { T[(ch * 16 + e) * 72 + tok] = oa[e]; T[(ch * 16 + 8 + e) * 72 + tok] = ob[e]; }
        __syncthreads();
        { const int dim = tid >> 2, tc = (tid & 3) * 16; const int bb = (blk * 64) >> 11, t0 = (blk * 64) & 2047;
          const f16x8 x0 = *(const f16x8*)(T + dim * 72 + tc), x1 = *(const f16x8*)(T + dim * 72 + tc + 8);
          f16* q = KVT + ((size_t)bb * 128 + dim) * SEQ + t0 + tc;
          *(f16x8*)q = x0; *(f16x8*)(q + 8) = x1; }
        __syncthreads();
    }
}
__device__ __forceinline__ void sb_attn_phase(unsigned char* lds, const f16* PROJ, f16* OBUF, int G, int wg) {
    const int tid = ltid(), lane = tid & 63, wv = tid >> 6, l32 = lane & 31, hh = lane >> 5;
    f16* Kt = (f16*)lds;
    f16* Vt = (f16*)(lds + 9216);
    volatile LAS int* flags = (volatile LAS int*)(lds + 18432);
    const int srow = tid >> 3, sch = tid & 7;
    for (int u = wg; u < 1024; u += G) {
        const int bh = u & 127, tt = u >> 7;
        const int qb = (tt & 1) ? ((tt == 1) ? 5 : (tt == 3) ? 2 : (tt == 5) ? 4 : 3) : ((tt == 0) ? 7 : (tt == 2) ? 0 : (tt == 4) ? 6 : 1);
        const int b = bh >> 3, h = bh & 7;
        const size_t rowbase = (size_t)b * SEQ;
        const int r0 = qb * 256 + wv * 32;
        f16x8 qf[4];
        { const f16* qp = PROJ + (rowbase + r0 + l32) * NPJ + C_SBQ + h * 64 + hh * 8;
#pragma unroll
          for (int s = 0; s < 4; ++s) qf[s] = *(const f16x8*)(qp + 16 * s); }
        f32x16 accO[2];
#pragma unroll
        for (int d = 0; d < 2; ++d)
#pragma unroll
            for (int r = 0; r < 16; ++r) accO[d][r] = 0.f;
        float C = 1.0f;
        const int kt_hi = qb * 4 + 3, kt_w = qb * 4 + (wv >> 1);
        const f16* kp = PROJ + (rowbase + srow) * NPJ + C_SBK + h * 64 + sch * 8;
        const f16* vp = PROJ + (rowbase + srow) * NPJ + C_SBV + h * 64 + sch * 8;
        f16x8 kreg = *(const f16x8*)(kp + (size_t)kt_hi * 64 * NPJ), vreg = *(const f16x8*)(vp + (size_t)kt_hi * 64 * NPJ);
        if (lane == 0) flags[wv] = 1;
        for (int kt = kt_hi; kt >= 0; --kt) {
            __syncthreads();
            { int alive = 0;
#pragma unroll
              for (int w8 = 0; w8 < 8; ++w8) alive |= flags[w8];
              if (!alive) break; }
            *(f16x8*)(Kt + srow * 72 + sch * 8) = kreg;
#pragma unroll
            for (int e = 0; e < 8; ++e) Vt[(sch * 8 + e) * 72 + srow] = vreg[e];
            __syncthreads();
            if (kt > 0) { kreg = *(const f16x8*)(kp + (size_t)(kt - 1) * 64 * NPJ); vreg = *(const f16x8*)(vp + (size_t)(kt - 1) * 64 * NPJ); }
            if (kt <= kt_w) {
                f32x16 S[2];
#pragma unroll
                for (int t = 0; t < 2; ++t) {
#pragma unroll
                    for (int r = 0; r < 16; ++r) S[t][r] = 0.f;
#pragma unroll
                    for (int s = 0; s < 4; ++s) { const f16x8 a = *(const f16x8*)(Kt + (32 * t + l32) * 72 + 16 * s + 8 * hh); S[t] = __builtin_amdgcn_mfma_f32_32x32x16_f16(a, qf[s], S[t], 0, 0, 0); }
                }
                const int q = r0 + l32, kb = kt * 64 + 4 * hh;
                const bool diag = (kt * 64 + 63 >= r0);
                f32x16 om[2];
#pragma unroll
                for (int t = 0; t < 2; ++t)
#pragma unroll
                    for (int r = 0; r < 16; ++r) {
                        const float z = S[t][r] * 0.125f;
                        const float e = __builtin_amdgcn_exp2f(-fabsf(z) * LOG2E);
                        const float rr = __builtin_amdgcn_rcpf(1.0f + e), sm = e * rr;
                        float be = z >= 0.f ? rr : sm, o = z >= 0.f ? sm : rr;
                        if (diag) { const int key = kb + 32 * t + 8 * (r >> 2) + (r & 3); if (key >= q) { be = 0.f; o = 1.0f; } }
                        S[t][r] = be; om[t][r] = o;
                    }
                float R = C;
#pragma unroll
                for (int t = 1; t >= 0; --t)
#pragma unroll
                    for (int g = 3; g >= 0; --g) {
                        const float o0 = om[t][4 * g], o1 = om[t][4 * g + 1], o2 = om[t][4 * g + 2], o3 = om[t][4 * g + 3];
                        const float gown = (o0 * o1) * (o2 * o3);
                        const float gp = __shfl_xor(gown, 32);
                        const float pre = hh ? R : R * gp;
                        const float p3 = pre, p2 = p3 * o3, p1 = p2 * o2, p0 = p1 * o1;
                        S[t][4 * g + 3] *= p3; S[t][4 * g + 2] *= p2; S[t][4 * g + 1] *= p1; S[t][4 * g] *= p0;
                        R = R * gown * gp;
                    }
                C = R;
                f16x8 pf[2][2];
#pragma unroll
                for (int t = 0; t < 2; ++t)
#pragma unroll
                    for (int s = 0; s < 2; ++s)
#pragma unroll
                        for (int e = 0; e < 8; ++e) pf[t][s][e] = (f16)S[t][8 * s + e];
#pragma unroll
                for (int d = 0; d < 2; ++d)
#pragma unroll
                    for (int t = 0; t < 2; ++t)
#pragma unroll
                        for (int s = 0; s < 2; ++s) {
                            const f16* vrow = Vt + (32 * d + l32) * 72 + 32 * t + 16 * s + 4 * hh;
                            const f16x4 lo = *(const f16x4*)vrow, hi = *(const f16x4*)(vrow + 8);
                            f16x8 a; a[0] = lo[0]; a[1] = lo[1]; a[2] = lo[2]; a[3] = lo[3]; a[4] = hi[0]; a[5] = hi[1]; a[6] = hi[2]; a[7] = hi[3];
                            accO[d] = __builtin_amdgcn_mfma_f32_32x32x16_f16(a, pf[t][s], accO[d], 0, 0, 0);
                        }
                const bool anyalive = __ballot(C != 0.f) != 0ull;
                if (lane == 0) flags[wv] = anyalive ? 1 : 0;
            }
        }
        { f16* op = OBUF + (rowbase + r0 + l32) * DM + h * 64 + 4 * hh;
#pragma unroll
          for (int d = 0; d < 2; ++d)
#pragma unroll
            for (int g = 0; g < 4; ++g) { f16x4 o; o[0] = (f16)accO[d][4 * g]; o[1] = (f16)accO[d][4 * g + 1]; o[2] = (f16)accO[d][4 * g + 2]; o[3] = (f16)accO[d][4 * g + 3];
                *(f16x4*)(op + 32 * d + 8 * g) = o; } }
        __syncthreads();
    }
}
constexpr int IDX_PITCH = 2052;
__device__ __forceinline__ void indexer_phase(unsigned char* lds, const f16* PROJ, unsigned* MASK, int G, int wg) {
    const int tid = ltid(), lane = tid & 63, wv = tid >> 6, l16 = lane & 15, lq = lane >> 4;
    float* SCR = (float*)lds;
    for (int u = wg; u < MT / 16; u += G) {
        const int b = u & 15, qg = 127 - (u >> 4);
        const int q0 = qg * 16; const size_t rowbase = (size_t)b * SEQ;
        const int nadm = 64 * ((q0 >> 6) + 1);
        f16x8 qa[8][2];
        { const f16* qp = PROJ + (rowbase + q0 + l16) * NPJ + C_IQ + lq * 8;
#pragma unroll
          for (int hd = 0; hd < 8; ++hd)
#pragma unroll
            for (int s = 0; s < 2; ++s) qa[hd][s] = *(const f16x8*)(qp + hd * 64 + 32 * s); }
        float wq[4][8];
#pragma unroll
        for (int r = 0; r < 4; ++r) { const f16x8 w8 = *(const f16x8*)(PROJ + (rowbase + q0 + 4 * lq + r) * NPJ + C_IW);
#pragma unroll
            for (int hd = 0; hd < 8; ++hd) wq[r][hd] = (float)w8[hd] * (0.35355339059327373f * 0.125f); }
        const int ntile = nadm >> 4;
        for (int nt = wv; nt < ntile; nt += NWAVES) {
            const f16* kp = PROJ + (rowbase + nt * 16 + l16) * NPJ + C_IK + lq * 8;
            const f16x8 kb0 = *(const f16x8*)kp, kb1 = *(const f16x8*)(kp + 32);
            f32x4 sc = {0.f, 0.f, 0.f, 0.f};
#pragma unroll
            for (int hd = 0; hd < 8; ++hd) {
                f32x4 a = {0.f, 0.f, 0.f, 0.f};
                a = __builtin_amdgcn_mfma_f32_16x16x32_f16(qa[hd][0], kb0, a, 0, 0, 0);
                a = __builtin_amdgcn_mfma_f32_16x16x32_f16(qa[hd][1], kb1, a, 0, 0, 0);
#pragma unroll
                for (int r = 0; r < 4; ++r) sc[r] += wq[r][hd] * fmaxf(a[r], 0.f);
            }
#pragma unroll
            for (int r = 0; r < 4; ++r) SCR[(4 * lq + r) * IDX_PITCH + nt * 16 + l16] = sc[r] + 0.0f;
        }
        __syncthreads();
        for (int qs = 0; qs < 2; ++qs) {
            const int qq = 2 * wv + qs;
            unsigned* mrow = MASK + (rowbase + q0 + qq) * 64;
            unsigned word = 0u;
            if (nadm <= 256) {
                word = (lane * 32 < nadm) ? 0xFFFFFFFFu : 0u;
            } else {
                const float* row = SCR + qq * IDX_PITCH;
                unsigned uk[32];
#pragma unroll
                for (int j = 0; j < 32; ++j) {
                    const int key = 64 * j + lane;
                    unsigned bits = 0u;
                    if (key < nadm) { bits = __float_as_uint(row[key]); bits ^= (unsigned)(((int)bits >> 31) | 0x80000000); }
                    uk[j] = bits;
                }
                unsigned T = 0u;
                for (int bit = 31; bit >= 0; --bit) {
                    const unsigned cand = T | (1u << bit);
                    int cnt = 0;
#pragma unroll
                    for (int j = 0; j < 32; ++j) cnt += __popcll(__ballot(uk[j] >= cand));
                    if (cnt >= 256) T = cand;
                }
                int cgt = 0;
#pragma unroll
                for (int j = 0; j < 32; ++j) cgt += __popcll(__ballot(uk[j] > T));
                int need = 256 - cgt;
#pragma unroll
                for (int j = 0; j < 32; ++j) {
                    unsigned long long sel = __ballot(uk[j] > T);
                    unsigned long long em = __ballot(uk[j] == T);
                    if (need > 0 && em != 0ull) {
                        const int pc = __popcll(em);
                        if (pc <= need) { sel |= em; need -= pc; }
                        else { unsigned long long keep = 0ull; for (int i = 0; i < need; ++i) { const unsigned long long lowb = em & (0ull - em); keep |= lowb; em ^= lowb; } sel |= keep; need = 0; }
                    }
                    const unsigned lo = (unsigned)sel, hi = (unsigned)(sel >> 32);
                    word = (lane == 2 * j) ? lo : word; word = (lane == 2 * j + 1) ? hi : word;
                }
            }
            mrow[lane] = word;
        }
        __syncthreads();
    }
}
__device__ __forceinline__ void dsa_attn_phase(unsigned char* lds, const f16* PROJ, const f16* KV, const f16* KVT, const unsigned* MASK, const float* BIAS2, const f16* WUVT, f16* OBUF, int G, int wg) {
    const int tid = ltid(), lane = tid & 63, wv = tid >> 6, l32 = lane & 31, hh = lane >> 5;
    f16* Kl = (f16*)lds;
    f16* Vl = (f16*)(lds + 17408);
    const int hd = wv;
    const float c1 = 0.08838834764831845f * LOG2E;
    for (int u = wg; u < 1024; u += G) {
        int b, qi;
        if (G == 256) { const int j = wg >> 4, i = u >> 8; b = wg & 15; qi = (i == 0) ? 63 - j : (i == 1) ? 32 + j : (i == 2) ? 31 - j : j; }
        else { b = u & 15; qi = 63 - (u >> 4); }
        const int q0 = qi * 32; const size_t rowbase = (size_t)b * SEQ;
        const int ntile = (q0 >> 6) + 1;
        f16x8 qf[8];
        { const f16* qp = PROJ + (rowbase + q0 + l32) * NPJ + C_DQ + hd * 128 + hh * 8;
#pragma unroll
          for (int s = 0; s < 8; ++s) qf[s] = *(const f16x8*)(qp + 16 * s); }
        const unsigned* mrow = MASK + (rowbase + q0 + l32) * 64;
        const int q = q0 + l32;
        f32x16 accO[4];
#pragma unroll
        for (int d = 0; d < 4; ++d)
#pragma unroll
            for (int r = 0; r < 16; ++r) accO[d][r] = 0.f;
        float mrun = -1e30f, lsum = 0.f;
        const int skey = tid >> 3, skc = (tid & 7) * 16, sdim = tid >> 2, sdc = (tid & 3) * 16;
        const f16* kvp = KV + (rowbase + skey) * 128 + skc;
        const f16* ktp = KVT + ((size_t)b * 128 + sdim) * SEQ + sdc;
        f16x8 k0 = *(const f16x8*)kvp, k1 = *(const f16x8*)(kvp + 8), t0 = *(const f16x8*)ktp, t1 = *(const f16x8*)(ktp + 8);
        for (int kt = 0; kt < ntile; ++kt) {
            __syncthreads();
            *(f16x8*)(Kl + skey * 136 + skc) = k0; *(f16x8*)(Kl + skey * 136 + skc + 8) = k1;
            *(f16x8*)(Vl + sdim * 72 + sdc) = t0; *(f16x8*)(Vl + sdim * 72 + sdc + 8) = t1;
            __syncthreads();
            if (kt + 1 < ntile) { const f16* a = kvp + (size_t)(kt + 1) * 64 * 128; const f16* c = ktp + (kt + 1) * 64;
                k0 = *(const f16x8*)a; k1 = *(const f16x8*)(a + 8); t0 = *(const f16x8*)c; t1 = *(const f16x8*)(c + 8); }
            const u32x2 mw = *(const u32x2*)(mrow + 2 * kt);
            f32x16 S[2];
#pragma unroll
            for (int t = 0; t < 2; ++t) {
#pragma unroll
                for (int r = 0; r < 16; ++r) S[t][r] = 0.f;
#pragma unroll
                for (int s = 0; s < 8; ++s) { const f16x8 a = *(const f16x8*)(Kl + (32 * t + l32) * 136 + 16 * s + 8 * hh); S[t] = __builtin_amdgcn_mfma_f32_32x32x16_f16(a, qf[s], S[t], 0, 0, 0); }
            }
            const bool near = (kt * 64 + 63 + 96 > q0);
            const float* bp = BIAS2 + hd * 2112 + 2047 - q + kt * 64 + 4 * hh;
            float tmax = -1e30f;
#pragma unroll
            for (int t = 0; t < 2; ++t) {
                const unsigned wsh = (t == 0 ? mw[0] : mw[1]) >> (4 * hh);
#pragma unroll
                for (int r = 0; r < 16; ++r) {
                    const int ko = 8 * (r >> 2) + (r & 3);
                    float x = S[t][r] * c1;
                    if (near) x += bp[32 * t + ko];
                    x = ((wsh >> ko) & 1u) ? x : -1e30f;
                    S[t][r] = x; tmax = fmaxf(tmax, x);
                }
            }
            tmax = fmaxf(tmax, __shfl_xor(tmax, 32));
            const float mnew = fmaxf(mrun, tmax);
            const float alpha = __builtin_amdgcn_exp2f(mrun - mnew);
            mrun = mnew;
            float ps = 0.f;
#pragma unroll
            for (int t = 0; t < 2; ++t)
#pragma unroll
                for (int r = 0; r < 16; ++r) { const float x = S[t][r]; const float p = (x > -1e29f) ? __builtin_amdgcn_exp2f(x - mnew) : 0.f; S[t][r] = p; ps += p; }
            lsum = lsum * alpha + ps;
#pragma unroll
            for (int d = 0; d < 4; ++d)
#pragma unroll
                for (int r = 0; r < 16; ++r) accO[d][r] *= alpha;
            f16x8 pf[2][2];
#pragma unroll
            for (int t = 0; t < 2; ++t)
#pragma unroll
                for (int s = 0; s < 2; ++s)
#pragma unroll
                    for (int e = 0; e < 8; ++e) pf[t][s][e] = (f16)S[t][8 * s + e];
#pragma unroll
            for (int d = 0; d < 4; ++d)
#pragma unroll
                for (int t = 0; t < 2; ++t)
#pragma unroll
                    for (int s = 0; s < 2; ++s) {
                        const f16* vrow = Vl + (32 * d + l32) * 72 + 32 * t + 16 * s + 4 * hh;
                        const f16x4 lo = *(const f16x4*)vrow, hi = *(const f16x4*)(vrow + 8);
                        f16x8 a; a[0] = lo[0]; a[1] = lo[1]; a[2] = lo[2]; a[3] = lo[3]; a[4] = hi[0]; a[5] = hi[1]; a[6] = hi[2]; a[7] = hi[3];
                        accO[d] = __builtin_amdgcn_mfma_f32_32x32x16_f16(a, pf[t][s], accO[d], 0, 0, 0);
                    }
        }
        const float ltot = lsum + __shfl_xor(lsum, 32);
        const float inv = 1.0f / ltot;
        f32x16 Z[2];
#pragma unroll
        for (int n = 0; n < 2; ++n)
#pragma unroll
            for (int r = 0; r < 16; ++r) Z[n][r] = 0.f;
#pragma unroll
        for (int d = 0; d < 4; ++d)
#pragma unroll
            for (int s = 0; s < 2; ++s) {
                f16x8 a;
#pragma unroll
                for (int e = 0; e < 8; ++e) a[e] = (f16)(accO[d][8 * s + e] * inv);
#pragma unroll
                for (int n = 0; n < 2; ++n) {
                    const f16* wp = WUVT + ((size_t)hd * 64 + 32 * n + l32) * 128 + 32 * d + 16 * s + 4 * hh;
                    const f16x4 lo = *(const f16x4*)wp, hi = *(const f16x4*)(wp + 8);
                    f16x8 bb; bb[0] = lo[0]; bb[1] = lo[1]; bb[2] = lo[2]; bb[3] = lo[3]; bb[4] = hi[0]; bb[5] = hi[1]; bb[6] = hi[2]; bb[7] = hi[3];
                    Z[n] = __builtin_amdgcn_mfma_f32_32x32x16_f16(a, bb, Z[n], 0, 0, 0);
                }
            }
        { f16* op = OBUF + (rowbase + q0) * DM + 512 + hd * 64 + l32;
#pragma unroll
          for (int n = 0; n < 2; ++n)
#pragma unroll
            for (int r = 0; r < 16; ++r) op[(size_t)(8 * (r >> 2) + 4 * hh + (r & 3)) * DM + 32 * n] = (f16)Z[n][r]; }
    }
}
constexpr int N_PHASES = 20;
struct Args { Ptrs p; int ph_lo, ph_hi; };

__global__ void __launch_bounds__(NTHR, 2) trunk_fwd(Args args) {
    extern __shared__ __attribute__((aligned(16))) unsigned char lds[];
    const Ptrs& P = args.p;
    unsigned char* ws = P.ws;
    const int G = gridDim.x, wg = blockIdx.x, tid = threadIdx.x;
    const int lo = args.ph_lo, hi = args.ph_hi;
    const bool multi = (hi - lo) > 1;
    XcdBarrier bar; bar.bar = (unsigned*)(ws + WS_CTL); bar.x = 0; bar.st = nullptr;
    if (multi) {
        if (tid < 4) ((LAS unsigned*)(lds + LDS_MISC))[tid] = 0u;
        __syncthreads();
        bar = xcd_barrier_post((unsigned*)(ws + WS_CTL), (volatile LAS unsigned*)(lds + LDS_MISC));
    }
#ifndef PHMASK
#define PHMASK 0xFFFFF
#endif
#define IN(k) (lo <= (k) && (k) < hi)
#define PM(j) ((PHMASK >> (j)) & 1)
#define SEAM(k) do { if (IN(k) && IN((k) + 1)) xcd_barrier(bar); } while (0)
    float* MOD = (float*)(ws + WS_MOD);
    f16* H = (f16*)(ws + WS_H); f16* PROJ = (f16*)(ws + WS_PROJ); f16* OBUF = (f16*)(ws + WS_OBUF); f16* HID = (f16*)(ws + WS_HID);
    f16* KV = (f16*)(ws + WS_KV); f16* KVT = (f16*)(ws + WS_KVT); unsigned* MASK = (unsigned*)(ws + WS_MASK);
    float* X = P.out;

    if (PM(0) && IN(0)) { prologue_phase(lds, P, G, wg); SEAM(0); }

    for (int l = 0; l < NLAYER; ++l) {
        const int pb = 1 + 9 * l;
        const float* modl = MOD + (size_t)l * 16 * 6144;
        const float* xin = (l == 0) ? P.x : X;
        if (PM(1) && IN(pb + 0)) { norm_mod_phase(xin, P.g_attn + l * DM, modl + 0 * DM, modl + 1 * DM, H, G, wg); SEAM(pb + 0); }
        if (PM(2) && IN(pb + 1)) {
            pg8::Gemm g{H, (const f16*)(ws + WS_WIN) + (size_t)l * NPJ * DM, MT, NPJ, DM}; pg8::StaticOrder S; S.init(MT, NPJ, G, wg);
            pg8::EpiF16<0> E{PROJ, NPJ};
            pg8::gemm_phase<pg8::EpiF16<0>, pg8::StaticOrder>((LAS unsigned char*)lds, g, S, E);
            SEAM(pb + 1);
        }
        if (PM(3) && IN(pb + 2)) {
#if ENABLE_DSA
            kvnorm_phase(lds, PROJ, P.kv_norm_g + l * 128, KV, KVT, G, wg);
            __syncthreads();
            indexer_phase(lds, PROJ, MASK, G, wg);
            __syncthreads();
#endif
#if ENABLE_SB
            sb_attn_phase(lds, PROJ, OBUF, G, wg);
#else
            for (size_t i = (size_t)wg * NTHR + tid; i < (size_t)MT * 64; i += (size_t)G * NTHR) { const size_t row = i >> 6, c8 = i & 63; *(f16x8*)(OBUF + row * DM + c8 * 8) = (f16x8){0, 0, 0, 0, 0, 0, 0, 0}; }
#endif
            SEAM(pb + 2);
        }
        if (PM(4) && IN(pb + 3)) {
#if ENABLE_DSA
            dsa_attn_phase(lds, PROJ, KV, KVT, MASK, (const float*)(ws + WS_BIAS), (const f16*)(ws + WS_WUV) + (size_t)l * 8 * 64 * 128, OBUF, G, wg);
#else
            for (size_t i = (size_t)wg * NTHR + tid; i < (size_t)MT * 64; i += (size_t)G * NTHR) { const size_t row = i >> 6, c8 = i & 63; *(f16x8*)(OBUF + row * DM + 512 + c8 * 8) = (f16x8){0, 0, 0, 0, 0, 0, 0, 0}; }
#endif
            SEAM(pb + 3);
        }
        if (PM(5) && IN(pb + 4)) { onorm_phase(OBUF, G, wg); SEAM(pb + 4); }
        if (PM(6) && IN(pb + 5)) {
            pg8::Gemm g{OBUF, (const f16*)(ws + WS_WOUT) + (size_t)l * DM * DM, MT, DM, DM}; pg8::StaticOrder S; S.init(MT, DM, G, wg);
            pg8::EpiResid E{xin, X, modl + 2 * DM};
            pg8::gemm_phase<pg8::EpiResid, pg8::StaticOrder>((LAS unsigned char*)lds, g, S, E);
            SEAM(pb + 5);
        }
        if (PM(7) && IN(pb + 6)) { norm_mod_phase(X, P.g_mlp + l * DM, modl + 3 * DM, modl + 4 * DM, H, G, wg); SEAM(pb + 6); }
        if (PM(8) && IN(pb + 7)) {
            pg8::Gemm g{H, (const f16*)(ws + WS_WUP) + (size_t)l * FF * DM, MT, FF, DM}; pg8::StaticOrder S; S.init(MT, FF, G, wg);
            pg8::EpiF16<1> E{HID, FF};
            pg8::gemm_phase<pg8::EpiF16<1>, pg8::StaticOrder>((LAS unsigned char*)lds, g, S, E);
            SEAM(pb + 7);
        }
        if (PM(9) && IN(pb + 8)) {
            pg8::Gemm g{HID, (const f16*)(ws + WS_WDN) + (size_t)l * DM * FF, MT, DM, FF}; pg8::StaticOrder S; S.init(MT, DM, G, wg);
            pg8::EpiResid E{X, X, modl + 5 * DM};
            pg8::gemm_phase<pg8::EpiResid, pg8::StaticOrder>((LAS unsigned char*)lds, g, S, E);
            SEAM(pb + 8);
        }
    }
    if (PM(10) && IN(19)) { final_norm_phase(X, P.g_final, P.out, G, wg); }
#undef IN
#undef SEAM
}

extern "C" void kernel_launch(void* const* d_in, const int* in_sizes, int n_in, void* d_out, int out_size, void* d_ws, size_t ws_size, hipStream_t stream) {
    static int grid = 0;
    if (grid == 0) {
        if (n_in != 16 || in_sizes[0] != MT * DM || out_size != MT * DM || ws_size < WS_END) {
            fprintf(stderr, "kernel_launch: unexpected shapes: n_in %d in0 %d out %d ws %zu (need %zu)\n", n_in, n_in > 0 ? in_sizes[0] : -1, out_size, ws_size, (size_t)WS_END); grid = -1; return; }
        int dev = 0, cus = 0, per_cu = 0;
        if (hipGetDevice(&dev) != hipSuccess || hipDeviceGetAttribute(&cus, hipDeviceAttributeMultiprocessorCount, dev) != hipSuccess) { grid = -1; return; }
        if (hipFuncSetAttribute((const void*)trunk_fwd, hipFuncAttributeMaxDynamicSharedMemorySize, LDS_BYTES) != hipSuccess) { fprintf(stderr, "kernel_launch: hipFuncSetAttribute failed\n"); grid = -1; return; }
        if (hipOccupancyMaxActiveBlocksPerMultiprocessor(&per_cu, (const void*)trunk_fwd, NTHR, LDS_BYTES) != hipSuccess || per_cu < 1) fprintf(stderr, "kernel_launch: occupancy query says %d\n", per_cu);
        (void)hipGetLastError();
        grid = cus;
    }
    if (grid < 0) return;
    (void)hipMemsetAsync((char*)d_ws + WS_CTL, 0, CTL_BYTES, stream);
    Args a{};
    a.p.x = (const float*)d_in[0]; a.p.c = (const float*)d_in[1]; a.p.w_mod = (const float*)d_in[2]; a.p.b_mod = (const float*)d_in[3]; a.p.g_attn = (const float*)d_in[4];
    a.p.w_in = (const float*)d_in[5]; a.p.kv_norm_g = (const float*)d_in[6]; a.p.w_uv = (const float*)d_in[7]; a.p.g_out_a = (const float*)d_in[8]; a.p.g_out_b = (const float*)d_in[9];
    a.p.w_out = (const float*)d_in[10]; a.p.g_mlp = (const float*)d_in[11]; a.p.w_up = (const float*)d_in[12]; a.p.w_down = (const float*)d_in[13]; a.p.rel_bias = (const float*)d_in[14];
    a.p.g_final = (const float*)d_in[15]; a.p.out = (float*)d_out; a.p.ws = (unsigned char*)d_ws;
#if N_LAUNCH_MODE == 1
    a.ph_lo = 0; a.ph_hi = N_PHASES;
    hipLaunchKernelGGL(trunk_fwd, dim3(grid), dim3(NTHR), LDS_BYTES, stream, a);
#else
    for (int ph = 0; ph < N_PHASES; ++ph) { a.ph_lo = ph; a.ph_hi = ph + 1; hipLaunchKernelGGL(trunk_fwd, dim3(grid), dim3(NTHR), LDS_BYTES, stream, a); }
#endif
}
```

```cpp
#define N_LAUNCH_MODE 1
#include <hip/hip_runtime.h>
#include <cstdio>
#include <cstdint>

#define LAS __attribute__((address_space(3)))
typedef _Float16 f16;
typedef _Float16 f16x8 __attribute__((ext_vector_type(8)));
typedef _Float16 f16x4 __attribute__((ext_vector_type(4)));
typedef float f32x2 __attribute__((ext_vector_type(2)));
typedef float f32x4 __attribute__((ext_vector_type(4)));
typedef float f32x16 __attribute__((ext_vector_type(16)));
typedef unsigned u32x2 __attribute__((ext_vector_type(2)));
typedef unsigned u32x4 __attribute__((ext_vector_type(4)));

#ifndef N_LAUNCH_MODE
#define N_LAUNCH_MODE 0
#endif
#ifndef ENABLE_SB
#define ENABLE_SB 1
#endif
#ifndef ENABLE_DSA
#define ENABLE_DSA 1
#endif

constexpr int NB = 16, SEQ = 2048, DM = 1024, MT = NB * SEQ, NPJ = 3328, NPJ_VALID = 3272, FF = 4096, NLAYER = 2;
constexpr int C_SBQ = 0, C_SBK = 512, C_SBV = 1024, C_DQ = 1536, C_DKV = 2560, C_IQ = 2688, C_IK = 3200, C_IW = 3264;
constexpr int NWAVES = 8, NTHR = 512;
constexpr float EPS = 1e-6f;
constexpr float LOG2E = 1.4426950408889634f;

constexpr size_t al256(size_t x) { return (x + 255) & ~(size_t)255; }
constexpr size_t WS_CTL = 0;
constexpr size_t CTL_BYTES = 65536;
constexpr size_t WS_MOD = WS_CTL + CTL_BYTES;
constexpr size_t WS_BIAS = WS_MOD + al256((size_t)2 * 16 * 6144 * 4);
constexpr size_t WS_WIN = WS_BIAS + al256((size_t)8 * 2112 * 4);
constexpr size_t WS_WOUT = WS_WIN + (size_t)2 * NPJ * DM * 2;
constexpr size_t WS_WUP = WS_WOUT + (size_t)2 * DM * DM * 2;
constexpr size_t WS_WDN = WS_WUP + (size_t)2 * FF * DM * 2;
constexpr size_t WS_WUV = WS_WDN + (size_t)2 * FF * DM * 2;
constexpr size_t WS_H = WS_WUV + (size_t)2 * 8 * 64 * 128 * 2;
constexpr size_t WS_KV = WS_H + (size_t)MT * DM * 2;
constexpr size_t WS_KVT = WS_KV + (size_t)MT * 128 * 2;
constexpr size_t WS_MASK = WS_KVT + (size_t)MT * 128 * 2;
constexpr size_t WS_PROJ = WS_MASK + (size_t)MT * 64 * 4;
constexpr size_t WS_OBUF = WS_PROJ + (size_t)MT * NPJ * 2;
constexpr size_t WS_HID = WS_PROJ;
constexpr size_t WS_END = WS_OBUF + (size_t)MT * DM * 2;
static_assert((size_t)MT * FF * 2 <= WS_END - WS_PROJ, "HID overlay must fit");

constexpr int LDS_BYTES = 147456;
constexpr int LDS_MISC = 135168;

__device__ __forceinline__ float wave_sum(float v) {
    v += __shfl_xor(v, 32); v += __shfl_xor(v, 16); v += __shfl_xor(v, 8); v += __shfl_xor(v, 4); v += __shfl_xor(v, 2); v += __shfl_xor(v, 1); return v;
}
__device__ __forceinline__ float half_sum(float v) {
    v += __shfl_xor(v, 16); v += __shfl_xor(v, 8); v += __shfl_xor(v, 4); v += __shfl_xor(v, 2); v += __shfl_xor(v, 1); return v;
}

__device__ __forceinline__ int ltid() { int t = threadIdx.x; asm volatile("" : "+v"(t)); return t; }
#define XB_TMO      128
#define XB_XCNT(j)  (256  + 64 * (j))
#define XB_XSUB(j)  (1280 + 64 * (j))
#define XB_XGEN(j)  (2304 + 64 * (j))
#define XB_TOP      3328
#define XB_TOPGEN   3392
#define XCD_BAR_WORDS 3456
#define XB_SPIN_CAP (1u << 18)

__device__ __forceinline__ unsigned xb_ld(unsigned* p)              { return __hip_atomic_load(p, __ATOMIC_RELAXED, __HIP_MEMORY_SCOPE_AGENT); }
__device__ __forceinline__ unsigned xb_add(unsigned* p, unsigned v) { return __hip_atomic_fetch_add(p, v, __ATOMIC_RELAXED, __HIP_MEMORY_SCOPE_AGENT); }
__device__ __forceinline__ unsigned xb_xcc_id() { return (unsigned)__builtin_amdgcn_s_getreg((3 << 11) | 20) & 0xFu; }
#define XB_SPIN(cond, bar) do { unsigned _sp = 0; while (cond) { __builtin_amdgcn_s_sleep(1); \
    if ((++_sp & 255u) == 0u) { if (xb_ld(&(bar)[XB_TMO])) break; if (_sp > XB_SPIN_CAP) { atomicAdd(&(bar)[XB_TMO], 1u); break; } } } } while (0)

struct XcdBarrier {
    unsigned* bar; unsigned x;
    volatile LAS unsigned* st;
};

__device__ __forceinline__ XcdBarrier xcd_barrier_post(unsigned* bar, volatile LAS unsigned* st) {
    XcdBarrier b; b.bar = bar; b.x = xb_xcc_id(); b.st = st;
    if (threadIdx.x == 0) (void)xb_add(&bar[XB_XCNT(b.x)], 1u);
    return b;
}
__device__ __forceinline__ void xcd_barrier_complete(unsigned* bar, unsigned x, unsigned& nloc, unsigned& nx) {
    const unsigned G = gridDim.x * gridDim.y * gridDim.z;
    unsigned sum, cnt, mine, sp = 0u;
    for (;;) {
        sum = 0u; cnt = 0u; mine = 0u;
#pragma unroll
        for (unsigned j = 0; j < 16; ++j) { const unsigned c = xb_ld(&bar[XB_XCNT(j)]); sum += c; cnt += (c > 0u) ? 1u : 0u; mine = (j == x) ? c : mine; }
        if (sum == G) break;
        __builtin_amdgcn_s_sleep(1);
        if ((++sp & 255u) == 0u) { if (xb_ld(&bar[XB_TMO])) break; if (sp > XB_SPIN_CAP) { atomicAdd(&bar[XB_TMO], 1u); break; } }
    }
    nloc = mine > 0u ? mine : 1u; nx = cnt > 0u ? cnt : 1u;
}

__device__ __forceinline__ void xcd_barrier(const XcdBarrier& b) {
    asm volatile("s_waitcnt vmcnt(0)" ::: "memory");
    __syncthreads();
    if (threadIdx.x == 0) {
        unsigned* bar = b.bar;
        __builtin_amdgcn_s_waitcnt(0);
        unsigned nloc = b.st[0], nx = b.st[1];
        if (nloc == 0u) { xcd_barrier_complete(bar, b.x, nloc, nx); b.st[0] = nloc; b.st[1] = nx; }
        const unsigned old = xb_add(&bar[XB_XSUB(b.x)], 1u);
        const unsigned gen = old / nloc;
        if (old + 1u == (gen + 1u) * nloc) {
            __builtin_amdgcn_fence(__ATOMIC_RELEASE, "agent");
            asm volatile("s_waitcnt vmcnt(0)" ::: "memory");
            const unsigned og = xb_add(&bar[XB_TOP], 1u);
            const unsigned tg = og / nx;
            if (og + 1u == (tg + 1u) * nx) xb_add(&bar[XB_TOPGEN], 1u);
            else XB_SPIN(xb_ld(&bar[XB_TOPGEN]) == tg, bar);
            __builtin_amdgcn_fence(__ATOMIC_ACQUIRE, "agent");
            xb_add(&bar[XB_XGEN(b.x)], 1u);
            asm volatile("s_waitcnt vmcnt(0)" ::: "memory");
        } else {
            XB_SPIN(xb_ld(&bar[XB_XGEN(b.x)]) == gen, bar);
            __builtin_amdgcn_fence(__ATOMIC_ACQUIRE, "agent");
            asm volatile("s_waitcnt vmcnt(0)" ::: "memory");
        }
    }
    __syncthreads();
}

namespace pg8 {
constexpr int BM = 256, BK = 64, HALF = 128, HTB = HALF * BK * 2  , STAGE_BYTES = 8 * HTB, NXCD = 8, WGM = 8;

__host__ __device__ __forceinline__ int lds_byte(int r, int c) { const int st = (r >> 4) * 2 + (c >> 5), rr = r & 15, cc = c & 31, ob = rr * 64 + cc * 2; return st * 1024 + (ob ^ (((ob >> 9) & 1) << 5)); }
__host__ __device__ __forceinline__ void stage_rc(int b, int& R, int& C) { const int st = b / 1024, sb = b % 1024, swz = sb ^ (((sb >> 9) & 1) << 5); R = (st >> 1) * 16 + swz / 64; C = (st & 1) * 32 + (swz % 64) / 2; }
__host__ __device__ __forceinline__ int perm32(int rho) { const int n = rho >> 4, i = rho & 15; return 8 * (i >> 2) + 4 * n + (i & 3); }

struct Unit { int pm, pn; };
struct Gemm { const f16* A; const f16* Bt; int M, N, K; };

struct StaticOrder {
    int nM, nN, nwg, G, c;
    __host__ __device__ void init(int M, int N, int G_, int c_) { nM = M / BM; nN = N / BM; nwg = nM * nN; G = G_; c = c_; }
    __host__ __device__ bool next(int i, Unit& u) const {
        const long L = (long)i * G + c; if (L >= nwg) return false;
        int wgid = (int)L; { const int q = nwg / NXCD, r = nwg % NXCD, xcd = wgid % NXCD, off = wgid / NXCD; wgid = (xcd < r ? xcd * (q + 1) : r * (q + 1) + (xcd - r) * q) + off; }
        const int nig = WGM * nN, gid = wgid / nig, fm = gid * WGM, gsz = (nM - fm) < WGM ? (nM - fm) : WGM;
        u.pm = fm + ((wgid % nig) % gsz); u.pn = (wgid % nig) / gsz; return true;
    }
    __device__ __forceinline__ void a_ready(const Unit&) const {}
    __device__ __forceinline__ void done(const Unit&) const {}
};

template <int ACT  > struct EpiF16 {
    static constexpr bool PERM = true, AFTER_DRAIN = false;
    f16* O; int ldc;
    __device__ __forceinline__ void operator()(const f32x4 (&acc)[2][2][4][2], const Unit& u, int wr, int wc, int fr, int fq) const {
        const int row0 = u.pm * BM + wr * 64 + fr; const int col0 = u.pn * BM + wc * 32 + 8 * fq;
#pragma unroll
        for (int ai = 0; ai < 2; ++ai)
#pragma unroll
            for (int m = 0; m < 4; ++m) { f16* rowp = O + (size_t)(row0 + ai * HALF + m * 16) * ldc + col0;
#pragma unroll
                for (int bj = 0; bj < 2; ++bj) { f32x4 v0 = acc[ai][bj][m][0], v1 = acc[ai][bj][m][1];
                    if (ACT == 1) {
#pragma unroll
                        for (int e = 0; e < 4; ++e) { const float a = fmaxf(v0[e], 0.f), b = fmaxf(v1[e], 0.f); v0[e] = a * a; v1[e] = b * b; } }
                    f16x8 w; w[0] = (f16)v0[0]; w[1] = (f16)v0[1]; w[2] = (f16)v0[2]; w[3] = (f16)v0[3]; w[4] = (f16)v1[0]; w[5] = (f16)v1[1]; w[6] = (f16)v1[2]; w[7] = (f16)v1[3];
                    *(f16x8*)(rowp + bj * HALF) = w; } }
    }
};
struct EpiResid {
    static constexpr bool PERM = false, AFTER_DRAIN = false;
    const float* base; float* out; const float* gate;
    __device__ __forceinline__ void operator()(const f32x4 (&acc)[2][2][4][2], const Unit& u, int wr, int wc, int fr, int fq) const {
        const int row0 = u.pm * BM + wr * 64 + fr; const int col0 = u.pn * BM + wc * 32 + 4 * fq;
        const float* gp = gate + (size_t)((u.pm * BM) >> 11) * 6144 + col0;
        f32x4 gv[2][2];
#pragma unroll
        for (int bj = 0; bj < 2; ++bj)
#pragma unroll
            for (int n = 0; n < 2; ++n) gv[bj][n] = *(const f32x4*)(gp + bj * HALF + 16 * n);
#pragma unroll
        for (int ai = 0; ai < 2; ++ai)
#pragma unroll
            for (int m = 0; m < 4; ++m) { const size_t ro = (size_t)(row0 + ai * HALF + m * 16) * DM + col0;
#pragma unroll
                for (int bj = 0; bj < 2; ++bj)
#pragma unroll
                    for (int n = 0; n < 2; ++n) { const f32x4 x = *(const f32x4*)(base + ro + bj * HALF + 16 * n);
                        *(f32x4*)(out + ro + bj * HALF + 16 * n) = x + gv[bj][n] * acc[ai][bj][m][n]; } }
    }
};

template <class Epi, class Sched>
__device__ __forceinline__ void gemm_phase(LAS unsigned char* lds, const Gemm g, const Sched& S, const Epi& E) {
    const int tid = ltid(), wid = __builtin_amdgcn_readfirstlane(tid >> 6), lane = tid & 63, wr = wid >> 2, wc = wid & 3, fr = lane & 15, fq = lane >> 4;
    const int K = g.K, nt = K / BK;
    unsigned voffA[2], voffB[2];
#pragma unroll
    for (int i = 0; i < 2; ++i) { int R, C; stage_rc(tid * 16 + i * 8192, R, C); const int Rb = Epi::PERM ? ((R & ~31) + perm32(R & 31)) : R;
        voffA[i] = (unsigned)(R * K + C) * 2u; voffB[i] = (unsigned)(Rb * K + C) * 2u; }
    const size_t kstep = (size_t)(BK * 2);
    const size_t hstep = (size_t)HALF * K * 2;
    const size_t tstep = 2 * hstep;
    const unsigned ldsw = (unsigned)wid * 1024u;
    const int aoff = lds_byte(wr * 64 + fr, fq * 8), boff = lds_byte(wc * 32 + fr, fq * 8);
#define PG8_SA(b, h) (((b) * 2 + (h)) * HTB)
#define PG8_SB(b, h) ((4 + (b) * 2 + (h)) * HTB)
#define PG8_STAGE(bufoff, gbase, voff) do { _Pragma("unroll") for (int _i = 0; _i < 2; ++_i) \
        __builtin_amdgcn_global_load_lds((const unsigned*)((const char*)(gbase) + (voff)[_i]), (LAS unsigned*)(lds + (bufoff) + ldsw + _i * 8192), 16, 0, 0); } while (0)
#define PG8_LDA(dst, b, h) do { _Pragma("unroll") for (int m = 0; m < 4; ++m) _Pragma("unroll") for (int k = 0; k < 2; ++k) dst[m][k] = *(const LAS f16x8*)(lds + PG8_SA(b, h) + aoff + m * 2048 + k * 1024); } while (0)
#define PG8_LDB(dst, b, h) do { _Pragma("unroll") for (int n = 0; n < 2; ++n) _Pragma("unroll") for (int k = 0; k < 2; ++k) dst[n][k] = *(const LAS f16x8*)(lds + PG8_SB(b, h) + boff + n * 2048 + k * 1024); } while (0)
#define PG8_MMA(ai, bj, At, Bt) do { __builtin_amdgcn_s_setprio(1); _Pragma("unroll") for (int m = 0; m < 4; ++m) _Pragma("unroll") for (int n = 0; n < 2; ++n) _Pragma("unroll") for (int k = 0; k < 2; ++k) \
        acc[ai][bj][m][n] = __builtin_amdgcn_mfma_f32_16x16x32_f16(Bt[n][k], At[m][k], acc[ai][bj][m][n], 0, 0, 0); __builtin_amdgcn_s_setprio(0); } while (0)
#define PG8_WAIT_V(n) asm volatile("s_waitcnt vmcnt(" #n ")" ::: "memory")
#define PG8_WAIT_L(n) asm volatile("s_waitcnt lgkmcnt(" #n ")" ::: "memory")
#define PG8_BAR __builtin_amdgcn_s_barrier()
#define PG8_SCHED __builtin_amdgcn_sched_barrier(0)
    Unit cur, nxt; int ui = 0;
    if (!S.next(0, cur)) return;
    f32x4 acc[2][2][4][2];
#pragma unroll
    for (int a = 0; a < 2; ++a)
#pragma unroll
        for (int b = 0; b < 2; ++b)
#pragma unroll
            for (int m = 0; m < 4; ++m)
#pragma unroll
                for (int n = 0; n < 2; ++n) acc[a][b][m][n] = (f32x4){0.f, 0.f, 0.f, 0.f};
    f16x8 At[4][2], B0[2][2], B1[2][2];
    const char* cA = (const char*)g.A + (size_t)cur.pm * tstep; const char* cB = (const char*)g.Bt + (size_t)cur.pn * tstep;
    S.a_ready(cur);
    PG8_STAGE(PG8_SB(0, 0), cB, voffB); PG8_STAGE(PG8_SB(0, 1), cB + hstep, voffB); PG8_STAGE(PG8_SA(0, 0), cA, voffA); PG8_STAGE(PG8_SA(0, 1), cA + hstep, voffA);
    if (wr == 1) PG8_BAR;
    PG8_WAIT_V(2); PG8_BAR;
    PG8_STAGE(PG8_SB(1, 0), cB + kstep, voffB); PG8_STAGE(PG8_SA(1, 0), cA + kstep, voffA); PG8_STAGE(PG8_SB(1, 1), cB + hstep + kstep, voffB);
    PG8_WAIT_V(6); PG8_BAR;
    for (;;) {
        const bool has_next = S.next(ui + 1, nxt);
        const char* nA = has_next ? (const char*)g.A + (size_t)nxt.pm * tstep : cA; const char* nB = has_next ? (const char*)g.Bt + (size_t)nxt.pn * tstep : cB;
        for (int t = 0; t < nt; t += 2) {
            const bool last = (t == nt - 2);
            const char* a1 = cA + (size_t)(t + 1) * kstep;
            const char* a2 = last ? nA : cA + (size_t)(t + 2) * kstep; const char* b2 = last ? nB : cB + (size_t)(t + 2) * kstep;
            const char* a3 = a2 + kstep; const char* b3 = b2 + kstep;
            if (last && has_next) S.a_ready(nxt);
            PG8_LDB(B0, 0, 0); PG8_LDB(B1, 0, 1); PG8_SCHED; PG8_LDA(At, 0, 0); PG8_STAGE(PG8_SA(1, 1), a1 + hstep, voffA);
            PG8_WAIT_V(8); PG8_WAIT_L(0); PG8_BAR; PG8_MMA(0, 0, At, B0); PG8_MMA(0, 1, At, B1); PG8_BAR; PG8_SCHED;
            PG8_LDA(At, 0, 1); PG8_STAGE(PG8_SB(0, 0), b2, voffB); PG8_STAGE(PG8_SB(0, 1), b2 + hstep, voffB); PG8_STAGE(PG8_SA(0, 0), a2, voffA);
            PG8_WAIT_V(8); PG8_WAIT_L(0); PG8_BAR; PG8_MMA(1, 0, At, B0); PG8_MMA(1, 1, At, B1); PG8_BAR; PG8_SCHED;
            PG8_LDB(B0, 1, 0); PG8_LDB(B1, 1, 1); PG8_SCHED; PG8_LDA(At, 1, 0); PG8_STAGE(PG8_SA(0, 1), a2 + hstep, voffA);
            PG8_WAIT_V(8); PG8_WAIT_L(0); PG8_BAR; PG8_MMA(0, 0, At, B0); PG8_MMA(0, 1, At, B1); PG8_BAR; PG8_SCHED;
            PG8_LDA(At, 1, 1); PG8_STAGE(PG8_SB(1, 0), b3, voffB); PG8_STAGE(PG8_SB(1, 1), b3 + hstep, voffB); PG8_STAGE(PG8_SA(1, 0), a3, voffA);
            PG8_WAIT_V(8); PG8_WAIT_L(0); PG8_BAR; PG8_MMA(1, 0, At, B0); PG8_MMA(1, 1, At, B1); PG8_BAR; PG8_SCHED;
        }
        if (wr == 0) PG8_BAR;
        E(acc, cur, wr, wc, fr, fq); S.done(cur);
        if (!has_next) break;
#pragma unroll
        for (int a = 0; a < 2; ++a)
#pragma unroll
            for (int b = 0; b < 2; ++b)
#pragma unroll
                for (int m = 0; m < 4; ++m)
#pragma unroll
                    for (int n = 0; n < 2; ++n) acc[a][b][m][n] = (f32x4){0.f, 0.f, 0.f, 0.f};
        cur = nxt; cA = nA; cB = nB; ++ui;
        if (wr == 1) PG8_BAR;
    }
    PG8_WAIT_V(0);
    PG8_BAR;
#undef PG8_SA
#undef PG8_SB
#undef PG8_STAGE
#undef PG8_LDA
#undef PG8_LDB
#undef PG8_MMA
#undef PG8_WAIT_V
#undef PG8_WAIT_L
#undef PG8_BAR
#undef PG8_SCHED
}
}
struct Ptrs {
    const float *x, *c, *w_mod, *b_mod, *g_attn, *w_in, *kv_norm_g, *w_uv, *g_out_a, *g_out_b, *w_out, *g_mlp, *w_up, *w_down, *rel_bias, *g_final;
    float* out; unsigned char* ws;
};

__device__ __forceinline__ void conv_tile(float* T  , const float* src, int N, int K, int Nvalid, const float* ks0, const float* ks1, f16* dst, int tn, int tk) {
    const int tid = ltid();
#pragma unroll
    for (int i = 0; i < 8; ++i) {
        const int kk = (tid >> 6) + 8 * i, k = tk * 64 + kk, n = tn * 64 + (tid & 63);
        float v = (n < Nvalid) ? src[(size_t)k * N + n] : 0.f;
        if (ks0) v *= (k < 512 ? ks0[k] : ks1[k - 512]);
        T[kk * 65 + (tid & 63)] = v;
    }
    __syncthreads();
    { const int nn = tid >> 3, kc = (tid & 7) * 8; f16x8 o;
#pragma unroll
      for (int e = 0; e < 8; ++e) o[e] = (f16)T[(kc + e) * 65 + nn];
      *(f16x8*)(dst + (size_t)(tn * 64 + nn) * K + tk * 64 + kc) = o; }
    __syncthreads();
}

__device__ __forceinline__ int t5_bucket_dev(int rel) {
    const int n = rel < 0 ? -rel : rel; int bk;
    if (n < 8) bk = n; else if (n < 12) bk = 8; else if (n < 16) bk = 9; else if (n < 23) bk = 10; else if (n < 32) bk = 11; else if (n < 46) bk = 12; else if (n < 64) bk = 13; else if (n < 91) bk = 14; else bk = 15;
    return (rel > 0 ? 16 : 0) + bk;
}

__device__ __forceinline__ void prologue_phase(unsigned char* lds, const Ptrs& P, int G, int wg) {
    const int tid = ltid(), lane = tid & 63, wv = tid >> 6;
    unsigned char* ws = P.ws;
    float* T = (float*)lds;
    constexpr int T_IN = 52 * 16, T_OUT = 16 * 16, T_UP = 64 * 16, T_DN = 16 * 64, T_UV = 16, T_L = T_IN + T_OUT + T_UP + T_DN + T_UV;
    for (int u = wg; u < 2 * T_L; u += G) {
        const int l = u / T_L; int r = u % T_L;
        if (r < T_IN) { conv_tile(T, P.w_in + (size_t)l * DM * NPJ_VALID, NPJ_VALID, DM, NPJ_VALID, nullptr, nullptr, (f16*)(ws + WS_WIN) + (size_t)l * NPJ * DM, r / 16, r % 16); continue; }
        r -= T_IN;
        if (r < T_OUT) { conv_tile(T, P.w_out + (size_t)l * DM * DM, DM, DM, DM, P.g_out_a + l * 512, P.g_out_b + l * 512, (f16*)(ws + WS_WOUT) + (size_t)l * DM * DM, r / 16, r % 16); continue; }
        r -= T_OUT;
        if (r < T_UP) { conv_tile(T, P.w_up + (size_t)l * DM * FF, FF, DM, FF, nullptr, nullptr, (f16*)(ws + WS_WUP) + (size_t)l * FF * DM, r / 16, r % 16); continue; }
        r -= T_UP;
        if (r < T_DN) { conv_tile(T, P.w_down + (size_t)l * FF * DM, DM, FF, DM, nullptr, nullptr, (f16*)(ws + WS_WDN) + (size_t)l * DM * FF, r / 64, r % 64); continue; }
        r -= T_DN;
        { const int h = r >> 1; conv_tile(T, P.w_uv + ((size_t)l * 8 + h) * 128 * 64, 64, 128, 64, nullptr, nullptr, (f16*)(ws + WS_WUV) + ((size_t)l * 8 + h) * 64 * 128, 0, r & 1); }
    }
    if (wg == G - 1) {
        float* BT = (float*)(ws + WS_BIAS);
        for (int i = tid; i < 8 * 2112; i += NTHR) { const int h = i / 2112, idx = i % 2112; const int bk = t5_bucket_dev(idx - 2047);
            BT[i] = (P.rel_bias[bk * 8 + h] - P.rel_bias[15 * 8 + h]) * LOG2E; }
    }
    __syncthreads();
    if (wg < 192) {
        float* SC = (float*)lds;
        float* RED = (float*)(lds + 65536);
        for (int i = tid; i < 16 * 1024; i += NTHR) { const int b = i >> 10, k = i & 1023; const float cv = P.c[i]; SC[k * 16 + b] = cv / (1.f + __expf(-cv)); }
        __syncthreads();
        for (int u = wg; u < 192; u += G) {
            const int l = u / 96, cb = u % 96, col = cb * 64 + lane;
            const float* wp = P.w_mod + (size_t)l * DM * 6144 + col;
            float acc[16];
#pragma unroll
            for (int b = 0; b < 16; ++b) acc[b] = 0.f;
            for (int k = wv * 128; k < wv * 128 + 128; ++k) {
                const float w = wp[(size_t)k * 6144];
                const f32x4 s0 = *(const f32x4*)(SC + k * 16), s1 = *(const f32x4*)(SC + k * 16 + 4), s2 = *(const f32x4*)(SC + k * 16 + 8), s3 = *(const f32x4*)(SC + k * 16 + 12);
#pragma unroll
                for (int e = 0; e < 4; ++e) { acc[e] += s0[e] * w; acc[4 + e] += s1[e] * w; acc[8 + e] += s2[e] * w; acc[12 + e] += s3[e] * w; }
            }
#pragma unroll
            for (int b = 0; b < 16; ++b) RED[(wv * 16 + b) * 64 + lane] = acc[b];
            __syncthreads();
            for (int i = tid; i < 1024; i += NTHR) { const int b = i >> 6, cc = i & 63; float s = P.b_mod[l * 6144 + cb * 64 + cc];
#pragma unroll
                for (int w8 = 0; w8 < 8; ++w8) s += RED[(w8 * 16 + b) * 64 + cc];
                ((float*)(ws + WS_MOD))[((size_t)l * 16 + b) * 6144 + cb * 64 + cc] = s; }
            __syncthreads();
        }
    }
}

__device__ __forceinline__ void norm_mod_phase(const float* x, const float* gain, const float* sh, const float* sc, f16* H, int G, int wg) {
    const int tid_ = ltid(); const int lane = tid_ & 63, wv = tid_ >> 6;
    for (int row = wg * NWAVES + wv; row < MT; row += G * NWAVES) {
        const int b = row >> 11; const float* xp = x + (size_t)row * DM + lane * 4;
        f32x4 v[4]; float ss = 0.f;
#pragma unroll
        for (int i = 0; i < 4; ++i) { v[i] = *(const f32x4*)(xp + i * 256); ss += v[i][0] * v[i][0] + v[i][1] * v[i][1] + v[i][2] * v[i][2] + v[i][3] * v[i][3]; }
        ss = wave_sum(ss);
        const float rstd = rsqrtf(ss * (1.0f / DM) + EPS);
#pragma unroll
        for (int i = 0; i < 4; ++i) { const int col = i * 256 + lane * 4;
            const f32x4 g4 = *(const f32x4*)(gain + col), s4 = *(const f32x4*)(sc + (size_t)b * 6144 + col), h4 = *(const f32x4*)(sh + (size_t)b * 6144 + col);
            f16x4 o;
#pragma unroll
            for (int e = 0; e < 4; ++e) o[e] = (f16)((v[i][e] * rstd * g4[e]) * (1.f + s4[e]) + h4[e]);
            *(f16x4*)(H + (size_t)row * DM + col) = o; }
    }
}

__device__ __forceinline__ void final_norm_phase(const float* x, const float* gain, float* out, int G, int wg) {
    const int tid_ = ltid(); const int lane = tid_ & 63, wv = tid_ >> 6;
    for (int row = wg * NWAVES + wv; row < MT; row += G * NWAVES) {
        const float* xp = x + (size_t)row * DM + lane * 4;
        f32x4 v[4]; float ss = 0.f;
#pragma unroll
        for (int i = 0; i < 4; ++i) { v[i] = *(const f32x4*)(xp + i * 256); ss += v[i][0] * v[i][0] + v[i][1] * v[i][1] + v[i][2] * v[i][2] + v[i][3] * v[i][3]; }
        ss = wave_sum(ss);
        const float rstd = rsqrtf(ss * (1.0f / DM) + EPS);
#pragma unroll
        for (int i = 0; i < 4; ++i) { const int col = i * 256 + lane * 4; const f32x4 g4 = *(const f32x4*)(gain + col);
            *(f32x4*)(out + (size_t)row * DM + col) = v[i] * rstd * g4; }
    }
}

__device__ __forceinline__ void onorm_phase(f16* O, int G, int wg) {
    const int tid_ = ltid(); const int lane = tid_ & 63, wv = tid_ >> 6;
    for (int row = wg * NWAVES + wv; row < MT; row += G * NWAVES) {
        f16* p = O + (size_t)row * DM + lane * 16;
        f16x8 a = *(const f16x8*)p, b = *(const f16x8*)(p + 8); float ss = 0.f;
#pragma unroll
        for (int e = 0; e < 8; ++e) { const float x = (float)a[e], y = (float)b[e]; ss += x * x + y * y; }
        ss = half_sum(ss);
        const float rstd = rsqrtf(ss * (1.0f / 512.f) + EPS);
#pragma unroll
        for (int e = 0; e < 8; ++e) { a[e] = (f16)((float)a[e] * rstd); b[e] = (f16)((float)b[e] * rstd); }
        *(f16x8*)p = a; *(f16x8*)(p + 8) = b;
    }
}

__device__ __forceinline__ void kvnorm_phase(unsigned char* lds, const f16* PROJ, const float* g, f16* KV, f16* KVT, int G, int wg) {
    const int tid = ltid();
    f16* T = (f16*)lds;
    for (int blk = wg; blk < MT / 64; blk += G) {
        const int tok = tid >> 3, ch = tid & 7; const size_t row = (size_t)blk * 64 + tok;
        const f16* p = PROJ + row * NPJ + C_DKV + ch * 16;
        const f16x8 a = *(const f16x8*)p, b = *(const f16x8*)(p + 8);
        float va[8], vb[8]; float ss = 0.f;
#pragma unroll
        for (int e = 0; e < 8; ++e) { va[e] = (float)a[e]; vb[e] = (float)b[e]; ss += va[e] * va[e] + vb[e] * vb[e]; }
        ss += __shfl_xor(ss, 4); ss += __shfl_xor(ss, 2); ss += __shfl_xor(ss, 1);
        const float rstd = rsqrtf(ss * (1.0f / 128.f) + EPS);
        f16x8 oa, ob;
#pragma unroll
        for (int e = 0; e < 8; ++e) { oa[e] = (f16)(va[e] * rstd * g[ch * 16 + e]); ob[e] = (f16)(vb[e] * rstd * g[ch * 16 + 8 + e]); }
        *(f16x8*)(KV + row * 128 + ch * 16) = oa; *(f16x8*)(KV + row * 128 + ch * 16 + 8) = ob;
#pragma unroll
        for (int e = 0; e < 8; ++e) { T[(ch * 16 + e) * 72 + tok] = oa[e]; T[(ch * 16 + 8 + e) * 72 + tok] = ob[e]; }
        __syncthreads();
        { const int dim = tid >> 2, tc = (tid & 3) * 16; const int bb = (blk * 64) >> 11, t0 = (blk * 64) & 2047;
          const f16x8 x0 = *(const f16x8*)(T + dim * 72 + tc), x1 = *(const f16x8*)(T + dim * 72 + tc + 8);
          f16* q = KVT + ((size_t)bb * 128 + dim) * SEQ + t0 + tc;
          *(f16x8*)q = x0; *(f16x8*)(q + 8) = x1; }
        __syncthreads();
    }
}
__device__ __forceinline__ void sb_attn_phase(unsigned char* lds, const f16* PROJ, f16* OBUF, int G, int wg) {
    const int tid = ltid(), lane = tid & 63, wv = tid >> 6, l32 = lane & 31, hh = lane >> 5;
    f16* Kt = (f16*)lds;
    f16* Vt = (f16*)(lds + 9216);
    volatile LAS int* flags = (volatile LAS int*)(lds + 18432);
    const int srow = tid >> 3, sch = tid & 7;
    for (int u = wg; u < 1024; u += G) {
        const int bh = u & 127, tt = u >> 7;
        const int qb = (tt & 1) ? ((tt == 1) ? 5 : (tt == 3) ? 2 : (tt == 5) ? 4 : 3) : ((tt == 0) ? 7 : (tt == 2) ? 0 : (tt == 4) ? 6 : 1);
        const int b = bh >> 3, h = bh & 7;
        const size_t rowbase = (size_t)b * SEQ;
        const int r0 = qb * 256 + wv * 32;
        f16x8 qf[4];
        { const f16* qp = PROJ + (rowbase + r0 + l32) * NPJ + C_SBQ + h * 64 + hh * 8;
#pragma unroll
          for (int s = 0; s < 4; ++s) qf[s] = *(const f16x8*)(qp + 16 * s); }
        f32x16 accO[2];
#pragma unroll
        for (int d = 0; d < 2; ++d)
#pragma unroll
            for (int r = 0; r < 16; ++r) accO[d][r] = 0.f;
        float C = 1.0f;
        const int kt_hi = qb * 4 + 3, kt_w = qb * 4 + (wv >> 1);
        const f16* kp = PROJ + (rowbase + srow) * NPJ + C_SBK + h * 64 + sch * 8;
        const f16* vp = PROJ + (rowbase + srow) * NPJ + C_SBV + h * 64 + sch * 8;
        f16x8 kreg = *(const f16x8*)(kp + (size_t)kt_hi * 64 * NPJ), vreg = *(const f16x8*)(vp + (size_t)kt_hi * 64 * NPJ);
        if (lane == 0) flags[wv] = 1;
        for (int kt = kt_hi; kt >= 0; --kt) {
            __syncthreads();
            { int alive = 0;
#pragma unroll
              for (int w8 = 0; w8 < 8; ++w8) alive |= flags[w8];
              if (!alive) break; }
            *(f16x8*)(Kt + srow * 72 + sch * 8) = kreg;
#pragma unroll
            for (int e = 0; e < 8; ++e) Vt[(sch * 8 + e) * 72 + srow] = vreg[e];
            __syncthreads();
            if (kt > 0) { kreg = *(const f16x8*)(kp + (size_t)(kt - 1) * 64 * NPJ); vreg = *(const f16x8*)(vp + (size_t)(kt - 1) * 64 * NPJ); }
            if (kt <= kt_w) {
                f32x16 S[2];
#pragma unroll
                for (int t = 0; t < 2; ++t) {
#pragma unroll
                    for (int r = 0; r < 16; ++r) S[t][r] = 0.f;
#pragma unroll
                    for (int s = 0; s < 4; ++s) { const f16x8 a = *(const f16x8*)(Kt + (32 * t + l32) * 72 + 16 * s + 8 * hh); S[t] = __builtin_amdgcn_mfma_f32_32x32x16_f16(a, qf[s], S[t], 0, 0, 0); }
                }
                const int q = r0 + l32, kb = kt * 64 + 4 * hh;
                const bool diag = (kt * 64 + 63 >= r0);
                f32x16 om[2];
#pragma unroll
                for (int t = 0; t < 2; ++t)
#pragma unroll
                    for (int r = 0; r < 16; ++r) {
                        const float z = S[t][r] * 0.125f;
                        const float e = __builtin_amdgcn_exp2f(-fabsf(z) * LOG2E);
                        const float rr = __builtin_amdgcn_rcpf(1.0f + e), sm = e * rr;
                        float be = z >= 0.f ? rr : sm, o = z >= 0.f ? sm : rr;
                        if (diag) { const int key = kb + 32 * t + 8 * (r >> 2) + (r & 3); if (key >= q) { be = 0.f; o = 1.0f; } }
                        S[t][r] = be; om[t][r] = o;
                    }
                float R = C;
#pragma unroll
                for (int t = 1; t >= 0; --t)
#pragma unroll
                    for (int g = 3; g >= 0; --g) {
                        const float o0 = om[t][4 * g], o1 = om[t][4 * g + 1], o2 = om[t][4 * g + 2], o3 = om[t][4 * g + 3];
                        const float gown = (o0 * o1) * (o2 * o3);
                        const float gp = __shfl_xor(gown, 32);
                        const float pre = hh ? R : R * gp;
                        const float p3 = pre, p2 = p3 * o3, p1 = p2 * o2, p0 = p1 * o1;
                        S[t][4 * g + 3] *= p3; S[t][4 * g + 2] *= p2; S[t][4 * g + 1] *= p1; S[t][4 * g] *= p0;
                        R = R * gown * gp;
                    }
                C = R;
                f16x8 pf[2][2];
#pragma unroll
                for (int t = 0; t < 2; ++t)
#pragma unroll
                    for (int s = 0; s < 2; ++s)
#pragma unroll
                        for (int e = 0; e < 8; ++e) pf[t][s][e] = (f16)S[t][8 * s + e];
#pragma unroll
                for (int d = 0; d < 2; ++d)
#pragma unroll
                    for (int t = 0; t < 2; ++t)
#pragma unroll
                        for (int s = 0; s < 2; ++s) {
                            const f16* vrow = Vt + (32 * d + l32) * 72 + 32 * t + 16 * s + 4 * hh;
                            const f16x4 lo = *(const f16x4*)vrow, hi = *(const f16x4*)(vrow + 8);
                            f16x8 a; a[0] = lo[0]; a[1] = lo[1]; a[2] = lo[2]; a[3] = lo[3]; a[4] = hi[0]; a[5] = hi[1]; a[6] = hi[2]; a[7] = hi[3];
                            accO[d] = __builtin_amdgcn_mfma_f32_32x32x16_f16(a, pf[t][s], accO[d], 0, 0, 0);
                        }
                const bool anyalive = __ballot(C != 0.f) != 0ull;
                if (lane == 0) flags[wv] = anyalive ? 1 : 0;
            }
        }
        { f16* op = OBUF + (rowbase + r0 + l32) * DM + h * 64 + 4 * hh;
#pragma unroll
          for (int d = 0; d < 2; ++d)
#pragma unroll
            for (int g = 0; g < 4; ++g) { f16x4 o; o[0] = (f16)accO[d][4 * g]; o[1] = (f16)accO[d][4 * g + 1]; o[2] = (f16)accO[d][4 * g + 2]; o[3] = (f16)accO[d][4 * g + 3];
                *(f16x4*)(op + 32 * d + 8 * g) = o; } }
        __syncthreads();
    }
}
constexpr int IDX_PITCH = 2052;
__device__ __forceinline__ void indexer_phase(unsigned char* lds, const f16* PROJ, unsigned* MASK, int G, int wg) {
    const int tid = ltid(), lane = tid & 63, wv = tid >> 6, l16 = lane & 15, lq = lane >> 4;
    float* SCR = (float*)lds;
    for (int u = wg; u < MT / 16; u += G) {
        const int b = u & 15, qg = 127 - (u >> 4);
        const int q0 = qg * 16; const size_t rowbase = (size_t)b * SEQ;
        const int nadm = 64 * ((q0 >> 6) + 1);
        f16x8 qa[8][2];
        { const f16* qp = PROJ + (rowbase + q0 + l16) * NPJ + C_IQ + lq * 8;
#pragma unroll
          for (int hd = 0; hd < 8; ++hd)
#pragma unroll
            for (int s = 0; s < 2; ++s) qa[hd][s] = *(const f16x8*)(qp + hd * 64 + 32 * s); }
        float wq[4][8];
#pragma unroll
        for (int r = 0; r < 4; ++r) { const f16x8 w8 = *(const f16x8*)(PROJ + (rowbase + q0 + 4 * lq + r) * NPJ + C_IW);
#pragma unroll
            for (int hd = 0; hd < 8; ++hd) wq[r][hd] = (float)w8[hd] * (0.35355339059327373f * 0.125f); }
        const int ntile = nadm >> 4;
        for (int nt = wv; nt < ntile; nt += NWAVES) {
            const f16* kp = PROJ + (rowbase + nt * 16 + l16) * NPJ + C_IK + lq * 8;
            const f16x8 kb0 = *(const f16x8*)kp, kb1 = *(const f16x8*)(kp + 32);
            f32x4 sc = {0.f, 0.f, 0.f, 0.f};
#pragma unroll
            for (int hd = 0; hd < 8; ++hd) {
                f32x4 a = {0.f, 0.f, 0.f, 0.f};
                a = __builtin_amdgcn_mfma_f32_16x16x32_f16(qa[hd][0], kb0, a, 0, 0, 0);
                a = __builtin_amdgcn_mfma_f32_16x16x32_f16(qa[hd][1], kb1, a, 0, 0, 0);
#pragma unroll
                for (int r = 0; r < 4; ++r) sc[r] += wq[r][hd] * fmaxf(a[r], 0.f);
            }
#pragma unroll
            for (int r = 0; r < 4; ++r) SCR[(4 * lq + r) * IDX_PITCH + nt * 16 + l16] = sc[r] + 0.0f;
        }
        __syncthreads();
        for (int qs = 0; qs < 2; ++qs) {
            const int qq = 2 * wv + qs;
            unsigned* mrow = MASK + (rowbase + q0 + qq) * 64;
            unsigned word = 0u;
            if (nadm <= 256) {
                word = (lane * 32 < nadm) ? 0xFFFFFFFFu : 0u;
            } else {
                const float* row = SCR + qq * IDX_PITCH;
                unsigned uk[32];
#pragma unroll
                for (int j = 0; j < 32; ++j) {
                    const int key = 64 * j + lane;
                    unsigned bits = 0u;
                    if (key < nadm) { bits = __float_as_uint(row[key]); bits ^= (unsigned)(((int)bits >> 31) | 0x80000000); }
                    uk[j] = bits;
                }
                unsigned T = 0u;
                for (int bit = 31; bit >= 0; --bit) {
                    const unsigned cand = T | (1u << bit);
                    int cnt = 0;
#pragma unroll
                    for (int j = 0; j < 32; ++j) cnt += __popcll(__ballot(uk[j] >= cand));
                    if (cnt >= 256) T = cand;
                }
                int cgt = 0;
#pragma unroll
                for (int j = 0; j < 32; ++j) cgt += __popcll(__ballot(uk[j] > T));
                int need = 256 - cgt;
#pragma unroll
                for (int j = 0; j < 32; ++j) {
                    unsigned long long sel = __ballot(uk[j] > T);
                    unsigned long long em = __ballot(uk[j] == T);
                    if (need > 0 && em != 0ull) {
                        const int pc = __popcll(em);
                        if (pc <= need) { sel |= em; need -= pc; }
                        else { unsigned long long keep = 0ull; for (int i = 0; i < need; ++i) { const unsigned long long lowb = em & (0ull - em); keep |= lowb; em ^= lowb; } sel |= keep; need = 0; }
                    }
                    const unsigned lo = (unsigned)sel, hi = (unsigned)(sel >> 32);
                    word = (lane == 2 * j) ? lo : word; word = (lane == 2 * j + 1) ? hi : word;
                }
            }
            mrow[lane] = word;
        }
        __syncthreads();
    }
}
__device__ __forceinline__ void dsa_attn_phase(unsigned char* lds, const f16* PROJ, const f16* KV, const f16* KVT, const unsigned* MASK, const float* BIAS2, const f16* WUVT, f16* OBUF, int G, int wg) {
    const int tid = ltid(), lane = tid & 63, wv = tid >> 6, l32 = lane & 31, hh = lane >> 5;
    f16* Kl = (f16*)lds;
    f16* Vl = (f16*)(lds + 17408);
    const int hd = wv;
    const float c1 = 0.08838834764831845f * LOG2E;
    for (int u = wg; u < 1024; u += G) {
        int b, qi;
        if (G == 256) { const int j = wg >> 4, i = u >> 8; b = wg & 15; qi = (i == 0) ? 63 - j : (i == 1) ? 32 + j : (i == 2) ? 31 - j : j; }
        else { b = u & 15; qi = 63 - (u >> 4); }
        const int q0 = qi * 32; const size_t rowbase = (size_t)b * SEQ;
        const int ntile = (q0 >> 6) + 1;
        f16x8 qf[8];
        { const f16* qp = PROJ + (rowbase + q0 + l32) * NPJ + C_DQ + hd * 128 + hh * 8;
#pragma unroll
          for (int s = 0; s < 8; ++s) qf[s] = *(const f16x8*)(qp + 16 * s); }
        const unsigned* mrow = MASK + (rowbase + q0 + l32) * 64;
        const int q = q0 + l32;
        f32x16 accO[4];
#pragma unroll
        for (int d = 0; d < 4; ++d)
#pragma unroll
            for (int r = 0; r < 16; ++r) accO[d][r] = 0.f;
        float mrun = -1e30f, lsum = 0.f;
        const int skey = tid >> 3, skc = (tid & 7) * 16, sdim = tid >> 2, sdc = (tid & 3) * 16;
        const f16* kvp = KV + (rowbase + skey) * 128 + skc;
        const f16* ktp = KVT + ((size_t)b * 128 + sdim) * SEQ + sdc;
        f16x8 k0 = *(const f16x8*)kvp, k1 = *(const f16x8*)(kvp + 8), t0 = *(const f16x8*)ktp, t1 = *(const f16x8*)(ktp + 8);
        for (int kt = 0; kt < ntile; ++kt) {
            __syncthreads();
            *(f16x8*)(Kl + skey * 136 + skc) = k0; *(f16x8*)(Kl + skey * 136 + skc + 8) = k1;
            *(f16x8*)(Vl + sdim * 72 + sdc) = t0; *(f16x8*)(Vl + sdim * 72 + sdc + 8) = t1;
            __syncthreads();
            if (kt + 1 < ntile) { const f16* a = kvp + (size_t)(kt + 1) * 64 * 128; const f16* c = ktp + (kt + 1) * 64;
                k0 = *(const f16x8*)a; k1 = *(const f16x8*)(a + 8); t0 = *(const f16x8*)c; t1 = *(const f16x8*)(c + 8); }
            const u32x2 mw = *(const u32x2*)(mrow + 2 * kt);
            f32x16 S[2];
#pragma unroll
            for (int t = 0; t < 2; ++t) {
#pragma unroll
                for (int r = 0; r < 16; ++r) S[t][r] = 0.f;
#pragma unroll
                for (int s = 0; s < 8; ++s) { const f16x8 a = *(const f16x8*)(Kl + (32 * t + l32) * 136 + 16 * s + 8 * hh); S[t] = __builtin_amdgcn_mfma_f32_32x32x16_f16(a, qf[s], S[t], 0, 0, 0); }
            }
            const bool near = (kt * 64 + 63 + 96 > q0);
            const float* bp = BIAS2 + hd * 2112 + 2047 - q + kt * 64 + 4 * hh;
            float tmax = -1e30f;
#pragma unroll
            for (int t = 0; t < 2; ++t) {
                const unsigned wsh = (t == 0 ? mw[0] : mw[1]) >> (4 * hh);
#pragma unroll
                for (int r = 0; r < 16; ++r) {
                    const int ko = 8 * (r >> 2) + (r & 3);
                    float x = S[t][r] * c1;
                    if (near) x += bp[32 * t + ko];
                    x = ((wsh >> ko) & 1u) ? x : -1e30f;
                    S[t][r] = x; tmax = fmaxf(tmax, x);
                }
            }
            tmax = fmaxf(tmax, __shfl_xor(tmax, 32));
            const float mnew = fmaxf(mrun, tmax);
            const float alpha = __builtin_amdgcn_exp2f(mrun - mnew);
            mrun = mnew;
            float ps = 0.f;
#pragma unroll
            for (int t = 0; t < 2; ++t)
#pragma unroll
                for (int r = 0; r < 16; ++r) { const float x = S[t][r]; const float p = (x > -1e29f) ? __builtin_amdgcn_exp2f(x - mnew) : 0.f; S[t][r] = p; ps += p; }
            lsum = lsum * alpha + ps;
#pragma unroll
            for (int d = 0; d < 4; ++d)
#pragma unroll
                for (int r = 0; r < 16; ++r) accO[d][r] *= alpha;
            f16x8 pf[2][2];
#pragma unroll
            for (int t = 0; t < 2; ++t)
#pragma unroll
                for (int s = 0; s < 2; ++s)
#pragma unroll
                    for (int e = 0; e < 8; ++e) pf[t][s][e] = (f16)S[t][8 * s + e];
#pragma unroll
            for (int d = 0; d < 4; ++d)
#pragma unroll
                for (int t = 0; t < 2; ++t)
#pragma unroll
                    for (int s = 0; s < 2; ++s) {
                        const f16* vrow = Vl + (32 * d + l32) * 72 + 32 * t + 16 * s + 4 * hh;
                        const f16x4 lo = *(const f16x4*)vrow, hi = *(const f16x4*)(vrow + 8);
                        f16x8 a; a[0] = lo[0]; a[1] = lo[1]; a[2] = lo[2]; a[3] = lo[3]; a[4] = hi[0]; a[5] = hi[1]; a[6] = hi[2]; a[7] = hi[3];
                        accO[d] = __builtin_amdgcn_mfma_f32_32x32x16_f16(a, pf[t][s], accO[d], 0, 0, 0);
                    }
        }
        const float ltot = lsum + __shfl_xor(lsum, 32);
        const float inv = 1.0f / ltot;
        f32x16 Z[2];
#pragma unroll
        for (int n = 0; n < 2; ++n)
#pragma unroll
            for (int r = 0; r < 16; ++r) Z[n][r] = 0.f;
#pragma unroll
        for (int d = 0; d < 4; ++d)
#pragma unroll
            for (int s = 0; s < 2; ++s) {
                f16x8 a;
#pragma unroll
                for (int e = 0; e < 8; ++e) a[e] = (f16)(accO[d][8 * s + e] * inv);
#pragma unroll
                for (int n = 0; n < 2; ++n) {
                    const f16* wp = WUVT + ((size_t)hd * 64 + 32 * n + l32) * 128 + 32 * d + 16 * s + 4 * hh;
                    const f16x4 lo = *(const f16x4*)wp, hi = *(const f16x4*)(wp + 8);
                    f16x8 bb; bb[0] = lo[0]; bb[1] = lo[1]; bb[2] = lo[2]; bb[3] = lo[3]; bb[4] = hi[0]; bb[5] = hi[1]; bb[6] = hi[2]; bb[7] = hi[3];
                    Z[n] = __builtin_amdgcn_mfma_f32_32x32x16_f16(a, bb, Z[n], 0, 0, 0);
                }
            }
        { f16* op = OBUF + (rowbase + q0) * DM + 512 + hd * 64 + l32;
#pragma unroll
          for (int n = 0; n < 2; ++n)
#pragma unroll
            for (int r = 0; r < 16; ++r) op[(size_t)(8 * (r >> 2) + 4 * hh + (r & 3)) * DM + 32 * n] = (f16)Z[n][r]; }
    }
}
constexpr int N_PHASES = 20;
struct Args { Ptrs p; int ph_lo, ph_hi; };

__global__ void __launch_bounds__(NTHR, 2) trunk_fwd(Args args) {
    extern __shared__ __attribute__((aligned(16))) unsigned char lds[];
    const Ptrs& P = args.p;
    unsigned char* ws = P.ws;
    const int G = gridDim.x, wg = blockIdx.x, tid = threadIdx.x;
    const int lo = args.ph_lo, hi = args.ph_hi;
    const bool multi = (hi - lo) > 1;
    XcdBarrier bar; bar.bar = (unsigned*)(ws + WS_CTL); bar.x = 0; bar.st = nullptr;
    if (multi) {
        if (tid < 4) ((LAS unsigned*)(lds + LDS_MISC))[tid] = 0u;
        __syncthreads();
        bar = xcd_barrier_post((unsigned*)(ws + WS_CTL), (volatile LAS unsigned*)(lds + LDS_MISC));
    }
#ifndef PHMASK
#define PHMASK 0xFFFFF
#endif
#define IN(k) (lo <= (k) && (k) < hi)
#define PM(j) ((PHMASK >> (j)) & 1)
#define SEAM(k) do { if (IN(k) && IN((k) + 1)) xcd_barrier(bar); } while (0)
    float* MOD = (float*)(ws + WS_MOD);
    f16* H = (f16*)(ws + WS_H); f16* PROJ = (f16*)(ws + WS_PROJ); f16* OBUF = (f16*)(ws + WS_OBUF); f16* HID = (f16*)(ws + WS_HID);
    f16* KV = (f16*)(ws + WS_KV); f16* KVT = (f16*)(ws + WS_KVT); unsigned* MASK = (unsigned*)(ws + WS_MASK);
    float* X = P.out;

    if (PM(0) && IN(0)) { prologue_phase(lds, P, G, wg); SEAM(0); }

    for (int l = 0; l < NLAYER; ++l) {
        const int pb = 1 + 9 * l;
        const float* modl = MOD + (size_t)l * 16 * 6144;
        const float* xin = (l == 0) ? P.x : X;
        if (PM(1) && IN(pb + 0)) { norm_mod_phase(xin, P.g_attn + l * DM, modl + 0 * DM, modl + 1 * DM, H, G, wg); SEAM(pb + 0); }
        if (PM(2) && IN(pb + 1)) {
            pg8::Gemm g{H, (const f16*)(ws + WS_WIN) + (size_t)l * NPJ * DM, MT, NPJ, DM}; pg8::StaticOrder S; S.init(MT, NPJ, G, wg);
            pg8::EpiF16<0> E{PROJ, NPJ};
            pg8::gemm_phase<pg8::EpiF16<0>, pg8::StaticOrder>((LAS unsigned char*)lds, g, S, E);
            SEAM(pb + 1);
        }
        if (PM(3) && IN(pb + 2)) {
#if ENABLE_DSA
            kvnorm_phase(lds, PROJ, P.kv_norm_g + l * 128, KV, KVT, G, wg);
            __syncthreads();
            indexer_phase(lds, PROJ, MASK, G, wg);
            __syncthreads();
#endif
#if ENABLE_SB
            sb_attn_phase(lds, PROJ, OBUF, G, wg);
#else
            for (size_t i = (size_t)wg * NTHR + tid; i < (size_t)MT * 64; i += (size_t)G * NTHR) { const size_t row = i >> 6, c8 = i & 63; *(f16x8*)(OBUF + row * DM + c8 * 8) = (f16x8){0, 0, 0, 0, 0, 0, 0, 0}; }
#endif
            SEAM(pb + 2);
        }
        if (PM(4) && IN(pb + 3)) {
#if ENABLE_DSA
            dsa_attn_phase(lds, PROJ, KV, KVT, MASK, (const float*)(ws + WS_BIAS), (const f16*)(ws + WS_WUV) + (size_t)l * 8 * 64 * 128, OBUF, G, wg);
#else
            for (size_t i = (size_t)wg * NTHR + tid; i < (size_t)MT * 64; i += (size_t)G * NTHR) { const size_t row = i >> 6, c8 = i & 63; *(f16x8*)(OBUF + row * DM + 512 + c8 * 8) = (f16x8){0, 0, 0, 0, 0, 0, 0, 0}; }
#endif
            SEAM(pb + 3);
        }
        if (PM(5) && IN(pb + 4)) { onorm_phase(OBUF, G, wg); SEAM(pb + 4); }
        if (PM(6) && IN(pb + 5)) {
            pg8::Gemm g{OBUF, (const f16*)(ws + WS_WOUT) + (size_t)l * DM * DM, MT, DM, DM}; pg8::StaticOrder S; S.init(MT, DM, G, wg);
            pg8::EpiResid E{xin, X, modl + 2 * DM};
            pg8::gemm_phase<pg8::EpiResid, pg8::StaticOrder>((LAS unsigned char*)lds, g, S, E);
            SEAM(pb + 5);
        }
        if (PM(7) && IN(pb + 6)) { norm_mod_phase(X, P.g_mlp + l * DM, modl + 3 * DM, modl + 4 * DM, H, G, wg); SEAM(pb + 6); }
        if (PM(8) && IN(pb + 7)) {
            pg8::Gemm g{H, (const f16*)(ws + WS_WUP) + (size_t)l * FF * DM, MT, FF, DM}; pg8::StaticOrder S; S.init(MT, FF, G, wg);
            pg8::EpiF16<1> E{HID, FF};
            pg8::gemm_phase<pg8::EpiF16<1>, pg8::StaticOrder>((LAS unsigned char*)lds, g, S, E);
            SEAM(pb + 7);
        }
        if (PM(9) && IN(pb + 8)) {
            pg8::Gemm g{HID, (const f16*)(ws + WS_WDN) + (size_t)l * DM * FF, MT, DM, FF}; pg8::StaticOrder S; S.init(MT, DM, G, wg);
            pg8::EpiResid E{X, X, modl + 5 * DM};
            pg8::gemm_phase<pg8::EpiResid, pg8::StaticOrder>((LAS unsigned char*)lds, g, S, E);
            SEAM(pb + 8);
        }
    }
    if (PM(10) && IN(19)) { final_norm_phase(X, P.g_final, P.out, G, wg); }
#undef IN
#undef SEAM
}

extern "C" void kernel_launch(void* const* d_in, const int* in_sizes, int n_in, void* d_out, int out_size, void* d_ws, size_t ws_size, hipStream_t stream) {
    static int grid = 0;
    if (grid == 0) {
        if (n_in != 16 || in_sizes[0] != MT * DM || out_size != MT * DM || ws_size < WS_END) {
            fprintf(stderr, "kernel_launch: unexpected shapes: n_in %d in0 %d out %d ws %zu (need %zu)\n", n_in, n_in > 0 ? in_sizes[0] : -1, out_size, ws_size, (size_t)WS_END); grid = -1; return; }
        int dev = 0, cus = 0, per_cu = 0;
        if (hipGetDevice(&dev) != hipSuccess || hipDeviceGetAttribute(&cus, hipDeviceAttributeMultiprocessorCount, dev) != hipSuccess) { grid = -1; return; }
        if (hipFuncSetAttribute((const void*)trunk_fwd, hipFuncAttributeMaxDynamicSharedMemorySize, LDS_BYTES) != hipSuccess) { fprintf(stderr, "kernel_launch: hipFuncSetAttribute failed\n"); grid = -1; return; }
        if (hipOccupancyMaxActiveBlocksPerMultiprocessor(&per_cu, (const void*)trunk_fwd, NTHR, LDS_BYTES) != hipSuccess || per_cu < 1) fprintf(stderr, "kernel_launch: occupancy query says %d\n", per_cu);
        (void)hipGetLastError();
        grid = cus;
    }
    if (grid < 0) return;
    (void)hipMemsetAsync((char*)d_ws + WS_CTL, 0, CTL_BYTES, stream);
    Args a{};
    a.p.x = (const float*)d_in[0]; a.p.c = (const float*)d_in[1]; a.p.w_mod = (const float*)d_in[2]; a.p.b_mod = (const float*)d_in[3]; a.p.g_attn = (const float*)d_in[4];
    a.p.w_in = (const float*)d_in[5]; a.p.kv_norm_g = (const float*)d_in[6]; a.p.w_uv = (const float*)d_in[7]; a.p.g_out_a = (const float*)d_in[8]; a.p.g_out_b = (const float*)d_in[9];
    a.p.w_out = (const float*)d_in[10]; a.p.g_mlp = (const float*)d_in[11]; a.p.w_up = (const float*)d_in[12]; a.p.w_down = (const float*)d_in[13]; a.p.rel_bias = (const float*)d_in[14];
    a.p.g_final = (const float*)d_in[15]; a.p.out = (float*)d_out; a.p.ws = (unsigned char*)d_ws;
#if N_LAUNCH_MODE == 1
    a.ph_lo = 0; a.ph_hi = N_PHASES;
    hipLaunchKernelGGL(trunk_fwd, dim3(grid), dim3(NTHR), LDS_BYTES, stream, a);
#else
    for (int ph = 0; ph < N_PHASES; ++ph) { a.ph_lo = ph; a.ph_hi = ph + 1; hipLaunchKernelGGL(trunk_fwd, dim3(grid), dim3(NTHR), LDS_BYTES, stream, a); }
#endif
}
```

```cpp
#include <hip/hip_runtime.h>
#include <cstdio>
#include <cstdint>

#define LAS __attribute__((address_space(3)))
typedef _Float16 f16;
typedef _Float16 f16x8 __attribute__((ext_vector_type(8)));
typedef _Float16 f16x4 __attribute__((ext_vector_type(4)));
typedef float f32x2 __attribute__((ext_vector_type(2)));
typedef float f32x4 __attribute__((ext_vector_type(4)));
typedef float f32x16 __attribute__((ext_vector_type(16)));
typedef unsigned u32x2 __attribute__((ext_vector_type(2)));
typedef unsigned u32x4 __attribute__((ext_vector_type(4)));

#ifndef N_LAUNCH_MODE
#define N_LAUNCH_MODE 1
#endif
#ifndef ENABLE_SB
#define ENABLE_SB 1
#endif
#ifndef ENABLE_DSA
#define ENABLE_DSA 1
#endif

constexpr int NB = 16, SEQ = 2048, DM = 1024, MT = NB * SEQ, NPJ = 3328, NPJ_VALID = 3272, FF = 4096, NLAYER = 2;
constexpr int C_SBQ = 0, C_SBK = 512, C_SBV = 1024, C_DQ = 1536, C_DKV = 2560, C_IQ = 2688, C_IK = 3200, C_IW = 3264;
constexpr int NWAVES = 8, NTHR = 512;
constexpr float EPS = 1e-6f;
constexpr float LOG2E = 1.4426950408889634f;

constexpr size_t al256(size_t x) { return (x + 255) & ~(size_t)255; }
constexpr size_t WS_CTL = 0;
constexpr size_t CTL_BYTES = 65536;
constexpr size_t WS_MOD = WS_CTL + CTL_BYTES;
constexpr size_t WS_BIAS = WS_MOD + al256((size_t)2 * 16 * 6144 * 4);
constexpr size_t WS_SSQ = WS_BIAS + al256((size_t)8 * 2112 * 4);
constexpr size_t WS_BW = WS_SSQ + (size_t)4 * MT * 4;
constexpr size_t WS_WIN = WS_BW + (size_t)2 * 2 * 16 * 4096 * 4;
constexpr size_t WS_WOUT = WS_WIN + (size_t)2 * NPJ * DM * 2;
constexpr size_t WS_WUP = WS_WOUT + (size_t)2 * DM * DM * 2;
constexpr size_t WS_WDN = WS_WUP + (size_t)2 * FF * DM * 2;
constexpr size_t WS_WUV = WS_WDN + (size_t)2 * FF * DM * 2;
constexpr size_t WS_H = WS_WUV + (size_t)2 * 8 * 64 * 128 * 2;
constexpr size_t WS_KV = WS_H + (size_t)MT * DM * 2;
constexpr size_t WS_KVT = WS_KV + (size_t)MT * 128 * 2;
constexpr size_t WS_VTA = WS_KVT + (size_t)MT * 128 * 2;
constexpr size_t WS_MASK = WS_VTA + (size_t)MT * 512 * 2;
constexpr size_t WS_PROJ = WS_MASK + (size_t)MT * 64 * 4;
constexpr size_t WS_OBUF = WS_PROJ + (size_t)MT * NPJ * 2;
constexpr size_t WS_HID = WS_PROJ;
constexpr size_t WS_END = WS_OBUF + (size_t)MT * DM * 2;
static_assert((size_t)MT * FF * 2 <= WS_END - WS_PROJ, "HID overlay must fit");

constexpr int LDS_BYTES = 147456;
constexpr int LDS_MISC = 135168;

__device__ __forceinline__ float wave_sum(float v) {
    v += __shfl_xor(v, 32); v += __shfl_xor(v, 16); v += __shfl_xor(v, 8); v += __shfl_xor(v, 4); v += __shfl_xor(v, 2); v += __shfl_xor(v, 1); return v;
}
__device__ __forceinline__ float half_sum(float v) {
    v += __shfl_xor(v, 16); v += __shfl_xor(v, 8); v += __shfl_xor(v, 4); v += __shfl_xor(v, 2); v += __shfl_xor(v, 1); return v;
}

__device__ __forceinline__ int ltid() { int t = threadIdx.x; asm volatile("" : "+v"(t)); return t; }

__device__ __forceinline__ int wave_sum_i(int v) {
    v += __builtin_amdgcn_update_dpp(0, v, 0xB1, 0xf, 0xf, true);
    v += __builtin_amdgcn_update_dpp(0, v, 0x4E, 0xf, 0xf, true);
    v += __builtin_amdgcn_update_dpp(0, v, 0x141, 0xf, 0xf, true);
    v += __builtin_amdgcn_update_dpp(0, v, 0x140, 0xf, 0xf, true);
    return __builtin_amdgcn_readlane(v, 0) + __builtin_amdgcn_readlane(v, 16) + __builtin_amdgcn_readlane(v, 32) + __builtin_amdgcn_readlane(v, 48);
}

__device__ __forceinline__ int kperm16(int k) { return (k & ~12) | ((k & 8) >> 1) | ((k & 4) << 1); }
#define XB_TMO      128
#define XB_XCNT(j)  (256  + 64 * (j))
#define XB_XSUB(j)  (1280 + 64 * (j))
#define XB_XGEN(j)  (2304 + 64 * (j))
#define XB_TOP      3328
#define XB_TOPGEN   3392
#define XCD_BAR_WORDS 3456
#define XB_SPIN_CAP (1u << 18)

__device__ __forceinline__ unsigned xb_ld(unsigned* p)              { return __hip_atomic_load(p, __ATOMIC_RELAXED, __HIP_MEMORY_SCOPE_AGENT); }
__device__ __forceinline__ unsigned xb_add(unsigned* p, unsigned v) { return __hip_atomic_fetch_add(p, v, __ATOMIC_RELAXED, __HIP_MEMORY_SCOPE_AGENT); }
__device__ __forceinline__ unsigned xb_xcc_id() { return (unsigned)__builtin_amdgcn_s_getreg((3 << 11) | 20) & 0xFu; }
#define XB_SPIN(cond, bar) do { unsigned _sp = 0; while (cond) { __builtin_amdgcn_s_sleep(1); \
    if ((++_sp & 255u) == 0u) { if (xb_ld(&(bar)[XB_TMO])) break; if (_sp > XB_SPIN_CAP) { atomicAdd(&(bar)[XB_TMO], 1u); break; } } } } while (0)

struct XcdBarrier {
    unsigned* bar; unsigned x;
    volatile LAS unsigned* st;
};

__device__ __forceinline__ XcdBarrier xcd_barrier_post(unsigned* bar, volatile LAS unsigned* st) {
    XcdBarrier b; b.bar = bar; b.x = xb_xcc_id(); b.st = st;
    if (threadIdx.x == 0) (void)xb_add(&bar[XB_XCNT(b.x)], 1u);
    return b;
}
__device__ __forceinline__ void xcd_barrier_complete(unsigned* bar, unsigned x, unsigned& nloc, unsigned& nx) {
    const unsigned G = gridDim.x * gridDim.y * gridDim.z;
    unsigned sum, cnt, mine, sp = 0u;
    for (;;) {
        sum = 0u; cnt = 0u; mine = 0u;
#pragma unroll
        for (unsigned j = 0; j < 16; ++j) { const unsigned c = xb_ld(&bar[XB_XCNT(j)]); sum += c; cnt += (c > 0u) ? 1u : 0u; mine = (j == x) ? c : mine; }
        if (sum == G) break;
        __builtin_amdgcn_s_sleep(1);
        if ((++sp & 255u) == 0u) { if (xb_ld(&bar[XB_TMO])) break; if (sp > XB_SPIN_CAP) { atomicAdd(&bar[XB_TMO], 1u); break; } }
    }
    nloc = mine > 0u ? mine : 1u; nx = cnt > 0u ? cnt : 1u;
}

__device__ __forceinline__ void xcd_barrier(const XcdBarrier& b) {
    asm volatile("s_waitcnt vmcnt(0)" ::: "memory");
    __syncthreads();
    if (threadIdx.x == 0) {
        unsigned* bar = b.bar;
        __builtin_amdgcn_s_waitcnt(0);
        unsigned nloc = b.st[0], nx = b.st[1];
        if (nloc == 0u) { xcd_barrier_complete(bar, b.x, nloc, nx); b.st[0] = nloc; b.st[1] = nx; }
        const unsigned old = xb_add(&bar[XB_XSUB(b.x)], 1u);
        const unsigned gen = old / nloc;
        if (old + 1u == (gen + 1u) * nloc) {
            __builtin_amdgcn_fence(__ATOMIC_RELEASE, "agent");
            asm volatile("s_waitcnt vmcnt(0)" ::: "memory");
            const unsigned og = xb_add(&bar[XB_TOP], 1u);
            const unsigned tg = og / nx;
            if (og + 1u == (tg + 1u) * nx) xb_add(&bar[XB_TOPGEN], 1u);
            else XB_SPIN(xb_ld(&bar[XB_TOPGEN]) == tg, bar);
            __builtin_amdgcn_fence(__ATOMIC_ACQUIRE, "agent");
            xb_add(&bar[XB_XGEN(b.x)], 1u);
            asm volatile("s_waitcnt vmcnt(0)" ::: "memory");
        } else {
            XB_SPIN(xb_ld(&bar[XB_XGEN(b.x)]) == gen, bar);
            __builtin_amdgcn_fence(__ATOMIC_ACQUIRE, "agent");
            asm volatile("s_waitcnt vmcnt(0)" ::: "memory");
        }
    }
    __syncthreads();
}

namespace pg8 {
constexpr int BM = 256, BK = 64, HALF = 128, HTB = HALF * BK * 2  , STAGE_BYTES = 8 * HTB, NXCD = 8, WGM = 8;

__host__ __device__ __forceinline__ int lds_byte(int r, int c) { const int st = (r >> 4) * 2 + (c >> 5), rr = r & 15, cc = c & 31, ob = rr * 64 + cc * 2; return st * 1024 + (ob ^ (((ob >> 9) & 1) << 5)); }
__host__ __device__ __forceinline__ void stage_rc(int b, int& R, int& C) { const int st = b / 1024, sb = b % 1024, swz = sb ^ (((sb >> 9) & 1) << 5); R = (st >> 1) * 16 + swz / 64; C = (st & 1) * 32 + (swz % 64) / 2; }
__host__ __device__ __forceinline__ int perm32(int rho) { const int n = rho >> 4, i = rho & 15; return 8 * (i >> 2) + 4 * n + (i & 3); }

struct Unit { int pm, pn; };
struct Gemm { const f16* A; const f16* Bt; int M, N, K; };

struct StaticOrder {
    int nM, nN, nwg, G, c;
    __host__ __device__ void init(int M, int N, int G_, int c_) { nM = M / BM; nN = N / BM; nwg = nM * nN; G = G_; c = c_; }
    __host__ __device__ bool next(int i, Unit& u) const {
        const long L = (long)i * G + c; if (L >= nwg) return false;
        int wgid = (int)L; { const int q = nwg / NXCD, r = nwg % NXCD, xcd = wgid % NXCD, off = wgid / NXCD; wgid = (xcd < r ? xcd * (q + 1) : r * (q + 1) + (xcd - r) * q) + off; }
        const int nig = WGM * nN, gid = wgid / nig, fm = gid * WGM, gsz = (nM - fm) < WGM ? (nM - fm) : WGM;
        u.pm = fm + ((wgid % nig) % gsz); u.pn = (wgid % nig) / gsz; return true;
    }
    __device__ __forceinline__ void a_ready(const Unit&) const {}
    __device__ __forceinline__ void done(const Unit&) const {}
};

struct EpiResid {
    static constexpr bool PERM = true, AFTER_DRAIN = false, PREFETCH = false;
    const float* base; float* out; const float* gate;
    __device__ __forceinline__ void operator()(const f32x4 (&acc)[2][2][4][2], const Unit& u, int wr, int wc, int fr, int fq) const {
        const int row0 = u.pm * BM + wr * 64 + fr; const int col0 = u.pn * BM + wc * 32 + 8 * fq;
        const float* gp = gate + (size_t)((u.pm * BM) >> 11) * 6144 + col0;
        f32x4 gv[2][2];
#pragma unroll
        for (int bj = 0; bj < 2; ++bj)
#pragma unroll
            for (int n = 0; n < 2; ++n) gv[bj][n] = *(const f32x4*)(gp + bj * HALF + 4 * n);
#pragma unroll
        for (int ai = 0; ai < 2; ++ai)
#pragma unroll
            for (int m = 0; m < 4; ++m) { const size_t ro = (size_t)(row0 + ai * HALF + m * 16) * DM + col0;
#pragma unroll
                for (int bj = 0; bj < 2; ++bj)
#pragma unroll
                    for (int n = 0; n < 2; ++n) { const f32x4 x = *(const f32x4*)(base + ro + bj * HALF + 4 * n);
                        *(f32x4*)(out + ro + bj * HALF + 4 * n) = x + gv[bj][n] * acc[ai][bj][m][n]; } }
    }
};
template <int ACT  > struct EpiF16N {
    static constexpr bool PERM = true, AFTER_DRAIN = false, PREFETCH = true;
    f16* O; int ldc; const float* ssq; const float* bw;
    __device__ __forceinline__ void prefetch(LAS unsigned char* aux, const Unit& u, int tid, int wid) const {
        const float* src = (tid < 256) ? ssq + u.pm * BM + tid : bw + (size_t)((u.pm * BM) >> 11) * 4096 + u.pn * BM + (tid - 256);
        __builtin_amdgcn_global_load_lds((const unsigned*)src, (LAS unsigned*)(aux + wid * 256), 4, 0, 0);
    }
    __device__ __forceinline__ void with_lds(const f32x4 (&acc)[2][2][4][2], const Unit& u, int wr, int wc, int fr, int fq, LAS unsigned char* aux) const {
        const int row0 = u.pm * BM + wr * 64 + fr; const int col0 = u.pn * BM + wc * 32 + 8 * fq;
        const LAS float* sq = (const LAS float*)aux; const LAS float* bl = (const LAS float*)(aux + 1024) + wc * 32 + 8 * fq;
        f32x4 bv[2][2];
#pragma unroll
        for (int bj = 0; bj < 2; ++bj)
#pragma unroll
            for (int n = 0; n < 2; ++n) bv[bj][n] = *(const LAS f32x4*)(bl + bj * HALF + 4 * n);
        float rs[2][4];
#pragma unroll
        for (int ai = 0; ai < 2; ++ai)
#pragma unroll
            for (int m = 0; m < 4; ++m) rs[ai][m] = rsqrtf(sq[wr * 64 + fr + ai * HALF + m * 16] * (1.0f / DM) + EPS);
#pragma unroll
        for (int ai = 0; ai < 2; ++ai)
#pragma unroll
            for (int m = 0; m < 4; ++m) { f16* rowp = O + (size_t)(row0 + ai * HALF + m * 16) * ldc + col0;
#pragma unroll
                for (int bj = 0; bj < 2; ++bj) { f32x4 v0 = acc[ai][bj][m][0] * rs[ai][m] + bv[bj][0], v1 = acc[ai][bj][m][1] * rs[ai][m] + bv[bj][1];
                    if (ACT == 1) {
#pragma unroll
                        for (int e = 0; e < 4; ++e) { const float a = fmaxf(v0[e], 0.f), b = fmaxf(v1[e], 0.f); v0[e] = a * a; v1[e] = b * b; } }
                    f16x8 w; w[0] = (f16)v0[0]; w[1] = (f16)v0[1]; w[2] = (f16)v0[2]; w[3] = (f16)v0[3]; w[4] = (f16)v1[0]; w[5] = (f16)v1[1]; w[6] = (f16)v1[2]; w[7] = (f16)v1[3];
                    *(f16x8*)(rowp + bj * HALF) = w; } }
    }
    __device__ __forceinline__ void operator()(const f32x4 (&)[2][2][4][2], const Unit&, int, int, int, int) const {}
};
struct EpiResidN {
    static constexpr bool PERM = true, AFTER_DRAIN = false, PREFETCH = false;
    const float* base; float* out; const float* gate; const float* gain; const float* scale; f16* An; float* ssq;
    __device__ __forceinline__ void operator()(const f32x4 (&acc)[2][2][4][2], const Unit& u, int wr, int wc, int fr, int fq) const {
        const int row0 = u.pm * BM + wr * 64 + fr; const int col0 = u.pn * BM + wc * 32 + 8 * fq;
        const size_t bo = (size_t)((u.pm * BM) >> 11) * 6144 + col0;
        f32x4 gv[2][2], al[2][2];
#pragma unroll
        for (int bj = 0; bj < 2; ++bj)
#pragma unroll
            for (int n = 0; n < 2; ++n) { gv[bj][n] = *(const f32x4*)(gate + bo + bj * HALF + 4 * n);
                const f32x4 g4 = *(const f32x4*)(gain + col0 + bj * HALF + 4 * n), s4 = *(const f32x4*)(scale + bo + bj * HALF + 4 * n); al[bj][n] = g4 * (1.0f + s4); }
#pragma unroll
        for (int ai = 0; ai < 2; ++ai)
#pragma unroll
            for (int m = 0; m < 4; ++m) { const int row = row0 + ai * HALF + m * 16; const size_t ro = (size_t)row * DM + col0; float sq = 0.f;
#pragma unroll
                for (int bj = 0; bj < 2; ++bj) {
                    const f32x4 x0 = *(const f32x4*)(base + ro + bj * HALF), x1 = *(const f32x4*)(base + ro + bj * HALF + 4);
                    const f32x4 y0 = x0 + gv[bj][0] * acc[ai][bj][m][0], y1 = x1 + gv[bj][1] * acc[ai][bj][m][1];
                    *(f32x4*)(out + ro + bj * HALF) = y0; *(f32x4*)(out + ro + bj * HALF + 4) = y1;
                    sq += ((y0[0] * y0[0] + y0[1] * y0[1]) + (y0[2] * y0[2] + y0[3] * y0[3])) + ((y1[0] * y1[0] + y1[1] * y1[1]) + (y1[2] * y1[2] + y1[3] * y1[3]));
                    const f32x4 z0 = y0 * al[bj][0], z1 = y1 * al[bj][1]; f16x8 zz;
                    zz[0] = (f16)z0[0]; zz[1] = (f16)z0[1]; zz[2] = (f16)z0[2]; zz[3] = (f16)z0[3]; zz[4] = (f16)z1[0]; zz[5] = (f16)z1[1]; zz[6] = (f16)z1[2]; zz[7] = (f16)z1[3];
                    *(f16x8*)(An + ro + bj * HALF) = zz; }
                sq += __shfl_xor(sq, 16); sq += __shfl_xor(sq, 32);
                if (fq == 0) __hip_atomic_fetch_add(ssq + row, sq, __ATOMIC_RELAXED, __HIP_MEMORY_SCOPE_AGENT); }
    }
};

template <class Epi, class Sched>
__device__ __forceinline__ void gemm_phase(LAS unsigned char* lds, const Gemm g, const Sched& S, const Epi& E) {
    const int tid = ltid(), wid = __builtin_amdgcn_readfirstlane(tid >> 6), lane = tid & 63, wr = wid >> 2, wc = wid & 3, fr = lane & 15, fq = lane >> 4;
    const int K = g.K, nt = K / BK;
    unsigned voffA[2], voffB[2];
#pragma unroll
    for (int i = 0; i < 2; ++i) { int R, C; stage_rc(tid * 16 + i * 8192, R, C); const int Rb = Epi::PERM ? ((R & ~31) + perm32(R & 31)) : R;
        voffA[i] = (unsigned)(R * K + C) * 2u; voffB[i] = (unsigned)(Rb * K + C) * 2u; }
    const size_t kstep = (size_t)(BK * 2);
    const size_t hstep = (size_t)HALF * K * 2;
    const size_t tstep = 2 * hstep;
    const unsigned ldsw = (unsigned)wid * 1024u;
    const int aoff = lds_byte(wr * 64 + fr, fq * 8), boff = lds_byte(wc * 32 + fr, fq * 8);
#define PG8_SA(b, h) (((b) * 2 + (h)) * HTB)
#define PG8_SB(b, h) ((4 + (b) * 2 + (h)) * HTB)
#define PG8_STAGE(bufoff, gbase, voff) do { _Pragma("unroll") for (int _i = 0; _i < 2; ++_i) \
        __builtin_amdgcn_global_load_lds((const unsigned*)((const char*)(gbase) + (voff)[_i]), (LAS unsigned*)(lds + (bufoff) + ldsw + _i * 8192), 16, 0, 0); } while (0)
#define PG8_LDA(dst, b, h) do { _Pragma("unroll") for (int m = 0; m < 4; ++m) _Pragma("unroll") for (int k = 0; k < 2; ++k) dst[m][k] = *(const LAS f16x8*)(lds + PG8_SA(b, h) + aoff + m * 2048 + k * 1024); } while (0)
#define PG8_LDB(dst, b, h) do { _Pragma("unroll") for (int n = 0; n < 2; ++n) _Pragma("unroll") for (int k = 0; k < 2; ++k) dst[n][k] = *(const LAS f16x8*)(lds + PG8_SB(b, h) + boff + n * 2048 + k * 1024); } while (0)
#define PG8_MMA(ai, bj, At, Bt) do { __builtin_amdgcn_s_setprio(1); _Pragma("unroll") for (int m = 0; m < 4; ++m) _Pragma("unroll") for (int n = 0; n < 2; ++n) _Pragma("unroll") for (int k = 0; k < 2; ++k) \
        acc[ai][bj][m][n] = __builtin_amdgcn_mfma_f32_16x16x32_f16(Bt[n][k], At[m][k], acc[ai][bj][m][n], 0, 0, 0); __builtin_amdgcn_s_setprio(0); } while (0)
#define PG8_WAIT_V(n) asm volatile("s_waitcnt vmcnt(" #n ")" ::: "memory")
#define PG8_WAIT_L(n) asm volatile("s_waitcnt lgkmcnt(" #n ")" ::: "memory")
#define PG8_BAR __builtin_amdgcn_s_barrier()
#define PG8_SCHED __builtin_amdgcn_sched_barrier(0)
    Unit cur, nxt; int ui = 0;
    if (!S.next(0, cur)) return;
    f32x4 acc[2][2][4][2];
#pragma unroll
    for (int a = 0; a < 2; ++a)
#pragma unroll
        for (int b = 0; b < 2; ++b)
#pragma unroll
            for (int m = 0; m < 4; ++m)
#pragma unroll
                for (int n = 0; n < 2; ++n) acc[a][b][m][n] = (f32x4){0.f, 0.f, 0.f, 0.f};
    f16x8 At[4][2], B0[2][2], B1[2][2];
    const char* cA = (const char*)g.A + (size_t)cur.pm * tstep; const char* cB = (const char*)g.Bt + (size_t)cur.pn * tstep;
    S.a_ready(cur);
    if constexpr (Epi::PREFETCH) E.prefetch(lds + STAGE_BYTES, cur, tid, wid);
    PG8_STAGE(PG8_SB(0, 0), cB, voffB); PG8_STAGE(PG8_SB(0, 1), cB + hstep, voffB); PG8_STAGE(PG8_SA(0, 0), cA, voffA); PG8_STAGE(PG8_SA(0, 1), cA + hstep, voffA);
    if (wr == 1) PG8_BAR;
    PG8_WAIT_V(2); PG8_BAR;
    PG8_STAGE(PG8_SB(1, 0), cB + kstep, voffB); PG8_STAGE(PG8_SA(1, 0), cA + kstep, voffA); PG8_STAGE(PG8_SB(1, 1), cB + hstep + kstep, voffB);
    PG8_WAIT_V(6); PG8_BAR;
    for (;;) {
        const bool has_next = S.next(ui + 1, nxt);
        const char* nA = has_next ? (const char*)g.A + (size_t)nxt.pm * tstep : cA; const char* nB = has_next ? (const char*)g.Bt + (size_t)nxt.pn * tstep : cB;
        for (int t = 0; t < nt; t += 2) {
            const bool last = (t == nt - 2);
            const char* a1 = cA + (size_t)(t + 1) * kstep;
            const char* a2 = last ? nA : cA + (size_t)(t + 2) * kstep; const char* b2 = last ? nB : cB + (size_t)(t + 2) * kstep;
            const char* a3 = a2 + kstep; const char* b3 = b2 + kstep;
            if (last && has_next) S.a_ready(nxt);
            PG8_LDB(B0, 0, 0); PG8_LDB(B1, 0, 1); PG8_SCHED; PG8_LDA(At, 0, 0); PG8_STAGE(PG8_SA(1, 1), a1 + hstep, voffA);
            PG8_WAIT_V(8); PG8_WAIT_L(0); PG8_BAR; PG8_MMA(0, 0, At, B0); PG8_MMA(0, 1, At, B1); PG8_BAR; PG8_SCHED;
            PG8_LDA(At, 0, 1); PG8_STAGE(PG8_SB(0, 0), b2, voffB); PG8_STAGE(PG8_SB(0, 1), b2 + hstep, voffB); PG8_STAGE(PG8_SA(0, 0), a2, voffA);
            PG8_WAIT_V(8); PG8_WAIT_L(0); PG8_BAR; PG8_MMA(1, 0, At, B0); PG8_MMA(1, 1, At, B1); PG8_BAR; PG8_SCHED;
            PG8_LDB(B0, 1, 0); PG8_LDB(B1, 1, 1); PG8_SCHED; PG8_LDA(At, 1, 0); PG8_STAGE(PG8_SA(0, 1), a2 + hstep, voffA);
            PG8_WAIT_V(8); PG8_WAIT_L(0); PG8_BAR; PG8_MMA(0, 0, At, B0); PG8_MMA(0, 1, At, B1); PG8_BAR; PG8_SCHED;
            PG8_LDA(At, 1, 1); PG8_STAGE(PG8_SB(1, 0), b3, voffB); PG8_STAGE(PG8_SB(1, 1), b3 + hstep, voffB); PG8_STAGE(PG8_SA(1, 0), a3, voffA);
            PG8_WAIT_V(8); PG8_WAIT_L(0); PG8_BAR; PG8_MMA(1, 0, At, B0); PG8_MMA(1, 1, At, B1); PG8_BAR; PG8_SCHED;
        }
        if (wr == 0) PG8_BAR;
        if constexpr (Epi::PREFETCH) E.with_lds(acc, cur, wr, wc, fr, fq, lds + STAGE_BYTES + (ui & 1) * 2048); else E(acc, cur, wr, wc, fr, fq);
        S.done(cur);
        if (!has_next) break;
#pragma unroll
        for (int a = 0; a < 2; ++a)
#pragma unroll
            for (int b = 0; b < 2; ++b)
#pragma unroll
                for (int m = 0; m < 4; ++m)
#pragma unroll
                    for (int n = 0; n < 2; ++n) acc[a][b][m][n] = (f32x4){0.f, 0.f, 0.f, 0.f};
        cur = nxt; cA = nA; cB = nB; ++ui;
        if constexpr (Epi::PREFETCH) E.prefetch(lds + STAGE_BYTES + (ui & 1) * 2048, cur, tid, wid);
        if (wr == 1) PG8_BAR;
    }
    PG8_WAIT_V(0);
    PG8_BAR;
#undef PG8_SA
#undef PG8_SB
#undef PG8_STAGE
#undef PG8_LDA
#undef PG8_LDB
#undef PG8_MMA
#undef PG8_WAIT_V
#undef PG8_WAIT_L
#undef PG8_BAR
#undef PG8_SCHED
}
}
struct Ptrs {
    const float *x, *c, *w_mod, *b_mod, *g_attn, *w_in, *kv_norm_g, *w_uv, *g_out_a, *g_out_b, *w_out, *g_mlp, *w_up, *w_down, *rel_bias, *g_final;
    float* out; unsigned char* ws;
};

__device__ __forceinline__ void conv_tile(float* T  , const float* src, int N, int K, int Nvalid, const float* ks0, const float* ks1, f16* dst, int tn, int tk) {
    const int tid = ltid();
#pragma unroll
    for (int i = 0; i < 8; ++i) {
        const int kk = (tid >> 6) + 8 * i, k = tk * 64 + kk, n = tn * 64 + (tid & 63);
        float v = (n < Nvalid) ? src[(size_t)k * N + n] : 0.f;
        if (ks0) v *= (k < 512 ? ks0[k] : ks1[k - 512]);
        T[kk * 65 + (tid & 63)] = v;
    }
    __syncthreads();
    { const int nn = tid >> 3, kc = (tid & 7) * 8; f16x8 o;
#pragma unroll
      for (int e = 0; e < 8; ++e) o[e] = (f16)T[(kc + e) * 65 + nn];
      *(f16x8*)(dst + (size_t)(tn * 64 + nn) * K + tk * 64 + kc) = o; }
    __syncthreads();
}

__device__ __forceinline__ int t5_bucket_dev(int rel) {
    const int n = rel < 0 ? -rel : rel; int bk;
    if (n < 8) bk = n; else if (n < 12) bk = 8; else if (n < 16) bk = 9; else if (n < 23) bk = 10; else if (n < 32) bk = 11; else if (n < 46) bk = 12; else if (n < 64) bk = 13; else if (n < 91) bk = 14; else bk = 15;
    return (rel > 0 ? 16 : 0) + bk;
}

__device__ __forceinline__ void prologue_phase(unsigned char* lds, const Ptrs& P, int G, int wg) {
    const int tid = ltid(), lane = tid & 63, wv = tid >> 6;
    unsigned char* ws = P.ws;
    float* T = (float*)lds;
    constexpr int T_IN = 52 * 16, T_OUT = 16 * 16, T_UP = 64 * 16, T_DN = 16 * 64, T_UV = 16, T_L = T_IN + T_OUT + T_UP + T_DN + T_UV;
    for (int u = wg; u < 2 * T_L; u += G) {
        const int l = u / T_L; int r = u % T_L;
        if (r < T_IN) { conv_tile(T, P.w_in + (size_t)l * DM * NPJ_VALID, NPJ_VALID, DM, NPJ_VALID, nullptr, nullptr, (f16*)(ws + WS_WIN) + (size_t)l * NPJ * DM, r / 16, r % 16); continue; }
        r -= T_IN;
        if (r < T_OUT) { conv_tile(T, P.w_out + (size_t)l * DM * DM, DM, DM, DM, P.g_out_a + l * 512, P.g_out_b + l * 512, (f16*)(ws + WS_WOUT) + (size_t)l * DM * DM, r / 16, r % 16); continue; }
        r -= T_OUT;
        if (r < T_UP) { conv_tile(T, P.w_up + (size_t)l * DM * FF, FF, DM, FF, nullptr, nullptr, (f16*)(ws + WS_WUP) + (size_t)l * FF * DM, r / 16, r % 16); continue; }
        r -= T_UP;
        if (r < T_DN) { conv_tile(T, P.w_down + (size_t)l * FF * DM, DM, FF, DM, nullptr, nullptr, (f16*)(ws + WS_WDN) + (size_t)l * DM * FF, r / 64, r % 64); continue; }
        r -= T_DN;
        { const int h = r >> 1; conv_tile(T, P.w_uv + ((size_t)l * 8 + h) * 128 * 64, 64, 128, 64, nullptr, nullptr, (f16*)(ws + WS_WUV) + ((size_t)l * 8 + h) * 64 * 128, 0, r & 1); }
    }
    { float* sq = (float*)(ws + WS_SSQ) + MT; for (size_t i = (size_t)wg * NTHR + tid; i < (size_t)3 * MT / 4; i += (size_t)G * NTHR) ((f32x4*)sq)[i] = (f32x4){0.f, 0.f, 0.f, 0.f}; }
    if (wg == G - 1) {
        float* BT = (float*)(ws + WS_BIAS);
        for (int i = tid; i < 8 * 2112; i += NTHR) { const int h = i / 2112, idx = i % 2112; const int bk = t5_bucket_dev(idx - 2047);
            BT[i] = (P.rel_bias[bk * 8 + h] - P.rel_bias[15 * 8 + h]) * LOG2E; }
    }
    __syncthreads();
    if (wg < 192) {
        float* SC = (float*)lds;
        float* RED = (float*)(lds + 65536);
        for (int i = tid; i < 16 * 1024; i += NTHR) { const int b = i >> 10, k = i & 1023; const float cv = P.c[i]; SC[k * 16 + b] = cv / (1.f + __expf(-cv)); }
        __syncthreads();
        for (int u = wg; u < 192; u += G) {
            const int l = u / 96, cb = u % 96, col = cb * 64 + lane;
            const float* wp = P.w_mod + (size_t)l * DM * 6144 + col;
            float acc[16];
#pragma unroll
            for (int b = 0; b < 16; ++b) acc[b] = 0.f;
            for (int k = wv * 128; k < wv * 128 + 128; ++k) {
                const float w = wp[(size_t)k * 6144];
                const f32x4 s0 = *(const f32x4*)(SC + k * 16), s1 = *(const f32x4*)(SC + k * 16 + 4), s2 = *(const f32x4*)(SC + k * 16 + 8), s3 = *(const f32x4*)(SC + k * 16 + 12);
#pragma unroll
                for (int e = 0; e < 4; ++e) { acc[e] += s0[e] * w; acc[4 + e] += s1[e] * w; acc[8 + e] += s2[e] * w; acc[12 + e] += s3[e] * w; }
            }
#pragma unroll
            for (int b = 0; b < 16; ++b) RED[(wv * 16 + b) * 64 + lane] = acc[b];
            __syncthreads();
            for (int i = tid; i < 1024; i += NTHR) { const int b = i >> 6, cc = i & 63; float s = P.b_mod[l * 6144 + cb * 64 + cc];
#pragma unroll
                for (int w8 = 0; w8 < 8; ++w8) s += RED[(w8 * 16 + b) * 64 + cc];
                ((float*)(ws + WS_MOD))[((size_t)l * 16 + b) * 6144 + cb * 64 + cc] = s; }
            __syncthreads();
        }
    }
}

__device__ __forceinline__ void final_norm_phase(const float* x, const float* gain, float* out, int G, int wg) {
    const int tid_ = ltid(); const int lane = tid_ & 63, wv = tid_ >> 6;
    for (int row = wg * NWAVES + wv; row < MT; row += G * NWAVES) {
        const float* xp = x + (size_t)row * DM + lane * 4;
        f32x4 v[4]; float ss = 0.f;
#pragma unroll
        for (int i = 0; i < 4; ++i) { v[i] = *(const f32x4*)(xp + i * 256); ss += v[i][0] * v[i][0] + v[i][1] * v[i][1] + v[i][2] * v[i][2] + v[i][3] * v[i][3]; }
        ss = wave_sum(ss);
        const float rstd = rsqrtf(ss * (1.0f / DM) + EPS);
#pragma unroll
        for (int i = 0; i < 4; ++i) { const int col = i * 256 + lane * 4; const f32x4 g4 = *(const f32x4*)(gain + col);
            *(f32x4*)(out + (size_t)row * DM + col) = v[i] * rstd * g4; }
    }
}

__device__ __forceinline__ void kvnorm_phase(unsigned char* lds, const f16* PROJ, const float* g, f16* KV, f16* KVT, int G, int wg) {
    const int tid = ltid();
    f16* T = (f16*)lds;
    for (int blk = wg; blk < MT / 64; blk += G) {
        const int tok = tid >> 3, ch = tid & 7; const size_t row = (size_t)blk * 64 + tok;
        const f16* p = PROJ + row * NPJ + C_DKV + ch * 16;
        const f16x8 a = *(const f16x8*)p, b = *(const f16x8*)(p + 8);
        float va[8], vb[8]; float ss = 0.f;
#pragma unroll
        for (int e = 0; e < 8; ++e) { va[e] = (float)a[e]; vb[e] = (float)b[e]; ss += va[e] * va[e] + vb[e] * vb[e]; }
        ss += __shfl_xor(ss, 4); ss += __shfl_xor(ss, 2); ss += __shfl_xor(ss, 1);
        const float rstd = rsqrtf(ss * (1.0f / 128.f) + EPS);
        f16x8 oa, ob;
#pragma unroll
        for (int e = 0; e < 8; ++e) { oa[e] = (f16)(va[e] * rstd * g[ch * 16 + e]); ob[e] = (f16)(vb[e] * rstd * g[ch * 16 + 8 + e]); }
        *(f16x8*)(KV + row * 128 + ch * 16) = oa; *(f16x8*)(KV + row * 128 + ch * 16 + 8) = ob;
        { const int tp = (tok & ~15) | kperm16(tok & 15);
#pragma unroll
        for (int e = 0; e < 8; ++e) { T[(ch * 16 + e) * 72 + tp] = oa[e]; T[(ch * 16 + 8 + e) * 72 + tp] = ob[e]; } }
        __syncthreads();
        { const int dim = tid >> 2, tc = (tid & 3) * 16; const int bb = (blk * 64) >> 11, t0 = (blk * 64) & 2047;
          const f16x8 x0 = *(const f16x8*)(T + dim * 72 + tc), x1 = *(const f16x8*)(T + dim * 72 + tc + 8);
          f16* q = KVT + ((size_t)bb * 128 + dim) * SEQ + t0 + tc;
          *(f16x8*)q = x0; *(f16x8*)(q + 8) = x1; }
        __syncthreads();
    }
}

__device__ __forceinline__ void prenorm0_phase(const float* x, const float* gain, const float* sc, f16* An, float* ssq, int G, int wg) {
    const int tid_ = ltid(); const int lane = tid_ & 63, wv = tid_ >> 6;
    for (int row = wg * NWAVES + wv; row < MT; row += G * NWAVES) {
        const int b = row >> 11; const float* xp = x + (size_t)row * DM + lane * 4;
        f32x4 v[4]; float ss = 0.f;
#pragma unroll
        for (int i = 0; i < 4; ++i) { v[i] = *(const f32x4*)(xp + i * 256); ss += v[i][0] * v[i][0] + v[i][1] * v[i][1] + v[i][2] * v[i][2] + v[i][3] * v[i][3]; }
        ss = wave_sum(ss);
        if (lane == 0) ssq[row] = ss;
#pragma unroll
        for (int i = 0; i < 4; ++i) { const int col = i * 256 + lane * 4;
            const f32x4 g4 = *(const f32x4*)(gain + col), s4 = *(const f32x4*)(sc + (size_t)b * 6144 + col);
            f16x4 o;
#pragma unroll
            for (int e = 0; e < 4; ++e) o[e] = (f16)(v[i][e] * (g4[e] * (1.f + s4[e])));
            *(f16x4*)(An + (size_t)row * DM + col) = o; }
    }
}

__device__ __forceinline__ void bw_phase(unsigned char* lds, const Ptrs& P, const float* MOD, float* BW, int G, int wg) {
    const int tid = ltid(), lane = tid & 63, wv = tid >> 6;
    float* SH = (float*)lds;
    float* RED = (float*)(lds + 65536);
    for (int u = wg; u < 2 * 116; u += G) {
        const int l = u / 116, r = u % 116, site = (r < 52) ? 0 : 1, cb = (site == 0) ? r : r - 52;
        const int N = (site == 0) ? NPJ_VALID : FF;
        const float* W = (site == 0) ? P.w_in + (size_t)l * DM * NPJ_VALID : P.w_up + (size_t)l * DM * FF;
        const float* shp = MOD + (size_t)l * 16 * 6144 + (site == 0 ? 0 : 3) * DM;
        __syncthreads();
        for (int i = tid; i < 16 * 1024; i += NTHR) { const int b = i >> 10, k = i & 1023; SH[k * 16 + b] = shp[(size_t)b * 6144 + k]; }
        __syncthreads();
        const int col = cb * 64 + lane; const bool ok = col < N;
        const float* wp = W + (ok ? col : 0);
        float acc[16];
#pragma unroll
        for (int b = 0; b < 16; ++b) acc[b] = 0.f;
        for (int k = wv * 128; k < wv * 128 + 128; ++k) {
            const float w = ok ? wp[(size_t)k * N] : 0.f;
            const f32x4 s0 = *(const f32x4*)(SH + k * 16), s1 = *(const f32x4*)(SH + k * 16 + 4), s2 = *(const f32x4*)(SH + k * 16 + 8), s3 = *(const f32x4*)(SH + k * 16 + 12);
#pragma unroll
            for (int e = 0; e < 4; ++e) { acc[e] += s0[e] * w; acc[4 + e] += s1[e] * w; acc[8 + e] += s2[e] * w; acc[12 + e] += s3[e] * w; }
        }
#pragma unroll
        for (int b = 0; b < 16; ++b) RED[(wv * 16 + b) * 64 + lane] = acc[b];
        __syncthreads();
        for (int i = tid; i < 1024; i += NTHR) { const int b = i >> 6, cc = i & 63; float s = 0.f;
#pragma unroll
            for (int w8 = 0; w8 < 8; ++w8) s += RED[(w8 * 16 + b) * 64 + cc];
            BW[(((size_t)l * 2 + site) * 16 + b) * 4096 + cb * 64 + cc] = s; }
    }
    __syncthreads();
}

__device__ __forceinline__ void vtrans_phase(unsigned char* lds, const f16* PROJ, f16* VTA, int G, int wg) {
    const int tid = ltid();
    f16* T = (f16*)lds;
    for (int blk = wg; blk < 16 * 8 * 32; blk += G) {
        const int bh = blk >> 5, tb = blk & 31, b = bh >> 3, h = bh & 7;
        const int tok = tid >> 3, ch = tid & 7;
        const f16x8 v = *(const f16x8*)(PROJ + ((size_t)b * SEQ + tb * 64 + tok) * NPJ + C_SBV + h * 64 + ch * 8);
        const int tp = (tok & ~15) | kperm16(tok & 15);
#pragma unroll
        for (int e = 0; e < 8; ++e) T[(ch * 8 + e) * 72 + tp] = v[e];
        __syncthreads();
        { const int dim = tid >> 3, kc = (tid & 7) * 8;
          *(f16x8*)(VTA + ((size_t)bh * 64 + dim) * SEQ + tb * 64 + kc) = *(const f16x8*)(T + dim * 72 + kc); }
        __syncthreads();
    }
}

#define SB_LOAD(KF, VF, HT) do { const int _ht = (HT) < 0 ? 0 : (HT); \
    _Pragma("unroll") for (int s = 0; s < 4; ++s) KF[s] = *(const f16x8*)(kp + (size_t)_ht * 32 * NPJ + 16 * s); \
    _Pragma("unroll") for (int d = 0; d < 2; ++d) _Pragma("unroll") for (int s = 0; s < 2; ++s) VF[d][s] = *(const f16x8*)(vp + (size_t)d * 32 * SEQ + _ht * 32 + 16 * s); } while (0)

#define SB_COMPUTE(KF, VF, HT) do { \
    f32x16 S; _Pragma("unroll") for (int r = 0; r < 16; ++r) S[r] = 0.f; \
    _Pragma("unroll") for (int s = 0; s < 4; ++s) S = __builtin_amdgcn_mfma_f32_32x32x16_f16(KF[s], qf[s], S, 0, 0, 0); \
    f32x16 om; \
    _Pragma("unroll") for (int r = 0; r < 16; ++r) { \
        const float zc = __builtin_amdgcn_fmed3f(S[r], -640.f, 640.f);                    \
        const float e1 = __builtin_amdgcn_exp2f(zc * (-0.125f * LOG2E));                  \
        const float be = __builtin_amdgcn_rcpf(1.0f + e1);                                \
        S[r] = be; om[r] = e1 * be; }                                                      \
    if ((HT) == rb) {                                                                      \
        const int kb = (HT) * 32 + 4 * hh; \
        _Pragma("unroll") for (int r = 0; r < 16; ++r) { const int key = kb + 8 * (r >> 2) + (r & 3); if (key >= q) { S[r] = 0.f; om[r] = 1.0f; } } } \
    float R = C; \
    _Pragma("unroll") for (int g = 3; g >= 0; --g) { \
        const float o0 = om[4 * g], o1 = om[4 * g + 1], o2 = om[4 * g + 2], o3 = om[4 * g + 3]; \
        const float gown = (o0 * o1) * (o2 * o3); \
        const float gp = __shfl_xor(gown, 32); \
        const float pre = hh ? R : R * gp; \
        const float p3 = pre, p2 = p3 * o3, p1 = p2 * o2, p0 = p1 * o1; \
        S[4 * g + 3] *= p3; S[4 * g + 2] *= p2; S[4 * g + 1] *= p1; S[4 * g] *= p0; \
        R = R * gown * gp; } \
    C = R; \
    f16x8 pf[2]; \
    _Pragma("unroll") for (int s = 0; s < 2; ++s) _Pragma("unroll") for (int e = 0; e < 8; ++e) pf[s][e] = (f16)S[8 * s + e]; \
    _Pragma("unroll") for (int d = 0; d < 2; ++d) _Pragma("unroll") for (int s = 0; s < 2; ++s) accO[d] = __builtin_amdgcn_mfma_f32_32x32x16_f16(VF[d][s], pf[s], accO[d], 0, 0, 0); \
    } while (0)

__device__ __forceinline__ void sb_attn_phase(unsigned char* lds, const f16* PROJ, const f16* VTA, f16* OBUF, int G, int wg) {
    const int tid = ltid(), lane = tid & 63, wv = tid >> 6, l32 = lane & 31, hh = lane >> 5;
    float* RED = (float*)(lds + 73728);
    int par = 0;
    for (int u = wg; u < 1024; u += G, par ^= 1) {
        const int b = 2 * (u & 7) + ((u >> 3) & 1), rb = 63 - (u >> 4), h = wv, bh = b * 8 + h;
        const size_t rowbase = (size_t)b * SEQ;
        const int r0 = rb * 32, q = r0 + l32;
        f16x8 qf[4];
        { const f16* qp = PROJ + (rowbase + q) * NPJ + C_SBQ + h * 64 + hh * 8;
#pragma unroll
          for (int s = 0; s < 4; ++s) qf[s] = *(const f16x8*)(qp + 16 * s); }
        const f16* kp = PROJ + (rowbase + l32) * NPJ + C_SBK + h * 64 + hh * 8;
        const f16* vp = VTA + ((size_t)bh * 64 + l32) * SEQ + 8 * hh;
        f32x16 accO[2];
#pragma unroll
        for (int d = 0; d < 2; ++d)
#pragma unroll
            for (int r = 0; r < 16; ++r) accO[d][r] = 0.f;
        float C = 1.0f;
        f16x8 kA[4], vA[2][2], kB[4], vB[2][2];
        int ht = rb;
        SB_LOAD(kA, vA, ht);
        for (;;) {
            SB_LOAD(kB, vB, ht - 1);
            SB_COMPUTE(kA, vA, ht);
            if (ht == 0 || __ballot(C >= 2.9e-8f) == 0ull) break;
            --ht;
            SB_LOAD(kA, vA, ht - 1);
            SB_COMPUTE(kB, vB, ht);
            if (ht == 0 || __ballot(C >= 2.9e-8f) == 0ull) break;
            --ht;
        }
        float ssq = 0.f;
#pragma unroll
        for (int d = 0; d < 2; ++d)
#pragma unroll
            for (int r = 0; r < 16; ++r) ssq += accO[d][r] * accO[d][r];
        ssq += __shfl_xor(ssq, 32);
        if (hh == 0) RED[(par * 8 + wv) * 32 + l32] = ssq;
        __syncthreads();
        float tot = 0.f;
#pragma unroll
        for (int w8 = 0; w8 < 8; ++w8) tot += RED[(par * 8 + w8) * 32 + l32];
        const float rstd = rsqrtf(tot * (1.0f / 512.f) + EPS);
        { f16* op = OBUF + (rowbase + q) * DM + h * 64 + 4 * hh;
#pragma unroll
          for (int d = 0; d < 2; ++d)
#pragma unroll
            for (int g = 0; g < 4; ++g) { f16x4 o; o[0] = (f16)(accO[d][4 * g] * rstd); o[1] = (f16)(accO[d][4 * g + 1] * rstd); o[2] = (f16)(accO[d][4 * g + 2] * rstd); o[3] = (f16)(accO[d][4 * g + 3] * rstd);
                *(f16x4*)(op + 32 * d + 8 * g) = o; } }
    }
}
constexpr int IDX_PITCH = 2052;
__device__ __forceinline__ unsigned radix_scan(const unsigned* hist, int lane, unsigned& digit, unsigned& rank) {
    const u32x4 b = *(const u32x4*)(hist + 4 * lane);
    const unsigned s = b[0] + b[1] + b[2] + b[3];
    unsigned p = s;
    p += (unsigned)__builtin_amdgcn_update_dpp(0, (int)p, 0x101, 0xf, 0xf, true);
    p += (unsigned)__builtin_amdgcn_update_dpp(0, (int)p, 0x102, 0xf, 0xf, true);
    p += (unsigned)__builtin_amdgcn_update_dpp(0, (int)p, 0x104, 0xf, 0xf, true);
    p += (unsigned)__builtin_amdgcn_update_dpp(0, (int)p, 0x108, 0xf, 0xf, true);
    { const unsigned t1 = __builtin_amdgcn_readlane(p, 16), t2 = __builtin_amdgcn_readlane(p, 32), t3 = __builtin_amdgcn_readlane(p, 48);
      p += (lane < 16) ? (t1 + t2 + t3) : (lane < 32) ? (t2 + t3) : (lane < 48) ? t3 : 0u; }
    const unsigned long long ge = __ballot(p >= rank);
    const int L = __popcll(ge) - 1;
    const unsigned pL = __builtin_amdgcn_readlane(p, L), sL = __builtin_amdgcn_readlane(s, L);
    unsigned r = rank - (pL - sL);
    const unsigned b3 = __builtin_amdgcn_readlane(b[3], L), b2 = __builtin_amdgcn_readlane(b[2], L), b1 = __builtin_amdgcn_readlane(b[1], L);
    unsigned k = 3, bc = b3;
    if (r > b3) { r -= b3; k = 2; bc = b2; if (r > b2) { r -= b2; k = 1; bc = b1; if (r > b1) { r -= b1; k = 0; bc = __builtin_amdgcn_readlane(b[0], L); } } }
    digit = 4u * (unsigned)L + k; rank = r; return bc;
}
template <int NJ> __device__ __forceinline__ unsigned topk_words(const float* row, int nadm, int lane, unsigned* hist, unsigned* hist_dummy) {
    unsigned uk[NJ];
#pragma unroll
    for (int j = 0; j < NJ; ++j) {
        const int key = 64 * j + lane;
        unsigned bits = 0u;
        if (key < nadm) { bits = __float_as_uint(row[key]); bits ^= (unsigned)(((int)bits >> 31) | 0x80000000); }
        uk[j] = bits;
    }
    unsigned rank = 256u, T = 0u, dg;
    unsigned* dummy = hist_dummy + lane;
    *(u32x4*)(hist + 4 * lane) = (u32x4){0u, 0u, 0u, 0u};
#pragma unroll
    for (int j = 0; j < NJ; ++j) __hip_atomic_fetch_add(hist + (uk[j] >> 24), 1u, __ATOMIC_RELAXED, __HIP_MEMORY_SCOPE_WORKGROUP);
    unsigned binc = radix_scan(hist, lane, dg, rank); T = dg << 24;
#pragma unroll
    for (int lv = 1; lv < 4; ++lv) {
        const int sh = 24 - 8 * lv;
        if (binc == rank) break;
        *(u32x4*)(hist + 4 * lane) = (u32x4){0u, 0u, 0u, 0u};
        const unsigned pre = T >> (sh + 8);
#pragma unroll
        for (int j = 0; j < NJ; ++j) { unsigned* dst = ((uk[j] >> (sh + 8)) == pre) ? hist + ((uk[j] >> sh) & 255u) : dummy;
            __hip_atomic_fetch_add(dst, 1u, __ATOMIC_RELAXED, __HIP_MEMORY_SCOPE_WORKGROUP); }
        binc = radix_scan(hist, lane, dg, rank); T |= dg << sh;
    }
    int need = (int)rank;
    unsigned word = 0u;
#pragma unroll
    for (int j = 0; j < NJ; ++j) {
        unsigned long long sel = __ballot(uk[j] > T);
        unsigned long long em = __ballot(uk[j] == T);
        if (need > 0 && em != 0ull) {
            const int pc = __popcll(em);
            if (pc <= need) { sel |= em; need -= pc; }
            else { unsigned long long keep = 0ull; for (int i = 0; i < need; ++i) { const unsigned long long lowb = em & (0ull - em); keep |= lowb; em ^= lowb; } sel |= keep; need = 0; }
        }
        asm volatile("v_writelane_b32 %0, %1, %3\n\tv_writelane_b32 %0, %2, %4" : "+v"(word) : "s"((unsigned)sel), "s"((unsigned)(sel >> 32)), "n"(2 * j), "n"(2 * j + 1));
    }
    return word;
}
__device__ __forceinline__ void indexer_phase(unsigned char* lds, const f16* PROJ, unsigned* MASK, int G, int wg, bool do_topk) {
    const int tid = ltid(), lane = tid & 63, wv = tid >> 6, l16 = lane & 15, lq = lane >> 4;
    float* SCR = (float*)lds;
    unsigned* hist = (unsigned*)(lds + 136192) + wv * 256;
    unsigned* hdum = (unsigned*)(lds + 136192 + 8192) + wv * 64;
    f16x8 qa[8][2]; f16x8 w8r[4]; f16x8 ka[4][2];
#define IDX_LOAD_UNIT(U) do { const int _b = 2 * ((U) & 7) + (((U) >> 3) & 1), _q0 = (127 - ((U) >> 4)) * 16; const size_t _rb = (size_t)_b * SEQ; \
        const f16* _qp = PROJ + (_rb + _q0 + l16) * NPJ + C_IQ + lq * 8; \
        _Pragma("unroll") for (int hd = 0; hd < 8; ++hd) _Pragma("unroll") for (int s_ = 0; s_ < 2; ++s_) qa[hd][s_] = *(const f16x8*)(_qp + hd * 64 + 32 * s_); \
        _Pragma("unroll") for (int r = 0; r < 4; ++r) w8r[r] = *(const f16x8*)(PROJ + (_rb + _q0 + 4 * lq + r) * NPJ + C_IW); \
        const int _c0 = (((64 * ((_q0 >> 6) + 1)) >> 4) + 7) >> 3; const f16* _kb = PROJ + (_rb + wv * 16 + l16) * NPJ + C_IK + lq * 8; \
        _Pragma("unroll") for (int j = 0; j < 4; ++j) { const int _it = (j < _c0 - 1) ? j : _c0 - 1; const f16* _kp = _kb + (size_t)_it * (128 * NPJ); ka[j][0] = *(const f16x8*)_kp; ka[j][1] = *(const f16x8*)(_kp + 32); } } while (0)
    if (wg < MT / 16) IDX_LOAD_UNIT(wg);
    for (int u = wg; u < MT / 16; u += G) {
        const int b = 2 * (u & 7) + ((u >> 3) & 1), qg = 127 - (u >> 4);
        const int q0 = qg * 16; const size_t rowbase = (size_t)b * SEQ;
        const int nadm = 64 * ((q0 >> 6) + 1);
        float wq[4][8];
#pragma unroll
        for (int r = 0; r < 4; ++r)
#pragma unroll
            for (int hd = 0; hd < 8; ++hd) wq[r][hd] = (float)w8r[r][hd] * (0.35355339059327373f * 0.125f);
        const int ntile = nadm >> 4;
        const int c0 = (ntile + 7) >> 3, cnt = (c0 + 3) & ~3;
        const f16* kbase = PROJ + (rowbase + wv * 16 + l16) * NPJ + C_IK + lq * 8;
        for (int i = 0; i < cnt; i += 4) {
#pragma unroll
            for (int j = 0; j < 4; ++j) {
                const int it = (i + j < c0 - 1) ? i + j : c0 - 1;
                f32x4 sc = {0.f, 0.f, 0.f, 0.f};
                f32x4 a[8];
#pragma unroll
                for (int hd = 0; hd < 8; ++hd) { a[hd] = (f32x4){0.f, 0.f, 0.f, 0.f}; a[hd] = __builtin_amdgcn_mfma_f32_16x16x32_f16(qa[hd][0], ka[j][0], a[hd], 0, 0, 0); }
#pragma unroll
                for (int hd = 0; hd < 8; ++hd) a[hd] = __builtin_amdgcn_mfma_f32_16x16x32_f16(qa[hd][1], ka[j][1], a[hd], 0, 0, 0);
                __builtin_amdgcn_sched_barrier(0);
#pragma unroll
                for (int hd = 0; hd < 8; ++hd)
#pragma unroll
                    for (int r = 0; r < 4; ++r) { const int bi = __float_as_int(a[hd][r]); sc[r] += wq[r][hd] * __int_as_float(bi > 0 ? bi : 0); }
                { const int itn = (i + j + 4 < c0 - 1) ? i + j + 4 : c0 - 1; const f16* kp = kbase + (size_t)itn * (128 * NPJ); ka[j][0] = *(const f16x8*)kp; ka[j][1] = *(const f16x8*)(kp + 32); }
#pragma unroll
                for (int r = 0; r < 4; ++r) SCR[(4 * lq + r) * IDX_PITCH + (wv + 8 * it) * 16 + l16] = sc[r] + 0.0f;
            }
        }
        __syncthreads();
        if (u + G < MT / 16) IDX_LOAD_UNIT(u + G);
#ifndef TOPK_REP
#define TOPK_REP 1
#endif
        if (do_topk) for (int qs = 0; qs < 2 * TOPK_REP; ++qs) {
            const int qq = 2 * wv + (qs & 1);
            unsigned* mrow = MASK + (rowbase + q0 + qq) * 64;
            unsigned word = 0u;
            if (nadm <= 256) {
                word = (lane * 32 < nadm) ? 0xFFFFFFFFu : 0u;
            } else {
                const float* row = SCR + qq * IDX_PITCH;
                if (nadm <= 512) word = topk_words<8>(row, nadm, lane, hist, hdum);
                else if (nadm <= 1024) word = topk_words<16>(row, nadm, lane, hist, hdum);
                else if (nadm <= 1536) word = topk_words<24>(row, nadm, lane, hist, hdum);
                else word = topk_words<32>(row, nadm, lane, hist, hdum);
            }
            mrow[lane] = word;
        }
        __syncthreads();
    }
}
__device__ __forceinline__ void dsa_attn_phase(unsigned char* lds, const f16* PROJ, const f16* KV, const f16* KVT, const unsigned* MASK, const float* BIAS2, const f16* WUVT, f16* OBUF, int G, int wg) {
    const int tid = ltid(), lane = tid & 63, wv = tid >> 6, l32 = lane & 31, hh = lane >> 5;
    f16* KlB = (f16*)lds;
    f16* VlB = (f16*)(lds + 2 * 17408);
    const int hd = wv;
    const float c1 = 0.08838834764831845f * LOG2E;
    const int skey = tid >> 3, skc = (tid & 7) * 16, sdim = tid >> 2, sdc = (tid & 3) * 16;
    f16x8 qraw[8], k0, k1, t0, t1;
#define DSA_UNIT_BQ(U, B_, QI_) do { if (G == 256) { const int _j = wg >> 4, _i = (U) >> 8; B_ = 2 * (wg & 7) + ((wg >> 3) & 1);     QI_ = (_i == 0) ? 63 - _j : (_i == 1) ? 32 + _j : (_i == 2) ? 31 - _j : _j; } \
        else { B_ = (U) & 15; QI_ = 63 - ((U) >> 4); } } while (0)
#define DSA_LOAD_UNIT(U) do { int _b, _qi; DSA_UNIT_BQ(U, _b, _qi); const size_t _rb = (size_t)_b * SEQ; \
        const f16* _qp = PROJ + (_rb + _qi * 32 + l32) * NPJ + C_DQ + hd * 128 + hh * 8; \
        _Pragma("unroll") for (int s_ = 0; s_ < 8; ++s_) qraw[s_] = *(const f16x8*)(_qp + 16 * s_); \
        const f16* _kv = KV + (_rb + skey) * 128 + skc; const f16* _kt = KVT + ((size_t)_b * 128 + sdim) * SEQ + sdc; \
        k0 = *(const f16x8*)_kv; k1 = *(const f16x8*)(_kv + 8); t0 = *(const f16x8*)_kt; t1 = *(const f16x8*)(_kt + 8); } while (0)
    float* BL = (float*)(lds + 77824) + wv * 256;
    { const float* bsrc = BIAS2 + hd * 2112 + 2047 - 192;
#pragma unroll
      for (int i = 0; i < 4; ++i) BL[lane + 64 * i] = bsrc[lane + 64 * i]; }
    float* RED = (float*)(lds + 73728 + 2048);
    int par = 0;
    for (int u = wg; u < 1024; u += G, par ^= 1) {
        int b, qi; DSA_UNIT_BQ(u, b, qi);
        DSA_LOAD_UNIT(u);
        const int q0 = qi * 32; const size_t rowbase = (size_t)b * SEQ;
        const int ntile = (q0 >> 6) + 1;
        f16x8 qf[8];
#pragma unroll
        for (int s = 0; s < 8; ++s)
#pragma unroll
            for (int e = 0; e < 8; ++e) qf[s][e] = (f16)((float)qraw[s][e] * c1);
        const unsigned* mrow = MASK + (rowbase + q0 + l32) * 64;
        const int q = q0 + l32;
        f32x16 accO[4];
#pragma unroll
        for (int d = 0; d < 4; ++d)
#pragma unroll
            for (int r = 0; r < 16; ++r) accO[d][r] = 0.f;
        float mrun = 0.f, lsum = 0.f;
        const f16* kvp = KV + (rowbase + skey) * 128 + skc;
        const f16* ktp = KVT + ((size_t)b * 128 + sdim) * SEQ + sdc;
        __syncthreads();
        { f16* Kw = KlB + skey * 136 + skc; f16* Vw = VlB + sdim * 72 + sdc;
          *(f16x8*)Kw = k0; *(f16x8*)(Kw + 8) = k1; *(f16x8*)Vw = t0; *(f16x8*)(Vw + 8) = t1; }
        __syncthreads();
        for (int kt = 0; kt < ntile; ++kt) {
            const f16* Kl = KlB + (kt & 1) * (64 * 136); const f16* Vl = VlB + (kt & 1) * (128 * 72);
            if (kt + 1 < ntile) { const f16* a = kvp + (size_t)(kt + 1) * 64 * 128; const f16* c = ktp + (kt + 1) * 64;
                k0 = *(const f16x8*)a; k1 = *(const f16x8*)(a + 8); t0 = *(const f16x8*)c; t1 = *(const f16x8*)(c + 8); }
            const u32x2 mw = *(const u32x2*)(mrow + 2 * kt);
            const bool near = (kt * 64 + 63 + 96 > q0);
            const float* bp = BL + 192 - q + kt * 64 + 4 * hh;
            f32x16 S0, S1;
            { const float ninit = -mrun;
#pragma unroll
              for (int r = 0; r < 16; ++r) { S0[r] = ninit; S1[r] = ninit; } }
#define DSA_QK(SX, T_) do { _Pragma("unroll") for (int s4 = 0; s4 < 8; s4 += 4) { f16x8 kf[4]; \
                _Pragma("unroll") for (int s = 0; s < 4; ++s) kf[s] = *(const f16x8*)(Kl + (32 * (T_) + l32) * 136 + 16 * (s4 + s) + 8 * hh); \
                __builtin_amdgcn_sched_barrier(0); __builtin_amdgcn_s_setprio(1); \
                _Pragma("unroll") for (int s = 0; s < 4; ++s) SX = __builtin_amdgcn_mfma_f32_32x32x16_f16(kf[s], qf[s4 + s], SX, 0, 0, 0); __builtin_amdgcn_s_setprio(0); } } while (0)
#define DSA_SOFTMAX(SX, SOTHER, T_, PF) do { \
                if (near) { _Pragma("unroll") for (int g = 0; g < 4; ++g) _Pragma("unroll") for (int e = 0; e < 4; ++e) SX[4 * g + e] += bp[32 * (T_) + 8 * g + e]; } \
                float tmax = SX[0]; _Pragma("unroll") for (int r = 1; r < 16; ++r) tmax = fmaxf(tmax, SX[r]); \
                const bool first = (kt == 0 && (T_) == 0); \
                if (first || __ballot(tmax > 8.0f) != 0ull) { \
                    const float tm2 = fmaxf(tmax, __shfl_xor(tmax, 32)); \
                    const float delta = (first || tm2 > 8.0f) ? tm2 : 0.f; \
                    const float alpha = __builtin_amdgcn_exp2f(-delta); \
                    mrun += delta; lsum *= alpha; \
                    _Pragma("unroll") for (int r = 0; r < 16; ++r) { SX[r] -= delta; if ((T_) == 0) SOTHER[r] -= delta; }     \
                    _Pragma("unroll") for (int d = 0; d < 4; ++d) _Pragma("unroll") for (int r = 0; r < 16; ++r) accO[d][r] *= alpha; } \
                const unsigned wsh = ((T_) == 0 ? mw[0] : mw[1]) >> (4 * hh); \
                float ps = 0.f; \
                _Pragma("unroll") for (int r = 0; r < 16; ++r) { \
                    const float p = __builtin_amdgcn_exp2f(SX[r]); float pm; \
                    asm("v_bfe_i32 %0, %1, %2, 1\n\tv_and_b32 %0, %0, %3" : "=&v"(pm) : "v"(wsh), "n"(8 * (r >> 2) + (r & 3)), "v"(p)); \
                    SX[r] = pm; ps += pm; } \
                lsum += ps; \
                _Pragma("unroll") for (int s = 0; s < 2; ++s) _Pragma("unroll") for (int e = 0; e < 8; ++e) PF[s][e] = (f16)SX[8 * s + e]; } while (0)
#define DSA_PV(PF, T_) do { _Pragma("unroll") for (int d2 = 0; d2 < 4; d2 += 2) { f16x8 vf[2][2]; \
                _Pragma("unroll") for (int d = 0; d < 2; ++d) _Pragma("unroll") for (int s = 0; s < 2; ++s) vf[d][s] = *(const f16x8*)(Vl + (32 * (d2 + d) + l32) * 72 + 32 * (T_) + 16 * s + 8 * hh); \
                __builtin_amdgcn_sched_barrier(0); __builtin_amdgcn_s_setprio(1); \
                _Pragma("unroll") for (int d = 0; d < 2; ++d) _Pragma("unroll") for (int s = 0; s < 2; ++s) accO[d2 + d] = __builtin_amdgcn_mfma_f32_32x32x16_f16(vf[d][s], PF[s], accO[d2 + d], 0, 0, 0); __builtin_amdgcn_s_setprio(0); } } while (0)
            DSA_QK(S0, 0); DSA_QK(S1, 1);
            { f16x8 pf0[2]; DSA_SOFTMAX(S0, S1, 0, pf0); DSA_PV(pf0, 0); }
            { f16x8 pf1[2]; DSA_SOFTMAX(S1, S0, 1, pf1); DSA_PV(pf1, 1); }
#undef DSA_QK
#undef DSA_SOFTMAX
#undef DSA_PV
            if (kt + 1 < ntile) { f16* Kw = KlB + ((kt + 1) & 1) * (64 * 136) + skey * 136 + skc; f16* Vw = VlB + ((kt + 1) & 1) * (128 * 72) + sdim * 72 + sdc;
                *(f16x8*)Kw = k0; *(f16x8*)(Kw + 8) = k1; *(f16x8*)Vw = t0; *(f16x8*)(Vw + 8) = t1; }
            __syncthreads();
        }
        const float ltot = lsum + __shfl_xor(lsum, 32);
        const float inv = 1.0f / ltot;
        f32x16 Z[2];
#pragma unroll
        for (int n = 0; n < 2; ++n)
#pragma unroll
            for (int r = 0; r < 16; ++r) Z[n][r] = 0.f;
#pragma unroll
        for (int dh = 0; dh < 2; ++dh) {
            f16x4 wlo[2][2][2], whi[2][2][2];
#pragma unroll
            for (int d = 0; d < 2; ++d)
#pragma unroll
                for (int s = 0; s < 2; ++s)
#pragma unroll
                    for (int n = 0; n < 2; ++n) {
                        const f16* wp = WUVT + ((size_t)hd * 64 + 32 * n + l32) * 128 + 32 * (2 * dh + d) + 16 * s + 4 * hh;
                        wlo[d][s][n] = *(const f16x4*)wp; whi[d][s][n] = *(const f16x4*)(wp + 8);
                    }
#pragma unroll
            for (int d = 0; d < 2; ++d)
#pragma unroll
                for (int s = 0; s < 2; ++s) {
                    f16x8 ob;
#pragma unroll
                    for (int e = 0; e < 8; ++e) ob[e] = (f16)(accO[2 * dh + d][8 * s + e] * inv);
#pragma unroll
                    for (int n = 0; n < 2; ++n) {
                        const f16x4 lo = wlo[d][s][n], hi = whi[d][s][n];
                        f16x8 wa; wa[0] = lo[0]; wa[1] = lo[1]; wa[2] = lo[2]; wa[3] = lo[3]; wa[4] = hi[0]; wa[5] = hi[1]; wa[6] = hi[2]; wa[7] = hi[3];
                        Z[n] = __builtin_amdgcn_mfma_f32_32x32x16_f16(wa, ob, Z[n], 0, 0, 0);
                    }
                }
        }
        float ssq = 0.f;
#pragma unroll
        for (int n = 0; n < 2; ++n)
#pragma unroll
            for (int r = 0; r < 16; ++r) ssq += Z[n][r] * Z[n][r];
        ssq += __shfl_xor(ssq, 32);
        if (hh == 0) RED[(par * 8 + wv) * 32 + l32] = ssq;
        __syncthreads();
        float tot = 0.f;
#pragma unroll
        for (int w8 = 0; w8 < 8; ++w8) tot += RED[(par * 8 + w8) * 32 + l32];
        const float rstd = rsqrtf(tot * (1.0f / 512.f) + EPS);
        { f16* op = OBUF + (rowbase + q) * DM + 512 + hd * 64 + 4 * hh;
#pragma unroll
          for (int n = 0; n < 2; ++n)
#pragma unroll
            for (int g = 0; g < 4; ++g) { f16x4 o; o[0] = (f16)(Z[n][4 * g] * rstd); o[1] = (f16)(Z[n][4 * g + 1] * rstd); o[2] = (f16)(Z[n][4 * g + 2] * rstd); o[3] = (f16)(Z[n][4 * g + 3] * rstd);
                *(f16x4*)(op + 32 * n + 8 * g) = o; } }
    }
}
constexpr int N_PHASES = 15;
struct Args { Ptrs p; int ph_lo, ph_hi; };

__global__ void __launch_bounds__(NTHR, 2) trunk_fwd(Args args) {
    extern __shared__ __attribute__((aligned(16))) unsigned char lds[];
    const Ptrs& P = args.p;
    unsigned char* ws = P.ws;
    const int G = gridDim.x, wg = blockIdx.x, tid = threadIdx.x;
    const int lo = args.ph_lo, hi = args.ph_hi;
    const bool multi = (hi - lo) > 1;
    XcdBarrier bar; bar.bar = (unsigned*)(ws + WS_CTL); bar.x = 0; bar.st = nullptr;
    if (multi) {
        if (tid < 4) ((LAS unsigned*)(lds + LDS_MISC))[tid] = 0u;
        __syncthreads();
        bar = xcd_barrier_post((unsigned*)(ws + WS_CTL), (volatile LAS unsigned*)(lds + LDS_MISC));
    }
#ifndef REP_IDX
#define REP_IDX 1
#endif
#ifndef REP_IDX_SCORE_ONLY
#define REP_IDX_SCORE_ONLY 0
#endif
#ifndef REP_SB
#define REP_SB 1
#endif
#ifndef REP_DSA
#define REP_DSA 1
#endif
#ifndef REP_GIN
#define REP_GIN 1
#endif
#ifndef REP_GUP
#define REP_GUP 1
#endif
#ifndef PHMASK
#define PHMASK 0xFFFFF
#endif
#define IN(k) (lo <= (k) && (k) < hi)
#define PM(j) ((PHMASK >> (j)) & 1)
#define SEAM(k) do { if (IN(k) && IN((k) + 1)) xcd_barrier(bar); } while (0)
    float* MOD = (float*)(ws + WS_MOD);
    f16* H = (f16*)(ws + WS_H); f16* PROJ = (f16*)(ws + WS_PROJ); f16* OBUF = (f16*)(ws + WS_OBUF); f16* HID = (f16*)(ws + WS_HID);
    f16* KV = (f16*)(ws + WS_KV); f16* KVT = (f16*)(ws + WS_KVT); f16* VTA = (f16*)(ws + WS_VTA); unsigned* MASK = (unsigned*)(ws + WS_MASK);
    float* X = P.out;

    float* SSQ = (float*)(ws + WS_SSQ); float* BW = (float*)(ws + WS_BW);
    if (PM(0) && IN(0)) { prologue_phase(lds, P, G, wg); SEAM(0); }
    if (PM(1) && IN(1)) {
        bw_phase(lds, P, MOD, BW, G, wg);
        prenorm0_phase(P.x, P.g_attn, MOD + 1 * DM, H, SSQ, G, wg);
        SEAM(1);
    }

    for (int l = 0; l < NLAYER; ++l) {
        const int pb = 2 + 6 * l;
        const float* modl = MOD + (size_t)l * 16 * 6144;
        const float* xin = (l == 0) ? P.x : X;
        const float* ssq1 = SSQ + (size_t)(l == 0 ? 0 : 2) * MT;
        float* ssq2 = SSQ + (size_t)(l == 0 ? 1 : 3) * MT;
        if (PM(2) && IN(pb + 0)) {
            pg8::Gemm g{H, (const f16*)(ws + WS_WIN) + (size_t)l * NPJ * DM, MT, NPJ, DM}; pg8::StaticOrder S; S.init(MT, NPJ, G, wg);
            pg8::EpiF16N<0> E{PROJ, NPJ, ssq1, BW + (size_t)(l * 2 + 0) * 16 * 4096};
            for (int rep = 0; rep < REP_GIN; ++rep) pg8::gemm_phase<pg8::EpiF16N<0>, pg8::StaticOrder>((LAS unsigned char*)lds, g, S, E);
            SEAM(pb + 0);
        }
        if (PM(3) && IN(pb + 1)) {
#if ENABLE_DSA
            kvnorm_phase(lds, PROJ, P.kv_norm_g + l * 128, KV, KVT, G, wg);
            __syncthreads();
#endif
#if ENABLE_SB
            vtrans_phase(lds, PROJ, VTA, G, wg);
            __syncthreads();
#endif
#if ENABLE_DSA
            for (int rep = 0; rep < REP_IDX; ++rep) { indexer_phase(lds, PROJ, MASK, G, wg, rep == 0 || !REP_IDX_SCORE_ONLY); __syncthreads(); }
#endif
            SEAM(pb + 1);
        }
        if (PM(4) && IN(pb + 2)) {
            for (int rep = 0; rep < REP_SB; ++rep) { sb_attn_phase(lds, PROJ, VTA, OBUF, G, wg); }
            for (int rep = 0; rep < REP_DSA; ++rep) { __syncthreads(); dsa_attn_phase(lds, PROJ, KV, KVT, MASK, (const float*)(ws + WS_BIAS), (const f16*)(ws + WS_WUV) + (size_t)l * 8 * 64 * 128, OBUF, G, wg); }
            SEAM(pb + 2);
        }
        if (PM(6) && IN(pb + 3)) {
            pg8::Gemm g{OBUF, (const f16*)(ws + WS_WOUT) + (size_t)l * DM * DM, MT, DM, DM}; pg8::StaticOrder S; S.init(MT, DM, G, wg);
            pg8::EpiResidN E{xin, X, modl + 2 * DM, P.g_mlp + l * DM, modl + 4 * DM, H, ssq2};
            pg8::gemm_phase<pg8::EpiResidN, pg8::StaticOrder>((LAS unsigned char*)lds, g, S, E);
            SEAM(pb + 3);
        }
        if (PM(8) && IN(pb + 4)) {
            pg8::Gemm g{H, (const f16*)(ws + WS_WUP) + (size_t)l * FF * DM, MT, FF, DM}; pg8::StaticOrder S; S.init(MT, FF, G, wg);
            pg8::EpiF16N<1> E{HID, FF, ssq2, BW + (size_t)(l * 2 + 1) * 16 * 4096};
            for (int rep = 0; rep < REP_GUP; ++rep) pg8::gemm_phase<pg8::EpiF16N<1>, pg8::StaticOrder>((LAS unsigned char*)lds, g, S, E);
            SEAM(pb + 4);
        }
        if (PM(9) && IN(pb + 5)) {
            pg8::Gemm g{HID, (const f16*)(ws + WS_WDN) + (size_t)l * DM * FF, MT, DM, FF}; pg8::StaticOrder S; S.init(MT, DM, G, wg);
            if (l == 0) {
                pg8::EpiResidN E{X, X, modl + 5 * DM, P.g_attn + DM, MOD + (size_t)16 * 6144 + 1 * DM, H, SSQ + (size_t)2 * MT};
                pg8::gemm_phase<pg8::EpiResidN, pg8::StaticOrder>((LAS unsigned char*)lds, g, S, E);
            } else {
                pg8::EpiResid E{X, X, modl + 5 * DM};
                pg8::gemm_phase<pg8::EpiResid, pg8::StaticOrder>((LAS unsigned char*)lds, g, S, E);
            }
            SEAM(pb + 5);
        }
    }
    if (PM(10) && IN(14)) { final_norm_phase(X, P.g_final, P.out, G, wg); }
#undef IN
#undef SEAM
}

extern "C" void kernel_launch(void* const* d_in, const int* in_sizes, int n_in, void* d_out, int out_size, void* d_ws, size_t ws_size, hipStream_t stream) {
    static int grid = 0;
    if (grid == 0) {
        if (n_in != 16 || in_sizes[0] != MT * DM || out_size != MT * DM || ws_size < WS_END) {
            fprintf(stderr, "kernel_launch: unexpected shapes: n_in %d in0 %d out %d ws %zu (need %zu)\n", n_in, n_in > 0 ? in_sizes[0] : -1, out_size, ws_size, (size_t)WS_END); grid = -1; return; }
        int dev = 0, cus = 0, per_cu = 0;
        if (hipGetDevice(&dev) != hipSuccess || hipDeviceGetAttribute(&cus, hipDeviceAttributeMultiprocessorCount, dev) != hipSuccess) { grid = -1; return; }
        if (hipFuncSetAttribute((const void*)trunk_fwd, hipFuncAttributeMaxDynamicSharedMemorySize, LDS_BYTES) != hipSuccess) { fprintf(stderr, "kernel_launch: hipFuncSetAttribute failed\n"); grid = -1; return; }
        if (hipOccupancyMaxActiveBlocksPerMultiprocessor(&per_cu, (const void*)trunk_fwd, NTHR, LDS_BYTES) != hipSuccess || per_cu < 1) fprintf(stderr, "kernel_launch: occupancy query says %d\n", per_cu);
        (void)hipGetLastError();
        grid = cus;
    }
    if (grid < 0) return;
    (void)hipMemsetAsync((char*)d_ws + WS_CTL, 0, CTL_BYTES, stream);
    Args a{};
    a.p.x = (const float*)d_in[0]; a.p.c = (const float*)d_in[1]; a.p.w_mod = (const float*)d_in[2]; a.p.b_mod = (const float*)d_in[3]; a.p.g_attn = (const float*)d_in[4];
    a.p.w_in = (const float*)d_in[5]; a.p.kv_norm_g = (const float*)d_in[6]; a.p.w_uv = (const float*)d_in[7]; a.p.g_out_a = (const float*)d_in[8]; a.p.g_out_b = (const float*)d_in[9];
    a.p.w_out = (const float*)d_in[10]; a.p.g_mlp = (const float*)d_in[11]; a.p.w_up = (const float*)d_in[12]; a.p.w_down = (const float*)d_in[13]; a.p.rel_bias = (const float*)d_in[14];
    a.p.g_final = (const float*)d_in[15]; a.p.out = (float*)d_out; a.p.ws = (unsigned char*)d_ws;
#if N_LAUNCH_MODE == 1
    a.ph_lo = 0; a.ph_hi = N_PHASES;
    hipLaunchKernelGGL(trunk_fwd, dim3(grid), dim3(NTHR), LDS_BYTES, stream, a);
#else
    for (int ph = 0; ph < N_PHASES; ++ph) { a.ph_lo = ph; a.ph_hi = ph + 1; hipLaunchKernelGGL(trunk_fwd, dim3(grid), dim3(NTHR), LDS_BYTES, stream, a); }
#endif
}
```

```cpp
#include <hip/hip_runtime.h>
#include <cstdio>
#include <cstdint>

#define LAS __attribute__((address_space(3)))
typedef _Float16 f16;
typedef _Float16 f16x8 __attribute__((ext_vector_type(8)));
typedef _Float16 f16x4 __attribute__((ext_vector_type(4)));
typedef float f32x2 __attribute__((ext_vector_type(2)));
typedef float f32x4 __attribute__((ext_vector_type(4)));
typedef float f32x16 __attribute__((ext_vector_type(16)));
typedef unsigned u32x2 __attribute__((ext_vector_type(2)));
typedef unsigned u32x4 __attribute__((ext_vector_type(4)));

#ifndef N_LAUNCH_MODE
#define N_LAUNCH_MODE 1
#endif
#ifndef ENABLE_SB
#define ENABLE_SB 1
#endif
#ifndef ENABLE_DSA
#define ENABLE_DSA 1
#endif

constexpr int NB = 16, SEQ = 2048, DM = 1024, MT = NB * SEQ, NPJ = 3328, NPJ_VALID = 3272, FF = 4096, NLAYER = 2;
constexpr int C_SBQ = 0, C_SBK = 512, C_SBV = 1024, C_DQ = 1536, C_DKV = 2560, C_IQ = 2688, C_IK = 3200, C_IW = 3264;
constexpr int NWAVES = 8, NTHR = 512;
constexpr float EPS = 1e-6f;
constexpr float LOG2E = 1.4426950408889634f;

constexpr size_t al256(size_t x) { return (x + 255) & ~(size_t)255; }
constexpr size_t WS_CTL = 0;
constexpr size_t CTL_BYTES = 65536;
constexpr size_t WS_MOD = WS_CTL + CTL_BYTES;
constexpr size_t WS_BIAS = WS_MOD + al256((size_t)2 * 16 * 6144 * 4);
constexpr size_t WS_SSQ = WS_BIAS + al256((size_t)8 * 2112 * 4);
constexpr size_t WS_BW = WS_SSQ + (size_t)4 * MT * 4;
constexpr size_t WS_WIN = WS_BW + (size_t)2 * 2 * 16 * 4096 * 4;
constexpr size_t WS_WOUT = WS_WIN + (size_t)2 * NPJ * DM * 2;
constexpr size_t WS_WUP = WS_WOUT + (size_t)2 * DM * DM * 2;
constexpr size_t WS_WDN = WS_WUP + (size_t)2 * FF * DM * 2;
constexpr size_t WS_WUV = WS_WDN + (size_t)2 * FF * DM * 2;
constexpr size_t WS_H = WS_WUV + (size_t)2 * 8 * 64 * 128 * 2;
constexpr size_t WS_KV = WS_H + (size_t)MT * DM * 2;
constexpr size_t WS_KVT = WS_KV + (size_t)MT * 128 * 2;
constexpr size_t WS_VTA = WS_KVT + (size_t)MT * 128 * 2;
constexpr size_t WS_MASK = WS_VTA + (size_t)MT * 512 * 2;
constexpr size_t WS_PROJ = WS_MASK + (size_t)MT * 64 * 4;
constexpr size_t WS_OBUF = WS_PROJ + (size_t)MT * NPJ * 2;
constexpr size_t WS_HID = WS_PROJ;
constexpr size_t WS_END = WS_OBUF + (size_t)MT * DM * 2;
static_assert((size_t)MT * FF * 2 <= WS_END - WS_PROJ, "HID overlay must fit");

constexpr int LDS_BYTES = 147456;
constexpr int LDS_MISC = 135168;

__device__ __forceinline__ float wave_sum(float v) {
    v += __shfl_xor(v, 32); v += __shfl_xor(v, 16); v += __shfl_xor(v, 8); v += __shfl_xor(v, 4); v += __shfl_xor(v, 2); v += __shfl_xor(v, 1); return v;
}
__device__ __forceinline__ float half_sum(float v) {
    v += __shfl_xor(v, 16); v += __shfl_xor(v, 8); v += __shfl_xor(v, 4); v += __shfl_xor(v, 2); v += __shfl_xor(v, 1); return v;
}

__device__ __forceinline__ int ltid() { int t = threadIdx.x; asm volatile("" : "+v"(t)); return t; }

__device__ __forceinline__ int wave_sum_i(int v) {
    v += __builtin_amdgcn_update_dpp(0, v, 0xB1, 0xf, 0xf, true);
    v += __builtin_amdgcn_update_dpp(0, v, 0x4E, 0xf, 0xf, true);
    v += __builtin_amdgcn_update_dpp(0, v, 0x141, 0xf, 0xf, true);
    v += __builtin_amdgcn_update_dpp(0, v, 0x140, 0xf, 0xf, true);
    return __builtin_amdgcn_readlane(v, 0) + __builtin_amdgcn_readlane(v, 16) + __builtin_amdgcn_readlane(v, 32) + __builtin_amdgcn_readlane(v, 48);
}

__device__ __forceinline__ int kperm16(int k) { return (k & ~12) | ((k & 8) >> 1) | ((k & 4) << 1); }
#define XB_TMO      128
#define XB_XCNT(j)  (256  + 64 * (j))
#define XB_XSUB(j)  (1280 + 64 * (j))
#define XB_XGEN(j)  (2304 + 64 * (j))
#define XB_TOP      3328
#define XB_TOPGEN   3392
#define XCD_BAR_WORDS 3456
#define XB_SPIN_CAP (1u << 18)

__device__ __forceinline__ unsigned xb_ld(unsigned* p)              { return __hip_atomic_load(p, __ATOMIC_RELAXED, __HIP_MEMORY_SCOPE_AGENT); }
__device__ __forceinline__ unsigned xb_add(unsigned* p, unsigned v) { return __hip_atomic_fetch_add(p, v, __ATOMIC_RELAXED, __HIP_MEMORY_SCOPE_AGENT); }
__device__ __forceinline__ unsigned xb_xcc_id() { return (unsigned)__builtin_amdgcn_s_getreg((3 << 11) | 20) & 0xFu; }
#define XB_SPIN(cond, bar) do { unsigned _sp = 0; while (cond) { __builtin_amdgcn_s_sleep(1); \
    if ((++_sp & 255u) == 0u) { if (xb_ld(&(bar)[XB_TMO])) break; if (_sp > XB_SPIN_CAP) { atomicAdd(&(bar)[XB_TMO], 1u); break; } } } } while (0)

struct XcdBarrier {
    unsigned* bar; unsigned x;
    volatile LAS unsigned* st;
};

__device__ __forceinline__ XcdBarrier xcd_barrier_post(unsigned* bar, volatile LAS unsigned* st) {
    XcdBarrier b; b.bar = bar; b.x = xb_xcc_id(); b.st = st;
    if (threadIdx.x == 0) (void)xb_add(&bar[XB_XCNT(b.x)], 1u);
    return b;
}
__device__ __forceinline__ void xcd_barrier_complete(unsigned* bar, unsigned x, unsigned& nloc, unsigned& nx) {
    const unsigned G = gridDim.x * gridDim.y * gridDim.z;
    unsigned sum, cnt, mine, sp = 0u;
    for (;;) {
        sum = 0u; cnt = 0u; mine = 0u;
#pragma unroll
        for (unsigned j = 0; j < 16; ++j) { const unsigned c = xb_ld(&bar[XB_XCNT(j)]); sum += c; cnt += (c > 0u) ? 1u : 0u; mine = (j == x) ? c : mine; }
        if (sum == G) break;
        __builtin_amdgcn_s_sleep(1);
        if ((++sp & 255u) == 0u) { if (xb_ld(&bar[XB_TMO])) break; if (sp > XB_SPIN_CAP) { atomicAdd(&bar[XB_TMO], 1u); break; } }
    }
    nloc = mine > 0u ? mine : 1u; nx = cnt > 0u ? cnt : 1u;
}

__device__ __forceinline__ void xcd_barrier(const XcdBarrier& b) {
    asm volatile("s_waitcnt vmcnt(0)" ::: "memory");
    __syncthreads();
    if (threadIdx.x == 0) {
        unsigned* bar = b.bar;
        __builtin_amdgcn_s_waitcnt(0);
        unsigned nloc = b.st[0], nx = b.st[1];
        if (nloc == 0u) { xcd_barrier_complete(bar, b.x, nloc, nx); b.st[0] = nloc; b.st[1] = nx; }
        const unsigned old = xb_add(&bar[XB_XSUB(b.x)], 1u);
        const unsigned gen = old / nloc;
        if (old + 1u == (gen + 1u) * nloc) {
            __builtin_amdgcn_fence(__ATOMIC_RELEASE, "agent");
            asm volatile("s_waitcnt vmcnt(0)" ::: "memory");
            const unsigned og = xb_add(&bar[XB_TOP], 1u);
            const unsigned tg = og / nx;
            if (og + 1u == (tg + 1u) * nx) xb_add(&bar[XB_TOPGEN], 1u);
            else XB_SPIN(xb_ld(&bar[XB_TOPGEN]) == tg, bar);
            __builtin_amdgcn_fence(__ATOMIC_ACQUIRE, "agent");
            xb_add(&bar[XB_XGEN(b.x)], 1u);
            asm volatile("s_waitcnt vmcnt(0)" ::: "memory");
        } else {
            XB_SPIN(xb_ld(&bar[XB_XGEN(b.x)]) == gen, bar);
            __builtin_amdgcn_fence(__ATOMIC_ACQUIRE, "agent");
            asm volatile("s_waitcnt vmcnt(0)" ::: "memory");
        }
    }
    __syncthreads();
}

namespace pg8 {
constexpr int BM = 256, BK = 64, HALF = 128, HTB = HALF * BK * 2  , STAGE_BYTES = 8 * HTB, NXCD = 8, WGM = 4;

__host__ __device__ __forceinline__ int lds_byte(int r, int c) { const int st = (r >> 4) * 2 + (c >> 5), rr = r & 15, cc = c & 31, ob = rr * 64 + cc * 2; return st * 1024 + (ob ^ (((ob >> 9) & 1) << 5)); }
__host__ __device__ __forceinline__ void stage_rc(int b, int& R, int& C) { const int st = b / 1024, sb = b % 1024, swz = sb ^ (((sb >> 9) & 1) << 5); R = (st >> 1) * 16 + swz / 64; C = (st & 1) * 32 + (swz % 64) / 2; }
__host__ __device__ __forceinline__ int perm32(int rho) { const int n = rho >> 4, i = rho & 15; return 8 * (i >> 2) + 4 * n + (i & 3); }

struct Unit { int pm, pn; };
struct Gemm { const f16* A; const f16* Bt; int M, N, K; };

struct StaticOrder {
    int nM, nN, nwg, G, c;
    __host__ __device__ void init(int M, int N, int G_, int c_) { nM = M / BM; nN = N / BM; nwg = nM * nN; G = G_; c = c_; }
    __host__ __device__ bool next(int i, Unit& u) const {
        const long L = (long)i * G + c; if (L >= nwg) return false;
        int wgid = (int)L;
#ifndef NO_XCD_REMAP
        { const int q = nwg / NXCD, r = nwg % NXCD, xcd = wgid % NXCD, off = wgid / NXCD; wgid = (xcd < r ? xcd * (q + 1) : r * (q + 1) + (xcd - r) * q) + off; }
#endif
        const int nig = WGM * nN, gid = wgid / nig, fm = gid * WGM, gsz = (nM - fm) < WGM ? (nM - fm) : WGM;
        u.pm = fm + ((wgid % nig) % gsz); u.pn = (wgid % nig) / gsz; return true;
    }
    __device__ __forceinline__ void a_ready(const Unit&) const {}
    __device__ __forceinline__ void done(const Unit&) const {}
};

struct EpiResid {
    static constexpr bool PERM = true, AFTER_DRAIN = false, PREFETCH = false;
    const float* base; float* out; const float* gate;
    __device__ __forceinline__ void operator()(const f32x4 (&acc)[2][2][4][2], const Unit& u, int wr, int wc, int fr, int fq) const {
        const int row0 = u.pm * BM + wr * 64 + fr; const int col0 = u.pn * BM + wc * 32 + 8 * fq;
        const float* gp = gate + (size_t)((u.pm * BM) >> 11) * 6144 + col0;
        f32x4 gv[2][2];
#pragma unroll
        for (int bj = 0; bj < 2; ++bj)
#pragma unroll
            for (int n = 0; n < 2; ++n) gv[bj][n] = *(const f32x4*)(gp + bj * HALF + 4 * n);
#pragma unroll
        for (int ai = 0; ai < 2; ++ai)
#pragma unroll
            for (int m = 0; m < 4; ++m) { const size_t ro = (size_t)(row0 + ai * HALF + m * 16) * DM + col0;
#pragma unroll
                for (int bj = 0; bj < 2; ++bj)
#pragma unroll
                    for (int n = 0; n < 2; ++n) { const f32x4 x = *(const f32x4*)(base + ro + bj * HALF + 4 * n);
                        *(f32x4*)(out + ro + bj * HALF + 4 * n) = x + gv[bj][n] * acc[ai][bj][m][n]; } }
    }
};
template <int ACT  > struct EpiF16N {
    static constexpr bool PERM = true, AFTER_DRAIN = false, PREFETCH = true;
    f16* O; int ldc; const float* ssq; const float* bw;
    __device__ __forceinline__ void prefetch(LAS unsigned char* aux, const Unit& u, int tid, int wid) const {
        const float* src = (tid < 256) ? ssq + u.pm * BM + tid : bw + (size_t)((u.pm * BM) >> 11) * 4096 + u.pn * BM + (tid - 256);
        __builtin_amdgcn_global_load_lds((const unsigned*)src, (LAS unsigned*)(aux + wid * 256), 4, 0, 0);
    }
    __device__ __forceinline__ void with_lds(const f32x4 (&acc)[2][2][4][2], const Unit& u, int wr, int wc, int fr, int fq, LAS unsigned char* aux) const {
        const int row0 = u.pm * BM + wr * 64 + fr; const int col0 = u.pn * BM + wc * 32 + 8 * fq;
        const LAS float* sq = (const LAS float*)aux; const LAS float* bl = (const LAS float*)(aux + 1024) + wc * 32 + 8 * fq;
        f32x4 bv[2][2];
#pragma unroll
        for (int bj = 0; bj < 2; ++bj)
#pragma unroll
            for (int n = 0; n < 2; ++n) bv[bj][n] = *(const LAS f32x4*)(bl + bj * HALF + 4 * n);
        float rs[2][4];
#pragma unroll
        for (int ai = 0; ai < 2; ++ai)
#pragma unroll
            for (int m = 0; m < 4; ++m) rs[ai][m] = rsqrtf(sq[wr * 64 + fr + ai * HALF + m * 16] * (1.0f / DM) + EPS);
#pragma unroll
        for (int ai = 0; ai < 2; ++ai)
#pragma unroll
            for (int m = 0; m < 4; ++m) { f16* rowp = O + (size_t)(row0 + ai * HALF + m * 16) * ldc + col0;
#pragma unroll
                for (int bj = 0; bj < 2; ++bj) { f32x4 v0 = acc[ai][bj][m][0] * rs[ai][m] + bv[bj][0], v1 = acc[ai][bj][m][1] * rs[ai][m] + bv[bj][1];
                    if (ACT == 1) {
#pragma unroll
                        for (int e = 0; e < 4; ++e) { const float a = fmaxf(v0[e], 0.f), b = fmaxf(v1[e], 0.f); v0[e] = a * a; v1[e] = b * b; } }
                    f16x8 w; w[0] = (f16)v0[0]; w[1] = (f16)v0[1]; w[2] = (f16)v0[2]; w[3] = (f16)v0[3]; w[4] = (f16)v1[0]; w[5] = (f16)v1[1]; w[6] = (f16)v1[2]; w[7] = (f16)v1[3];
                    *(f16x8*)(rowp + bj * HALF) = w; } }
    }
    __device__ __forceinline__ void operator()(const f32x4 (&)[2][2][4][2], const Unit&, int, int, int, int) const {}
};
struct EpiResidN {
    static constexpr bool PERM = true, AFTER_DRAIN = false, PREFETCH = false;
    const float* base; float* out; const float* gate; const float* gain; const float* scale; f16* An; float* ssq;
    __device__ __forceinline__ void operator()(const f32x4 (&acc)[2][2][4][2], const Unit& u, int wr, int wc, int fr, int fq) const {
        const int row0 = u.pm * BM + wr * 64 + fr; const int col0 = u.pn * BM + wc * 32 + 8 * fq;
        const size_t bo = (size_t)((u.pm * BM) >> 11) * 6144 + col0;
        f32x4 gv[2][2], al[2][2];
#pragma unroll
        for (int bj = 0; bj < 2; ++bj)
#pragma unroll
            for (int n = 0; n < 2; ++n) { gv[bj][n] = *(const f32x4*)(gate + bo + bj * HALF + 4 * n);
                const f32x4 g4 = *(const f32x4*)(gain + col0 + bj * HALF + 4 * n), s4 = *(const f32x4*)(scale + bo + bj * HALF + 4 * n); al[bj][n] = g4 * (1.0f + s4); }
#pragma unroll
        for (int ai = 0; ai < 2; ++ai)
#pragma unroll
            for (int m = 0; m < 4; ++m) { const int row = row0 + ai * HALF + m * 16; const size_t ro = (size_t)row * DM + col0; float sq = 0.f;
#pragma unroll
                for (int bj = 0; bj < 2; ++bj) {
                    const f32x4 x0 = *(const f32x4*)(base + ro + bj * HALF), x1 = *(const f32x4*)(base + ro + bj * HALF + 4);
                    const f32x4 y0 = x0 + gv[bj][0] * acc[ai][bj][m][0], y1 = x1 + gv[bj][1] * acc[ai][bj][m][1];
                    *(f32x4*)(out + ro + bj * HALF) = y0; *(f32x4*)(out + ro + bj * HALF + 4) = y1;
                    sq += ((y0[0] * y0[0] + y0[1] * y0[1]) + (y0[2] * y0[2] + y0[3] * y0[3])) + ((y1[0] * y1[0] + y1[1] * y1[1]) + (y1[2] * y1[2] + y1[3] * y1[3]));
                    const f32x4 z0 = y0 * al[bj][0], z1 = y1 * al[bj][1]; f16x8 zz;
                    zz[0] = (f16)z0[0]; zz[1] = (f16)z0[1]; zz[2] = (f16)z0[2]; zz[3] = (f16)z0[3]; zz[4] = (f16)z1[0]; zz[5] = (f16)z1[1]; zz[6] = (f16)z1[2]; zz[7] = (f16)z1[3];
                    *(f16x8*)(An + ro + bj * HALF) = zz; }
                sq += __shfl_xor(sq, 16); sq += __shfl_xor(sq, 32);
                if (fq == 0) __hip_atomic_fetch_add(ssq + row, sq, __ATOMIC_RELAXED, __HIP_MEMORY_SCOPE_AGENT); }
    }
};

template <class Epi, class Sched>
__device__ __forceinline__ void gemm_phase(LAS unsigned char* lds, const Gemm g, const Sched& S, const Epi& E) {
    const int tid = ltid(), wid = __builtin_amdgcn_readfirstlane(tid >> 6), lane = tid & 63, wr = wid >> 2, wc = wid & 3, fr = lane & 15, fq = lane >> 4;
    const int K = g.K, nt = K / BK;
    unsigned voffA[2], voffB[2];
#pragma unroll
    for (int i = 0; i < 2; ++i) { int R, C; stage_rc(tid * 16 + i * 8192, R, C); const int Rb = Epi::PERM ? ((R & ~31) + perm32(R & 31)) : R;
        voffA[i] = (unsigned)(R * K + C) * 2u; voffB[i] = (unsigned)(Rb * K + C) * 2u; }
    const size_t kstep = (size_t)(BK * 2);
    const size_t hstep = (size_t)HALF * K * 2;
    const size_t tstep = 2 * hstep;
    const unsigned ldsw = (unsigned)wid * 1024u;
    const int aoff = lds_byte(wr * 64 + fr, fq * 8), boff = lds_byte(wc * 32 + fr, fq * 8);
#define PG8_SA(b, h) (((b) * 2 + (h)) * HTB)
#define PG8_SB(b, h) ((4 + (b) * 2 + (h)) * HTB)
#define PG8_STAGE(bufoff, gbase, voff) do { _Pragma("unroll") for (int _i = 0; _i < 2; ++_i) \
        __builtin_amdgcn_global_load_lds((const unsigned*)((const char*)(gbase) + (voff)[_i]), (LAS unsigned*)(lds + (bufoff) + ldsw + _i * 8192), 16, 0, 0); } while (0)
#define PG8_LDA(dst, b, h) do { _Pragma("unroll") for (int m = 0; m < 4; ++m) _Pragma("unroll") for (int k = 0; k < 2; ++k) dst[m][k] = *(const LAS f16x8*)(lds + PG8_SA(b, h) + aoff + m * 2048 + k * 1024); } while (0)
#define PG8_LDB(dst, b, h) do { _Pragma("unroll") for (int n = 0; n < 2; ++n) _Pragma("unroll") for (int k = 0; k < 2; ++k) dst[n][k] = *(const LAS f16x8*)(lds + PG8_SB(b, h) + boff + n * 2048 + k * 1024); } while (0)
#define PG8_MMA(ai, bj, At, Bt) do { __builtin_amdgcn_s_setprio(1); _Pragma("unroll") for (int m = 0; m < 4; ++m) _Pragma("unroll") for (int n = 0; n < 2; ++n) _Pragma("unroll") for (int k = 0; k < 2; ++k) \
        acc[ai][bj][m][n] = __builtin_amdgcn_mfma_f32_16x16x32_f16(Bt[n][k], At[m][k], acc[ai][bj][m][n], 0, 0, 0); __builtin_amdgcn_s_setprio(0); } while (0)
#define PG8_WAIT_V(n) asm volatile("s_waitcnt vmcnt(" #n ")" ::: "memory")
#define PG8_WAIT_L(n) asm volatile("s_waitcnt lgkmcnt(" #n ")" ::: "memory")
#define PG8_BAR __builtin_amdgcn_s_barrier()
#define PG8_SCHED __builtin_amdgcn_sched_barrier(0)
    Unit cur, nxt; int ui = 0;
    if (!S.next(0, cur)) return;
    f32x4 acc[2][2][4][2];
#pragma unroll
    for (int a = 0; a < 2; ++a)
#pragma unroll
        for (int b = 0; b < 2; ++b)
#pragma unroll
            for (int m = 0; m < 4; ++m)
#pragma unroll
                for (int n = 0; n < 2; ++n) acc[a][b][m][n] = (f32x4){0.f, 0.f, 0.f, 0.f};
    f16x8 At[4][2], B0[2][2], B1[2][2];
    const char* cA = (const char*)g.A + (size_t)cur.pm * tstep; const char* cB = (const char*)g.Bt + (size_t)cur.pn * tstep;
    S.a_ready(cur);
    if constexpr (Epi::PREFETCH) E.prefetch(lds + STAGE_BYTES, cur, tid, wid);
    PG8_STAGE(PG8_SB(0, 0), cB, voffB); PG8_STAGE(PG8_SB(0, 1), cB + hstep, voffB); PG8_STAGE(PG8_SA(0, 0), cA, voffA); PG8_STAGE(PG8_SA(0, 1), cA + hstep, voffA);
    if (wr == 1) PG8_BAR;
    PG8_WAIT_V(2); PG8_BAR;
    PG8_STAGE(PG8_SB(1, 0), cB + kstep, voffB); PG8_STAGE(PG8_SA(1, 0), cA + kstep, voffA); PG8_STAGE(PG8_SB(1, 1), cB + hstep + kstep, voffB);
    PG8_WAIT_V(6); PG8_BAR;
    for (;;) {
        const bool has_next = S.next(ui + 1, nxt);
        const char* nA = has_next ? (const char*)g.A + (size_t)nxt.pm * tstep : cA; const char* nB = has_next ? (const char*)g.Bt + (size_t)nxt.pn * tstep : cB;
        for (int t = 0; t < nt; t += 2) {
            const bool last = (t == nt - 2);
            const char* a1 = cA + (size_t)(t + 1) * kstep;
            const char* a2 = last ? nA : cA + (size_t)(t + 2) * kstep; const char* b2 = last ? nB : cB + (size_t)(t + 2) * kstep;
            const char* a3 = a2 + kstep; const char* b3 = b2 + kstep;
            if (last && has_next) S.a_ready(nxt);
            PG8_LDB(B0, 0, 0); PG8_LDB(B1, 0, 1); PG8_SCHED; PG8_LDA(At, 0, 0); PG8_STAGE(PG8_SA(1, 1), a1 + hstep, voffA);
            PG8_WAIT_V(8); PG8_WAIT_L(0); PG8_BAR; PG8_MMA(0, 0, At, B0); PG8_MMA(0, 1, At, B1); PG8_BAR; PG8_SCHED;
            PG8_LDA(At, 0, 1); PG8_STAGE(PG8_SB(0, 0), b2, voffB); PG8_STAGE(PG8_SB(0, 1), b2 + hstep, voffB); PG8_STAGE(PG8_SA(0, 0), a2, voffA);
            PG8_WAIT_V(8); PG8_WAIT_L(0); PG8_BAR; PG8_MMA(1, 0, At, B0); PG8_MMA(1, 1, At, B1); PG8_BAR; PG8_SCHED;
            PG8_LDB(B0, 1, 0); PG8_LDB(B1, 1, 1); PG8_SCHED; PG8_LDA(At, 1, 0); PG8_STAGE(PG8_SA(0, 1), a2 + hstep, voffA);
            PG8_WAIT_V(8); PG8_WAIT_L(0); PG8_BAR; PG8_MMA(0, 0, At, B0); PG8_MMA(0, 1, At, B1); PG8_BAR; PG8_SCHED;
            PG8_LDA(At, 1, 1); PG8_STAGE(PG8_SB(1, 0), b3, voffB); PG8_STAGE(PG8_SB(1, 1), b3 + hstep, voffB); PG8_STAGE(PG8_SA(1, 0), a3, voffA);
            PG8_WAIT_V(8); PG8_WAIT_L(0); PG8_BAR; PG8_MMA(1, 0, At, B0); PG8_MMA(1, 1, At, B1); PG8_BAR; PG8_SCHED;
        }
        if (wr == 0) PG8_BAR;
        if constexpr (Epi::PREFETCH) E.with_lds(acc, cur, wr, wc, fr, fq, lds + STAGE_BYTES + (ui & 1) * 2048); else E(acc, cur, wr, wc, fr, fq);
        S.done(cur);
        if (!has_next) break;
#pragma unroll
        for (int a = 0; a < 2; ++a)
#pragma unroll
            for (int b = 0; b < 2; ++b)
#pragma unroll
                for (int m = 0; m < 4; ++m)
#pragma unroll
                    for (int n = 0; n < 2; ++n) acc[a][b][m][n] = (f32x4){0.f, 0.f, 0.f, 0.f};
        cur = nxt; cA = nA; cB = nB; ++ui;
        if constexpr (Epi::PREFETCH) E.prefetch(lds + STAGE_BYTES + (ui & 1) * 2048, cur, tid, wid);
        if (wr == 1) PG8_BAR;
    }
    PG8_WAIT_V(0);
    PG8_BAR;
#undef PG8_SA
#undef PG8_SB
#undef PG8_STAGE
#undef PG8_LDA
#undef PG8_LDB
#undef PG8_MMA
#undef PG8_WAIT_V
#undef PG8_WAIT_L
#undef PG8_BAR
#undef PG8_SCHED
}
}
struct Ptrs {
    const float *x, *c, *w_mod, *b_mod, *g_attn, *w_in, *kv_norm_g, *w_uv, *g_out_a, *g_out_b, *w_out, *g_mlp, *w_up, *w_down, *rel_bias, *g_final;
    float* out; unsigned char* ws;
};

__device__ __forceinline__ void conv_tile(float* T  , const float* src, int N, int K, int Nvalid, const float* ks0, const float* ks1, f16* dst, int tn, int tk) {
    const int tid = ltid();
#pragma unroll
    for (int i = 0; i < 8; ++i) {
        const int kk = (tid >> 6) + 8 * i, k = tk * 64 + kk, n = tn * 64 + (tid & 63);
        float v = (n < Nvalid) ? src[(size_t)k * N + n] : 0.f;
        if (ks0) v *= (k < 512 ? ks0[k] : ks1[k - 512]);
        T[kk * 65 + (tid & 63)] = v;
    }
    __syncthreads();
    { const int nn = tid >> 3, kc = (tid & 7) * 8; f16x8 o;
#pragma unroll
      for (int e = 0; e < 8; ++e) o[e] = (f16)T[(kc + e) * 65 + nn];
      *(f16x8*)(dst + (size_t)(tn * 64 + nn) * K + tk * 64 + kc) = o; }
    __syncthreads();
}

__device__ __forceinline__ int t5_bucket_dev(int rel) {
    const int n = rel < 0 ? -rel : rel; int bk;
    if (n < 8) bk = n; else if (n < 12) bk = 8; else if (n < 16) bk = 9; else if (n < 23) bk = 10; else if (n < 32) bk = 11; else if (n < 46) bk = 12; else if (n < 64) bk = 13; else if (n < 91) bk = 14; else bk = 15;
    return (rel > 0 ? 16 : 0) + bk;
}

__device__ __forceinline__ void prologue_phase(unsigned char* lds, const Ptrs& P, int G, int wg) {
    const int tid = ltid(), lane = tid & 63, wv = tid >> 6;
    unsigned char* ws = P.ws;
    float* T = (float*)lds;
    constexpr int T_IN = 52 * 16, T_OUT = 16 * 16, T_UP = 64 * 16, T_DN = 16 * 64, T_UV = 16, T_L = T_IN + T_OUT + T_UP + T_DN + T_UV;
    for (int u = wg; u < 2 * T_L; u += G) {
        const int l = u / T_L; int r = u % T_L;
        if (r < T_IN) { conv_tile(T, P.w_in + (size_t)l * DM * NPJ_VALID, NPJ_VALID, DM, NPJ_VALID, nullptr, nullptr, (f16*)(ws + WS_WIN) + (size_t)l * NPJ * DM, r / 16, r % 16); continue; }
        r -= T_IN;
        if (r < T_OUT) { conv_tile(T, P.w_out + (size_t)l * DM * DM, DM, DM, DM, P.g_out_a + l * 512, P.g_out_b + l * 512, (f16*)(ws + WS_WOUT) + (size_t)l * DM * DM, r / 16, r % 16); continue; }
        r -= T_OUT;
        if (r < T_UP) { conv_tile(T, P.w_up + (size_t)l * DM * FF, FF, DM, FF, nullptr, nullptr, (f16*)(ws + WS_WUP) + (size_t)l * FF * DM, r / 16, r % 16); continue; }
        r -= T_UP;
        if (r < T_DN) { conv_tile(T, P.w_down + (size_t)l * FF * DM, DM, FF, DM, nullptr, nullptr, (f16*)(ws + WS_WDN) + (size_t)l * DM * FF, r / 64, r % 64); continue; }
        r -= T_DN;
        { const int h = r >> 1; conv_tile(T, P.w_uv + ((size_t)l * 8 + h) * 128 * 64, 64, 128, 64, nullptr, nullptr, (f16*)(ws + WS_WUV) + ((size_t)l * 8 + h) * 64 * 128, 0, r & 1); }
    }
    { float* sq = (float*)(ws + WS_SSQ) + MT; for (size_t i = (size_t)wg * NTHR + tid; i < (size_t)3 * MT / 4; i += (size_t)G * NTHR) ((f32x4*)sq)[i] = (f32x4){0.f, 0.f, 0.f, 0.f}; }
    if (wg == G - 1) {
        float* BT = (float*)(ws + WS_BIAS);
        for (int i = tid; i < 8 * 2112; i += NTHR) { const int h = i / 2112, idx = i % 2112; const int bk = t5_bucket_dev(idx - 2047);
            BT[i] = (P.rel_bias[bk * 8 + h] - P.rel_bias[15 * 8 + h]) * LOG2E; }
    }
    __syncthreads();
    if (wg < 192) {
        float* SC = (float*)lds;
        float* RED = (float*)(lds + 65536);
        for (int i = tid; i < 16 * 1024; i += NTHR) { const int b = i >> 10, k = i & 1023; const float cv = P.c[i]; SC[k * 16 + b] = cv / (1.f + __expf(-cv)); }
        __syncthreads();
        for (int u = wg; u < 192; u += G) {
            const int l = u / 96, cb = u % 96, col = cb * 64 + lane;
            const float* wp = P.w_mod + (size_t)l * DM * 6144 + col;
            float acc[16];
#pragma unroll
            for (int b = 0; b < 16; ++b) acc[b] = 0.f;
            for (int k = wv * 128; k < wv * 128 + 128; ++k) {
                const float w = wp[(size_t)k * 6144];
                const f32x4 s0 = *(const f32x4*)(SC + k * 16), s1 = *(const f32x4*)(SC + k * 16 + 4), s2 = *(const f32x4*)(SC + k * 16 + 8), s3 = *(const f32x4*)(SC + k * 16 + 12);
#pragma unroll
                for (int e = 0; e < 4; ++e) { acc[e] += s0[e] * w; acc[4 + e] += s1[e] * w; acc[8 + e] += s2[e] * w; acc[12 + e] += s3[e] * w; }
            }
#pragma unroll
            for (int b = 0; b < 16; ++b) RED[(wv * 16 + b) * 64 + lane] = acc[b];
            __syncthreads();
            for (int i = tid; i < 1024; i += NTHR) { const int b = i >> 6, cc = i & 63; float s = P.b_mod[l * 6144 + cb * 64 + cc];
#pragma unroll
                for (int w8 = 0; w8 < 8; ++w8) s += RED[(w8 * 16 + b) * 64 + cc];
                ((float*)(ws + WS_MOD))[((size_t)l * 16 + b) * 6144 + cb * 64 + cc] = s; }
            __syncthreads();
        }
    }
}

__device__ __forceinline__ void final_norm_phase(const float* x, const float* gain, float* out, int G, int wg) {
    const int tid_ = ltid(); const int lane = tid_ & 63, wv = tid_ >> 6;
    for (int row = wg * NWAVES + wv; row < MT; row += G * NWAVES) {
        const float* xp = x + (size_t)row * DM + lane * 4;
        f32x4 v[4]; float ss = 0.f;
#pragma unroll
        for (int i = 0; i < 4; ++i) { v[i] = *(const f32x4*)(xp + i * 256); ss += v[i][0] * v[i][0] + v[i][1] * v[i][1] + v[i][2] * v[i][2] + v[i][3] * v[i][3]; }
        ss = wave_sum(ss);
        const float rstd = rsqrtf(ss * (1.0f / DM) + EPS);
#pragma unroll
        for (int i = 0; i < 4; ++i) { const int col = i * 256 + lane * 4; const f32x4 g4 = *(const f32x4*)(gain + col);
            *(f32x4*)(out + (size_t)row * DM + col) = v[i] * rstd * g4; }
    }
}

__device__ __forceinline__ void kvnorm_phase(unsigned char* lds, const f16* PROJ, const float* g, f16* KV, f16* KVT, int G, int wg) {
    const int tid = ltid();
    f16* T = (f16*)lds;
    for (int blk = wg; blk < MT / 64; blk += G) {
        const int tok = tid >> 3, ch = tid & 7; const size_t row = (size_t)blk * 64 + tok;
        const f16* p = PROJ + row * NPJ + C_DKV + ch * 16;
        const f16x8 a = *(const f16x8*)p, b = *(const f16x8*)(p + 8);
        float va[8], vb[8]; float ss = 0.f;
#pragma unroll
        for (int e = 0; e < 8; ++e) { va[e] = (float)a[e]; vb[e] = (float)b[e]; ss += va[e] * va[e] + vb[e] * vb[e]; }
        ss += __shfl_xor(ss, 4); ss += __shfl_xor(ss, 2); ss += __shfl_xor(ss, 1);
        const float rstd = rsqrtf(ss * (1.0f / 128.f) + EPS);
        f16x8 oa, ob;
#pragma unroll
        for (int e = 0; e < 8; ++e) { oa[e] = (f16)(va[e] * rstd * g[ch * 16 + e]); ob[e] = (f16)(vb[e] * rstd * g[ch * 16 + 8 + e]); }
        *(f16x8*)(KV + row * 128 + ch * 16) = oa; *(f16x8*)(KV + row * 128 + ch * 16 + 8) = ob;
        { const int tp = (tok & ~15) | kperm16(tok & 15);
#pragma unroll
        for (int e = 0; e < 8; ++e) { T[(ch * 16 + e) * 72 + tp] = oa[e]; T[(ch * 16 + 8 + e) * 72 + tp] = ob[e]; } }
        __syncthreads();
        { const int dim = tid >> 2, tc = (tid & 3) * 16; const int bb = (blk * 64) >> 11, t0 = (blk * 64) & 2047;
          const f16x8 x0 = *(const f16x8*)(T + dim * 72 + tc), x1 = *(const f16x8*)(T + dim * 72 + tc + 8);
          f16* q = KVT + ((size_t)bb * 128 + dim) * SEQ + t0 + tc;
          *(f16x8*)q = x0; *(f16x8*)(q + 8) = x1; }
        __syncthreads();
    }
}

__device__ __forceinline__ void prenorm0_phase(const float* x, const float* gain, const float* sc, f16* An, float* ssq, int G, int wg) {
    const int tid_ = ltid(); const int lane = tid_ & 63, wv = tid_ >> 6;
    for (int row = wg * NWAVES + wv; row < MT; row += G * NWAVES) {
        const int b = row >> 11; const float* xp = x + (size_t)row * DM + lane * 4;
        f32x4 v[4]; float ss = 0.f;
#pragma unroll
        for (int i = 0; i < 4; ++i) { v[i] = *(const f32x4*)(xp + i * 256); ss += v[i][0] * v[i][0] + v[i][1] * v[i][1] + v[i][2] * v[i][2] + v[i][3] * v[i][3]; }
        ss = wave_sum(ss);
        if (lane == 0) ssq[row] = ss;
#pragma unroll
        for (int i = 0; i < 4; ++i) { const int col = i * 256 + lane * 4;
            const f32x4 g4 = *(const f32x4*)(gain + col), s4 = *(const f32x4*)(sc + (size_t)b * 6144 + col);
            f16x4 o;
#pragma unroll
            for (int e = 0; e < 4; ++e) o[e] = (f16)(v[i][e] * (g4[e] * (1.f + s4[e])));
            *(f16x4*)(An + (size_t)row * DM + col) = o; }
    }
}

__device__ __forceinline__ void bw_phase(unsigned char* lds, const Ptrs& P, const float* MOD, float* BW, int G, int wg) {
    const int tid = ltid(), lane = tid & 63, wv = tid >> 6;
    float* SH = (float*)lds;
    float* RED = (float*)(lds + 65536);
    for (int u = wg; u < 2 * 116; u += G) {
        const int l = u / 116, r = u % 116, site = (r < 52) ? 0 : 1, cb = (site == 0) ? r : r - 52;
        const int N = (site == 0) ? NPJ_VALID : FF;
        const float* W = (site == 0) ? P.w_in + (size_t)l * DM * NPJ_VALID : P.w_up + (size_t)l * DM * FF;
        const float* shp = MOD + (size_t)l * 16 * 6144 + (site == 0 ? 0 : 3) * DM;
        __syncthreads();
        for (int i = tid; i < 16 * 1024; i += NTHR) { const int b = i >> 10, k = i & 1023; SH[k * 16 + b] = shp[(size_t)b * 6144 + k]; }
        __syncthreads();
        const int col = cb * 64 + lane; const bool ok = col < N;
        const float* wp = W + (ok ? col : 0);
        float acc[16];
#pragma unroll
        for (int b = 0; b < 16; ++b) acc[b] = 0.f;
        for (int k = wv * 128; k < wv * 128 + 128; ++k) {
            const float w = ok ? wp[(size_t)k * N] : 0.f;
            const f32x4 s0 = *(const f32x4*)(SH + k * 16), s1 = *(const f32x4*)(SH + k * 16 + 4), s2 = *(const f32x4*)(SH + k * 16 + 8), s3 = *(const f32x4*)(SH + k * 16 + 12);
#pragma unroll
            for (int e = 0; e < 4; ++e) { acc[e] += s0[e] * w; acc[4 + e] += s1[e] * w; acc[8 + e] += s2[e] * w; acc[12 + e] += s3[e] * w; }
        }
#pragma unroll
        for (int b = 0; b < 16; ++b) RED[(wv * 16 + b) * 64 + lane] = acc[b];
        __syncthreads();
        for (int i = tid; i < 1024; i += NTHR) { const int b = i >> 6, cc = i & 63; float s = 0.f;
#pragma unroll
            for (int w8 = 0; w8 < 8; ++w8) s += RED[(w8 * 16 + b) * 64 + cc];
            BW[(((size_t)l * 2 + site) * 16 + b) * 4096 + cb * 64 + cc] = s; }
    }
    __syncthreads();
}

__device__ __forceinline__ void vtrans_phase(unsigned char* lds, const f16* PROJ, f16* VTA, int G, int wg) {
    const int tid = ltid();
    f16* T = (f16*)lds;
    for (int blk = wg; blk < 16 * 8 * 32; blk += G) {
        const int bh = blk >> 5, tb = blk & 31, b = bh >> 3, h = bh & 7;
        const int tok = tid >> 3, ch = tid & 7;
        const f16x8 v = *(const f16x8*)(PROJ + ((size_t)b * SEQ + tb * 64 + tok) * NPJ + C_SBV + h * 64 + ch * 8);
        const int tp = (tok & ~15) | kperm16(tok & 15);
#pragma unroll
        for (int e = 0; e < 8; ++e) T[(ch * 8 + e) * 72 + tp] = v[e];
        __syncthreads();
        { const int dim = tid >> 3, kc = (tid & 7) * 8;
          *(f16x8*)(VTA + ((size_t)bh * 64 + dim) * SEQ + tb * 64 + kc) = *(const f16x8*)(T + dim * 72 + kc); }
        __syncthreads();
    }
}

#define SB_LOAD(KF, VF, HT) do { const int _ht = (HT) < 0 ? 0 : (HT); \
    _Pragma("unroll") for (int s = 0; s < 4; ++s) KF[s] = *(const f16x8*)(kp + (size_t)_ht * 32 * NPJ + 16 * s); \
    _Pragma("unroll") for (int d = 0; d < 2; ++d) _Pragma("unroll") for (int s = 0; s < 2; ++s) VF[d][s] = *(const f16x8*)(vp + (size_t)d * 32 * SEQ + _ht * 32 + 16 * s); } while (0)

#define SB_COMPUTE(KF, VF, HT) do { \
    f32x16 S; _Pragma("unroll") for (int r = 0; r < 16; ++r) S[r] = 0.f; \
    _Pragma("unroll") for (int s = 0; s < 4; ++s) S = __builtin_amdgcn_mfma_f32_32x32x16_f16(KF[s], qf[s], S, 0, 0, 0); \
    f32x16 om; \
    _Pragma("unroll") for (int r = 0; r < 16; ++r) { \
        const float zc = __builtin_amdgcn_fmed3f(S[r], -640.f, 640.f);                    \
        const float e1 = __builtin_amdgcn_exp2f(zc * (-0.125f * LOG2E));                  \
        const float be = __builtin_amdgcn_rcpf(1.0f + e1);                                \
        S[r] = be; om[r] = e1 * be; }                                                      \
    if ((HT) == rb) {                                                                      \
        const int kb = (HT) * 32 + 4 * hh; \
        _Pragma("unroll") for (int r = 0; r < 16; ++r) { const int key = kb + 8 * (r >> 2) + (r & 3); if (key >= q) { S[r] = 0.f; om[r] = 1.0f; } } } \
    float R = C; \
    _Pragma("unroll") for (int g = 3; g >= 0; --g) { \
        const float o0 = om[4 * g], o1 = om[4 * g + 1], o2 = om[4 * g + 2], o3 = om[4 * g + 3]; \
        const float gown = (o0 * o1) * (o2 * o3); \
        const float gp = __shfl_xor(gown, 32); \
        const float pre = hh ? R : R * gp; \
        const float p3 = pre, p2 = p3 * o3, p1 = p2 * o2, p0 = p1 * o1; \
        S[4 * g + 3] *= p3; S[4 * g + 2] *= p2; S[4 * g + 1] *= p1; S[4 * g] *= p0; \
        R = R * gown * gp; } \
    C = R; \
    f16x8 pf[2]; \
    _Pragma("unroll") for (int s = 0; s < 2; ++s) _Pragma("unroll") for (int e = 0; e < 8; ++e) pf[s][e] = (f16)S[8 * s + e]; \
    _Pragma("unroll") for (int d = 0; d < 2; ++d) _Pragma("unroll") for (int s = 0; s < 2; ++s) accO[d] = __builtin_amdgcn_mfma_f32_32x32x16_f16(VF[d][s], pf[s], accO[d], 0, 0, 0); \
    } while (0)

__device__ __forceinline__ void sb_attn_phase(unsigned char* lds, const f16* PROJ, const f16* VTA, f16* OBUF, int G, int wg) {
    const int tid = ltid(), lane = tid & 63, wv = tid >> 6, l32 = lane & 31, hh = lane >> 5;
    float* RED = (float*)(lds + 73728);
    int par = 0;
    for (int u = wg; u < 1024; u += G, par ^= 1) {
        const int b = 2 * (u & 7) + ((u >> 3) & 1), rb = 63 - (u >> 4), h = wv, bh = b * 8 + h;
        const size_t rowbase = (size_t)b * SEQ;
        const int r0 = rb * 32, q = r0 + l32;
        f16x8 qf[4];
        { const f16* qp = PROJ + (rowbase + q) * NPJ + C_SBQ + h * 64 + hh * 8;
#pragma unroll
          for (int s = 0; s < 4; ++s) qf[s] = *(const f16x8*)(qp + 16 * s); }
        const f16* kp = PROJ + (rowbase + l32) * NPJ + C_SBK + h * 64 + hh * 8;
        const f16* vp = VTA + ((size_t)bh * 64 + l32) * SEQ + 8 * hh;
        f32x16 accO[2];
#pragma unroll
        for (int d = 0; d < 2; ++d)
#pragma unroll
            for (int r = 0; r < 16; ++r) accO[d][r] = 0.f;
        float C = 1.0f;
        f16x8 kA[4], vA[2][2], kB[4], vB[2][2];
        int ht = rb;
        SB_LOAD(kA, vA, ht);
        for (;;) {
            SB_LOAD(kB, vB, ht - 1);
            SB_COMPUTE(kA, vA, ht);
            if (ht == 0 || __ballot(C >= 2.9e-8f) == 0ull) break;
            --ht;
            SB_LOAD(kA, vA, ht - 1);
            SB_COMPUTE(kB, vB, ht);
            if (ht == 0 || __ballot(C >= 2.9e-8f) == 0ull) break;
            --ht;
        }
        float ssq = 0.f;
#pragma unroll
        for (int d = 0; d < 2; ++d)
#pragma unroll
            for (int r = 0; r < 16; ++r) ssq += accO[d][r] * accO[d][r];
        ssq += __shfl_xor(ssq, 32);
        if (hh == 0) RED[(par * 8 + wv) * 32 + l32] = ssq;
        __syncthreads();
        float tot = 0.f;
#pragma unroll
        for (int w8 = 0; w8 < 8; ++w8) tot += RED[(par * 8 + w8) * 32 + l32];
        const float rstd = rsqrtf(tot * (1.0f / 512.f) + EPS);
        { f16* op = OBUF + (rowbase + q) * DM + h * 64 + 4 * hh;
#pragma unroll
          for (int d = 0; d < 2; ++d)
#pragma unroll
            for (int g = 0; g < 4; ++g) { f16x4 o; o[0] = (f16)(accO[d][4 * g] * rstd); o[1] = (f16)(accO[d][4 * g + 1] * rstd); o[2] = (f16)(accO[d][4 * g + 2] * rstd); o[3] = (f16)(accO[d][4 * g + 3] * rstd);
                *(f16x4*)(op + 32 * d + 8 * g) = o; } }
    }
}
constexpr int IDX_PITCH = 2052;
__device__ __forceinline__ unsigned radix_scan(const unsigned* hist, int lane, unsigned& digit, unsigned& rank) {
    const u32x4 b = *(const u32x4*)(hist + 4 * lane);
    const unsigned s = b[0] + b[1] + b[2] + b[3];
    unsigned p = s;
    p += (unsigned)__builtin_amdgcn_update_dpp(0, (int)p, 0x101, 0xf, 0xf, true);
    p += (unsigned)__builtin_amdgcn_update_dpp(0, (int)p, 0x102, 0xf, 0xf, true);
    p += (unsigned)__builtin_amdgcn_update_dpp(0, (int)p, 0x104, 0xf, 0xf, true);
    p += (unsigned)__builtin_amdgcn_update_dpp(0, (int)p, 0x108, 0xf, 0xf, true);
    { const unsigned t1 = __builtin_amdgcn_readlane(p, 16), t2 = __builtin_amdgcn_readlane(p, 32), t3 = __builtin_amdgcn_readlane(p, 48);
      p += (lane < 16) ? (t1 + t2 + t3) : (lane < 32) ? (t2 + t3) : (lane < 48) ? t3 : 0u; }
    const unsigned long long ge = __ballot(p >= rank);
    const int L = __popcll(ge) - 1;
    const unsigned pL = __builtin_amdgcn_readlane(p, L), sL = __builtin_amdgcn_readlane(s, L);
    unsigned r = rank - (pL - sL);
    const unsigned b3 = __builtin_amdgcn_readlane(b[3], L), b2 = __builtin_amdgcn_readlane(b[2], L), b1 = __builtin_amdgcn_readlane(b[1], L);
    unsigned k = 3, bc = b3;
    if (r > b3) { r -= b3; k = 2; bc = b2; if (r > b2) { r -= b2; k = 1; bc = b1; if (r > b1) { r -= b1; k = 0; bc = __builtin_amdgcn_readlane(b[0], L); } } }
    digit = 4u * (unsigned)L + k; rank = r; return bc;
}
template <int NJ> __device__ __forceinline__ unsigned topk_words(const float* row, int nadm, int lane, unsigned* hist, unsigned* hist_dummy) {
    unsigned uk[NJ];
#pragma unroll
    for (int j = 0; j < NJ; ++j) {
        const int key = 64 * j + lane;
        unsigned bits = 0u;
        if (key < nadm) { bits = __float_as_uint(row[key]); bits ^= (unsigned)(((int)bits >> 31) | 0x80000000); }
        uk[j] = bits;
    }
    unsigned rank = 256u, T = 0u, dg;
    unsigned* dummy = hist_dummy + lane;
    *(u32x4*)(hist + 4 * lane) = (u32x4){0u, 0u, 0u, 0u};
#pragma unroll
    for (int j = 0; j < NJ; ++j) __hip_atomic_fetch_add(hist + (uk[j] >> 24), 1u, __ATOMIC_RELAXED, __HIP_MEMORY_SCOPE_WORKGROUP);
    unsigned binc = radix_scan(hist, lane, dg, rank); T = dg << 24;
#pragma unroll
    for (int lv = 1; lv < 4; ++lv) {
        const int sh = 24 - 8 * lv;
        if (binc == rank) break;
        *(u32x4*)(hist + 4 * lane) = (u32x4){0u, 0u, 0u, 0u};
        const unsigned pre = T >> (sh + 8);
#pragma unroll
        for (int j = 0; j < NJ; ++j) { unsigned* dst = ((uk[j] >> (sh + 8)) == pre) ? hist + ((uk[j] >> sh) & 255u) : dummy;
            __hip_atomic_fetch_add(dst, 1u, __ATOMIC_RELAXED, __HIP_MEMORY_SCOPE_WORKGROUP); }
        binc = radix_scan(hist, lane, dg, rank); T |= dg << sh;
    }
    int need = (int)rank;
    unsigned word = 0u;
#pragma unroll
    for (int j = 0; j < NJ; ++j) {
        unsigned long long sel = __ballot(uk[j] > T);
        unsigned long long em = __ballot(uk[j] == T);
        if (need > 0 && em != 0ull) {
            const int pc = __popcll(em);
            if (pc <= need) { sel |= em; need -= pc; }
            else { unsigned long long keep = 0ull; for (int i = 0; i < need; ++i) { const unsigned long long lowb = em & (0ull - em); keep |= lowb; em ^= lowb; } sel |= keep; need = 0; }
        }
        asm volatile("v_writelane_b32 %0, %1, %3\n\tv_writelane_b32 %0, %2, %4" : "+v"(word) : "s"((unsigned)sel), "s"((unsigned)(sel >> 32)), "n"(2 * j), "n"(2 * j + 1));
    }
    return word;
}
__device__ __forceinline__ void indexer_phase(unsigned char* lds, const f16* PROJ, unsigned* MASK, int G, int wg, bool do_topk) {
    const int tid = ltid(), lane = tid & 63, wv = tid >> 6, l16 = lane & 15, lq = lane >> 4;
    float* SCR = (float*)lds;
    unsigned* hist = (unsigned*)(lds + 136192) + wv * 256;
    unsigned* hdum = (unsigned*)(lds + 136192 + 8192) + wv * 64;
    f16x8 qa[8][2]; f16x8 w8r[4]; f16x8 ka[4][2];
#define IDX_LOAD_UNIT(U) do { const int _b = 2 * ((U) & 7) + (((U) >> 3) & 1), _q0 = (127 - ((U) >> 4)) * 16; const size_t _rb = (size_t)_b * SEQ; \
        const f16* _qp = PROJ + (_rb + _q0 + l16) * NPJ + C_IQ + lq * 8; \
        _Pragma("unroll") for (int hd = 0; hd < 8; ++hd) _Pragma("unroll") for (int s_ = 0; s_ < 2; ++s_) qa[hd][s_] = *(const f16x8*)(_qp + hd * 64 + 32 * s_); \
        _Pragma("unroll") for (int r = 0; r < 4; ++r) w8r[r] = *(const f16x8*)(PROJ + (_rb + _q0 + 4 * lq + r) * NPJ + C_IW); \
        const int _c0 = (((64 * ((_q0 >> 6) + 1)) >> 4) + 7) >> 3; const f16* _kb = PROJ + (_rb + wv * 16 + l16) * NPJ + C_IK + lq * 8; \
        _Pragma("unroll") for (int j = 0; j < 4; ++j) { const int _it = (j < _c0 - 1) ? j : _c0 - 1; const f16* _kp = _kb + (size_t)_it * (128 * NPJ); ka[j][0] = *(const f16x8*)_kp; ka[j][1] = *(const f16x8*)(_kp + 32); } } while (0)
    if (wg < MT / 16) IDX_LOAD_UNIT(wg);
    for (int u = wg; u < MT / 16; u += G) {
        const int b = 2 * (u & 7) + ((u >> 3) & 1), qg = 127 - (u >> 4);
        const int q0 = qg * 16; const size_t rowbase = (size_t)b * SEQ;
        const int nadm = 64 * ((q0 >> 6) + 1);
        float wq[4][8];
#pragma unroll
        for (int r = 0; r < 4; ++r)
#pragma unroll
            for (int hd = 0; hd < 8; ++hd) wq[r][hd] = (float)w8r[r][hd] * (0.35355339059327373f * 0.125f);
        const int ntile = nadm >> 4;
        const int c0 = (ntile + 7) >> 3, cnt = (c0 + 3) & ~3;
        const f16* kbase = PROJ + (rowbase + wv * 16 + l16) * NPJ + C_IK + lq * 8;
        for (int i = 0; i < cnt; i += 4) {
#pragma unroll
            for (int j = 0; j < 4; ++j) {
                const int it = (i + j < c0 - 1) ? i + j : c0 - 1;
                f32x4 sc = {0.f, 0.f, 0.f, 0.f};
                f32x4 a[8];
#pragma unroll
                for (int hd = 0; hd < 8; ++hd) { a[hd] = (f32x4){0.f, 0.f, 0.f, 0.f}; a[hd] = __builtin_amdgcn_mfma_f32_16x16x32_f16(qa[hd][0], ka[j][0], a[hd], 0, 0, 0); }
#pragma unroll
                for (int hd = 0; hd < 8; ++hd) a[hd] = __builtin_amdgcn_mfma_f32_16x16x32_f16(qa[hd][1], ka[j][1], a[hd], 0, 0, 0);
                __builtin_amdgcn_sched_barrier(0);
#pragma unroll
                for (int hd = 0; hd < 8; ++hd)
#pragma unroll
                    for (int r = 0; r < 4; ++r) { const int bi = __float_as_int(a[hd][r]); sc[r] += wq[r][hd] * __int_as_float(bi > 0 ? bi : 0); }
                { const int itn = (i + j + 4 < c0 - 1) ? i + j + 4 : c0 - 1; const f16* kp = kbase + (size_t)itn * (128 * NPJ); ka[j][0] = *(const f16x8*)kp; ka[j][1] = *(const f16x8*)(kp + 32); }
#pragma unroll
                for (int r = 0; r < 4; ++r) SCR[(4 * lq + r) * IDX_PITCH + (wv + 8 * it) * 16 + l16] = sc[r] + 0.0f;
            }
        }
        __syncthreads();
        if (u + G < MT / 16) IDX_LOAD_UNIT(u + G);
#ifndef TOPK_REP
#define TOPK_REP 1
#endif
        if (do_topk) for (int qs = 0; qs < 2 * TOPK_REP; ++qs) {
            const int qq = 2 * wv + (qs & 1);
            unsigned* mrow = MASK + (rowbase + q0 + qq) * 64;
            unsigned word = 0u;
            if (nadm <= 256) {
                word = (lane * 32 < nadm) ? 0xFFFFFFFFu : 0u;
            } else {
                const float* row = SCR + qq * IDX_PITCH;
                if (nadm <= 512) word = topk_words<8>(row, nadm, lane, hist, hdum);
                else if (nadm <= 1024) word = topk_words<16>(row, nadm, lane, hist, hdum);
                else if (nadm <= 1536) word = topk_words<24>(row, nadm, lane, hist, hdum);
                else word = topk_words<32>(row, nadm, lane, hist, hdum);
            }
            mrow[lane] = word;
        }
        __syncthreads();
    }
}
__device__ __forceinline__ void dsa_attn_phase(unsigned char* lds, const f16* PROJ, const f16* KV, const f16* KVT, const unsigned* MASK, const float* BIAS2, const f16* WUVT, f16* OBUF, int G, int wg) {
    const int tid = ltid(), lane = tid & 63, wv = tid >> 6, l32 = lane & 31, hh = lane >> 5;
    f16* KlB = (f16*)lds;
    f16* VlB = (f16*)(lds + 2 * 17408);
    const int hd = wv;
    const float c1 = 0.08838834764831845f * LOG2E;
    const int skey = tid >> 3, skc = (tid & 7) * 16, sdim = tid >> 2, sdc = (tid & 3) * 16;
    f16x8 qraw[8], k0, k1, t0, t1;
#define DSA_UNIT_BQ(U, B_, QI_) do { if (G == 256) { const int _j = wg >> 4, _i = (U) >> 8; B_ = 2 * (wg & 7) + ((wg >> 3) & 1);     QI_ = (_i == 0) ? 63 - _j : (_i == 1) ? 32 + _j : (_i == 2) ? 31 - _j : _j; } \
        else { B_ = (U) & 15; QI_ = 63 - ((U) >> 4); } } while (0)
#define DSA_LOAD_UNIT(U) do { int _b, _qi; DSA_UNIT_BQ(U, _b, _qi); const size_t _rb = (size_t)_b * SEQ; \
        const f16* _qp = PROJ + (_rb + _qi * 32 + l32) * NPJ + C_DQ + hd * 128 + hh * 8; \
        _Pragma("unroll") for (int s_ = 0; s_ < 8; ++s_) qraw[s_] = *(const f16x8*)(_qp + 16 * s_); \
        const f16* _kv = KV + (_rb + skey) * 128 + skc; const f16* _kt = KVT + ((size_t)_b * 128 + sdim) * SEQ + sdc; \
        k0 = *(const f16x8*)_kv; k1 = *(const f16x8*)(_kv + 8); t0 = *(const f16x8*)_kt; t1 = *(const f16x8*)(_kt + 8); } while (0)
    float* BL = (float*)(lds + 77824) + wv * 256;
    { const float* bsrc = BIAS2 + hd * 2112 + 2047 - 192;
#pragma unroll
      for (int i = 0; i < 4; ++i) BL[lane + 64 * i] = bsrc[lane + 64 * i]; }
    float* RED = (float*)(lds + 73728 + 2048);
    int par = 0;
    for (int u = wg; u < 1024; u += G, par ^= 1) {
        int b, qi; DSA_UNIT_BQ(u, b, qi);
        DSA_LOAD_UNIT(u);
        const int q0 = qi * 32; const size_t rowbase = (size_t)b * SEQ;
        const int ntile = (q0 >> 6) + 1;
        f16x8 qf[8];
#pragma unroll
        for (int s = 0; s < 8; ++s)
#pragma unroll
            for (int e = 0; e < 8; ++e) qf[s][e] = (f16)((float)qraw[s][e] * c1);
        const unsigned* mrow = MASK + (rowbase + q0 + l32) * 64;
        const int q = q0 + l32;
        f32x16 accO[4];
#pragma unroll
        for (int d = 0; d < 4; ++d)
#pragma unroll
            for (int r = 0; r < 16; ++r) accO[d][r] = 0.f;
        float mrun = 0.f, lsum = 0.f;
        const f16* kvp = KV + (rowbase + skey) * 128 + skc;
        const f16* ktp = KVT + ((size_t)b * 128 + sdim) * SEQ + sdc;
        __syncthreads();
        { f16* Kw = KlB + skey * 136 + skc; f16* Vw = VlB + sdim * 72 + sdc;
          *(f16x8*)Kw = k0; *(f16x8*)(Kw + 8) = k1; *(f16x8*)Vw = t0; *(f16x8*)(Vw + 8) = t1; }
        __syncthreads();
        for (int kt = 0; kt < ntile; ++kt) {
            const f16* Kl = KlB + (kt & 1) * (64 * 136); const f16* Vl = VlB + (kt & 1) * (128 * 72);
            if (kt + 1 < ntile) { const f16* a = kvp + (size_t)(kt + 1) * 64 * 128; const f16* c = ktp + (kt + 1) * 64;
                k0 = *(const f16x8*)a; k1 = *(const f16x8*)(a + 8); t0 = *(const f16x8*)c; t1 = *(const f16x8*)(c + 8); }
            const u32x2 mw = *(const u32x2*)(mrow + 2 * kt);
            const bool near = (kt * 64 + 63 + 96 > q0);
            const float* bp = BL + 192 - q + kt * 64 + 4 * hh;
            f32x16 S0, S1;
            { const float ninit = -mrun;
#pragma unroll
              for (int r = 0; r < 16; ++r) { S0[r] = ninit; S1[r] = ninit; } }
#define DSA_QK(SX, T_) do { _Pragma("unroll") for (int s4 = 0; s4 < 8; s4 += 4) { f16x8 kf[4]; \
                _Pragma("unroll") for (int s = 0; s < 4; ++s) kf[s] = *(const f16x8*)(Kl + (32 * (T_) + l32) * 136 + 16 * (s4 + s) + 8 * hh); \
                __builtin_amdgcn_sched_barrier(0); __builtin_amdgcn_s_setprio(1); \
                _Pragma("unroll") for (int s = 0; s < 4; ++s) SX = __builtin_amdgcn_mfma_f32_32x32x16_f16(kf[s], qf[s4 + s], SX, 0, 0, 0); __builtin_amdgcn_s_setprio(0); } } while (0)
#define DSA_SOFTMAX(SX, SOTHER, T_, PF) do { \
                if (near) { _Pragma("unroll") for (int g = 0; g < 4; ++g) _Pragma("unroll") for (int e = 0; e < 4; ++e) SX[4 * g + e] += bp[32 * (T_) + 8 * g + e]; } \
                float tmax = SX[0]; _Pragma("unroll") for (int r = 1; r < 16; ++r) tmax = fmaxf(tmax, SX[r]); \
                const bool first = (kt == 0 && (T_) == 0); \
                if (first || __ballot(tmax > 8.0f) != 0ull) { \
                    const float tm2 = fmaxf(tmax, __shfl_xor(tmax, 32)); \
                    const float delta = (first || tm2 > 8.0f) ? tm2 : 0.f; \
                    const float alpha = __builtin_amdgcn_exp2f(-delta); \
                    mrun += delta; lsum *= alpha; \
                    _Pragma("unroll") for (int r = 0; r < 16; ++r) { SX[r] -= delta; if ((T_) == 0) SOTHER[r] -= delta; }     \
                    _Pragma("unroll") for (int d = 0; d < 4; ++d) _Pragma("unroll") for (int r = 0; r < 16; ++r) accO[d][r] *= alpha; } \
                const unsigned wsh = ((T_) == 0 ? mw[0] : mw[1]) >> (4 * hh); \
                float ps = 0.f; \
                _Pragma("unroll") for (int r = 0; r < 16; ++r) { \
                    const float p = __builtin_amdgcn_exp2f(SX[r]); float pm; \
                    asm("v_bfe_i32 %0, %1, %2, 1\n\tv_and_b32 %0, %0, %3" : "=&v"(pm) : "v"(wsh), "n"(8 * (r >> 2) + (r & 3)), "v"(p)); \
                    SX[r] = pm; ps += pm; } \
                lsum += ps; \
                _Pragma("unroll") for (int s = 0; s < 2; ++s) _Pragma("unroll") for (int e = 0; e < 8; ++e) PF[s][e] = (f16)SX[8 * s + e]; } while (0)
#define DSA_PV(PF, T_) do { _Pragma("unroll") for (int d2 = 0; d2 < 4; d2 += 2) { f16x8 vf[2][2]; \
                _Pragma("unroll") for (int d = 0; d < 2; ++d) _Pragma("unroll") for (int s = 0; s < 2; ++s) vf[d][s] = *(const f16x8*)(Vl + (32 * (d2 + d) + l32) * 72 + 32 * (T_) + 16 * s + 8 * hh); \
                __builtin_amdgcn_sched_barrier(0); __builtin_amdgcn_s_setprio(1); \
                _Pragma("unroll") for (int d = 0; d < 2; ++d) _Pragma("unroll") for (int s = 0; s < 2; ++s) accO[d2 + d] = __builtin_amdgcn_mfma_f32_32x32x16_f16(vf[d][s], PF[s], accO[d2 + d], 0, 0, 0); __builtin_amdgcn_s_setprio(0); } } while (0)
            DSA_QK(S0, 0); DSA_QK(S1, 1);
            { f16x8 pf0[2]; DSA_SOFTMAX(S0, S1, 0, pf0); DSA_PV(pf0, 0); }
            { f16x8 pf1[2]; DSA_SOFTMAX(S1, S0, 1, pf1); DSA_PV(pf1, 1); }
#undef DSA_QK
#undef DSA_SOFTMAX
#undef DSA_PV
            if (kt + 1 < ntile) { f16* Kw = KlB + ((kt + 1) & 1) * (64 * 136) + skey * 136 + skc; f16* Vw = VlB + ((kt + 1) & 1) * (128 * 72) + sdim * 72 + sdc;
                *(f16x8*)Kw = k0; *(f16x8*)(Kw + 8) = k1; *(f16x8*)Vw = t0; *(f16x8*)(Vw + 8) = t1; }
            __syncthreads();
        }
        const float ltot = lsum + __shfl_xor(lsum, 32);
        const float inv = 1.0f / ltot;
        f32x16 Z[2];
#pragma unroll
        for (int n = 0; n < 2; ++n)
#pragma unroll
            for (int r = 0; r < 16; ++r) Z[n][r] = 0.f;
#pragma unroll
        for (int dh = 0; dh < 2; ++dh) {
            f16x4 wlo[2][2][2], whi[2][2][2];
#pragma unroll
            for (int d = 0; d < 2; ++d)
#pragma unroll
                for (int s = 0; s < 2; ++s)
#pragma unroll
                    for (int n = 0; n < 2; ++n) {
                        const f16* wp = WUVT + ((size_t)hd * 64 + 32 * n + l32) * 128 + 32 * (2 * dh + d) + 16 * s + 4 * hh;
                        wlo[d][s][n] = *(const f16x4*)wp; whi[d][s][n] = *(const f16x4*)(wp + 8);
                    }
#pragma unroll
            for (int d = 0; d < 2; ++d)
#pragma unroll
                for (int s = 0; s < 2; ++s) {
                    f16x8 ob;
#pragma unroll
                    for (int e = 0; e < 8; ++e) ob[e] = (f16)(accO[2 * dh + d][8 * s + e] * inv);
#pragma unroll
                    for (int n = 0; n < 2; ++n) {
                        const f16x4 lo = wlo[d][s][n], hi = whi[d][s][n];
                        f16x8 wa; wa[0] = lo[0]; wa[1] = lo[1]; wa[2] = lo[2]; wa[3] = lo[3]; wa[4] = hi[0]; wa[5] = hi[1]; wa[6] = hi[2]; wa[7] = hi[3];
                        Z[n] = __builtin_amdgcn_mfma_f32_32x32x16_f16(wa, ob, Z[n], 0, 0, 0);
                    }
                }
        }
        float ssq = 0.f;
#pragma unroll
        for (int n = 0; n < 2; ++n)
#pragma unroll
            for (int r = 0; r < 16; ++r) ssq += Z[n][r] * Z[n][r];
        ssq += __shfl_xor(ssq, 32);
        if (hh == 0) RED[(par * 8 + wv) * 32 + l32] = ssq;
        __syncthreads();
        float tot = 0.f;
#pragma unroll
        for (int w8 = 0; w8 < 8; ++w8) tot += RED[(par * 8 + w8) * 32 + l32];
        const float rstd = rsqrtf(tot * (1.0f / 512.f) + EPS);
        { f16* op = OBUF + (rowbase + q) * DM + 512 + hd * 64 + 4 * hh;
#pragma unroll
          for (int n = 0; n < 2; ++n)
#pragma unroll
            for (int g = 0; g < 4; ++g) { f16x4 o; o[0] = (f16)(Z[n][4 * g] * rstd); o[1] = (f16)(Z[n][4 * g + 1] * rstd); o[2] = (f16)(Z[n][4 * g + 2] * rstd); o[3] = (f16)(Z[n][4 * g + 3] * rstd);
                *(f16x4*)(op + 32 * n + 8 * g) = o; } }
    }
}
constexpr int N_PHASES = 15;
struct Args { Ptrs p; int ph_lo, ph_hi; };

__global__ void __launch_bounds__(NTHR, 2) trunk_fwd(Args args) {
    extern __shared__ __attribute__((aligned(16))) unsigned char lds[];
    const Ptrs& P = args.p;
    unsigned char* ws = P.ws;
    const int G = gridDim.x, wg = blockIdx.x, tid = threadIdx.x;
    const int lo = args.ph_lo, hi = args.ph_hi;
    const bool multi = (hi - lo) > 1;
    XcdBarrier bar; bar.bar = (unsigned*)(ws + WS_CTL); bar.x = 0; bar.st = nullptr;
    if (multi) {
        if (tid < 4) ((LAS unsigned*)(lds + LDS_MISC))[tid] = 0u;
        __syncthreads();
        bar = xcd_barrier_post((unsigned*)(ws + WS_CTL), (volatile LAS unsigned*)(lds + LDS_MISC));
    }
#ifndef REP_IDX
#define REP_IDX 1
#endif
#ifndef REP_IDX_SCORE_ONLY
#define REP_IDX_SCORE_ONLY 0
#endif
#ifndef REP_SB
#define REP_SB 1
#endif
#ifndef REP_DSA
#define REP_DSA 1
#endif
#ifndef REP_GIN
#define REP_GIN 1
#endif
#ifndef REP_GUP
#define REP_GUP 1
#endif
#ifndef PHMASK
#define PHMASK 0xFFFFF
#endif
#define IN(k) (lo <= (k) && (k) < hi)
#define PM(j) ((PHMASK >> (j)) & 1)
#define SEAM(k) do { if (IN(k) && IN((k) + 1)) xcd_barrier(bar); } while (0)
    float* MOD = (float*)(ws + WS_MOD);
    f16* H = (f16*)(ws + WS_H); f16* PROJ = (f16*)(ws + WS_PROJ); f16* OBUF = (f16*)(ws + WS_OBUF); f16* HID = (f16*)(ws + WS_HID);
    f16* KV = (f16*)(ws + WS_KV); f16* KVT = (f16*)(ws + WS_KVT); f16* VTA = (f16*)(ws + WS_VTA); unsigned* MASK = (unsigned*)(ws + WS_MASK);
    float* X = P.out;

    float* SSQ = (float*)(ws + WS_SSQ); float* BW = (float*)(ws + WS_BW);
    if (PM(0) && IN(0)) { prologue_phase(lds, P, G, wg); SEAM(0); }
    if (PM(1) && IN(1)) {
        bw_phase(lds, P, MOD, BW, G, wg);
        prenorm0_phase(P.x, P.g_attn, MOD + 1 * DM, H, SSQ, G, wg);
        SEAM(1);
    }

    for (int l = 0; l < NLAYER; ++l) {
        const int pb = 2 + 6 * l;
        const float* modl = MOD + (size_t)l * 16 * 6144;
        const float* xin = (l == 0) ? P.x : X;
        const float* ssq1 = SSQ + (size_t)(l == 0 ? 0 : 2) * MT;
        float* ssq2 = SSQ + (size_t)(l == 0 ? 1 : 3) * MT;
        if (PM(2) && IN(pb + 0)) {
            pg8::Gemm g{H, (const f16*)(ws + WS_WIN) + (size_t)l * NPJ * DM, MT, NPJ, DM}; pg8::StaticOrder S; S.init(MT, NPJ, G, wg);
            pg8::EpiF16N<0> E{PROJ, NPJ, ssq1, BW + (size_t)(l * 2 + 0) * 16 * 4096};
            for (int rep = 0; rep < REP_GIN; ++rep) pg8::gemm_phase<pg8::EpiF16N<0>, pg8::StaticOrder>((LAS unsigned char*)lds, g, S, E);
            SEAM(pb + 0);
        }
        if (PM(3) && IN(pb + 1)) {
#if ENABLE_DSA
            kvnorm_phase(lds, PROJ, P.kv_norm_g + l * 128, KV, KVT, G, wg);
            __syncthreads();
#endif
#if ENABLE_SB
            vtrans_phase(lds, PROJ, VTA, G, wg);
            __syncthreads();
#endif
#if ENABLE_DSA
            for (int rep = 0; rep < REP_IDX; ++rep) { indexer_phase(lds, PROJ, MASK, G, wg, rep == 0 || !REP_IDX_SCORE_ONLY); __syncthreads(); }
#endif
            SEAM(pb + 1);
        }
        if (PM(4) && IN(pb + 2)) {
            for (int rep = 0; rep < REP_SB; ++rep) { sb_attn_phase(lds, PROJ, VTA, OBUF, G, wg); }
            for (int rep = 0; rep < REP_DSA; ++rep) { __syncthreads(); dsa_attn_phase(lds, PROJ, KV, KVT, MASK, (const float*)(ws + WS_BIAS), (const f16*)(ws + WS_WUV) + (size_t)l * 8 * 64 * 128, OBUF, G, wg); }
            SEAM(pb + 2);
        }
        if (PM(6) && IN(pb + 3)) {
            pg8::Gemm g{OBUF, (const f16*)(ws + WS_WOUT) + (size_t)l * DM * DM, MT, DM, DM}; pg8::StaticOrder S; S.init(MT, DM, G, wg);
            pg8::EpiResidN E{xin, X, modl + 2 * DM, P.g_mlp + l * DM, modl + 4 * DM, H, ssq2};
            pg8::gemm_phase<pg8::EpiResidN, pg8::StaticOrder>((LAS unsigned char*)lds, g, S, E);
            SEAM(pb + 3);
        }
        if (PM(8) && IN(pb + 4)) {
            pg8::Gemm g{H, (const f16*)(ws + WS_WUP) + (size_t)l * FF * DM, MT, FF, DM}; pg8::StaticOrder S; S.init(MT, FF, G, wg);
            pg8::EpiF16N<1> E{HID, FF, ssq2, BW + (size_t)(l * 2 + 1) * 16 * 4096};
            for (int rep = 0; rep < REP_GUP; ++rep) pg8::gemm_phase<pg8::EpiF16N<1>, pg8::StaticOrder>((LAS unsigned char*)lds, g, S, E);
            SEAM(pb + 4);
        }
        if (PM(9) && IN(pb + 5)) {
            pg8::Gemm g{HID, (const f16*)(ws + WS_WDN) + (size_t)l * DM * FF, MT, DM, FF}; pg8::StaticOrder S; S.init(MT, DM, G, wg);
            if (l == 0) {
                pg8::EpiResidN E{X, X, modl + 5 * DM, P.g_attn + DM, MOD + (size_t)16 * 6144 + 1 * DM, H, SSQ + (size_t)2 * MT};
                pg8::gemm_phase<pg8::EpiResidN, pg8::StaticOrder>((LAS unsigned char*)lds, g, S, E);
            } else {
                pg8::EpiResid E{X, X, modl + 5 * DM};
                pg8::gemm_phase<pg8::EpiResid, pg8::StaticOrder>((LAS unsigned char*)lds, g, S, E);
            }
            SEAM(pb + 5);
        }
    }
    if (PM(10) && IN(14)) { final_norm_phase(X, P.g_final, P.out, G, wg); }
#undef IN
#undef SEAM
}

extern "C" void kernel_launch(void* const* d_in, const int* in_sizes, int n_in, void* d_out, int out_size, void* d_ws, size_t ws_size, hipStream_t stream) {
    static int grid = 0;
    if (grid == 0) {
        if (n_in != 16 || in_sizes[0] != MT * DM || out_size != MT * DM || ws_size < WS_END) {
            fprintf(stderr, "kernel_launch: unexpected shapes: n_in %d in0 %d out %d ws %zu (need %zu)\n", n_in, n_in > 0 ? in_sizes[0] : -1, out_size, ws_size, (size_t)WS_END); grid = -1; return; }
        int dev = 0, cus = 0, per_cu = 0;
        if (hipGetDevice(&dev) != hipSuccess || hipDeviceGetAttribute(&cus, hipDeviceAttributeMultiprocessorCount, dev) != hipSuccess) { grid = -1; return; }
        if (hipFuncSetAttribute((const void*)trunk_fwd, hipFuncAttributeMaxDynamicSharedMemorySize, LDS_BYTES) != hipSuccess) { fprintf(stderr, "kernel_launch: hipFuncSetAttribute failed\n"); grid = -1; return; }
        if (hipOccupancyMaxActiveBlocksPerMultiprocessor(&per_cu, (const void*)trunk_fwd, NTHR, LDS_BYTES) != hipSuccess || per_cu < 1) fprintf(stderr, "kernel_launch: occupancy query says %d\n", per_cu);
        (void)hipGetLastError();
        grid = cus;
    }
    if (grid < 0) return;
    (void)hipMemsetAsync((char*)d_ws + WS_CTL, 0, CTL_BYTES, stream);
    Args a{};
    a.p.x = (const float*)d_in[0]; a.p.c = (const float*)d_in[1]; a.p.w_mod = (const float*)d_in[2]; a.p.b_mod = (const float*)d_in[3]; a.p.g_attn = (const float*)d_in[4];
    a.p.w_in = (const float*)d_in[5]; a.p.kv_norm_g = (const float*)d_in[6]; a.p.w_uv = (const float*)d_in[7]; a.p.g_out_a = (const float*)d_in[8]; a.p.g_out_b = (const float*)d_in[9];
    a.p.w_out = (const float*)d_in[10]; a.p.g_mlp = (const float*)d_in[11]; a.p.w_up = (const float*)d_in[12]; a.p.w_down = (const float*)d_in[13]; a.p.rel_bias = (const float*)d_in[14];
    a.p.g_final = (const float*)d_in[15]; a.p.out = (float*)d_out; a.p.ws = (unsigned char*)d_ws;
#if N_LAUNCH_MODE == 1
    a.ph_lo = 0; a.ph_hi = N_PHASES;
    hipLaunchKernelGGL(trunk_fwd, dim3(grid), dim3(NTHR), LDS_BYTES, stream, a);
#else
    for (int ph = 0; ph < N_PHASES; ++ph) { a.ph_lo = ph; a.ph_hi = ph + 1; hipLaunchKernelGGL(trunk_fwd, dim3(grid), dim3(NTHR), LDS_BYTES, stream, a); }
#endif
}
```

```cpp
#include <hip/hip_runtime.h>
#include <cstdio>
#include <cstdint>

#define LAS __attribute__((address_space(3)))
typedef _Float16 f16;
typedef _Float16 f16x8 __attribute__((ext_vector_type(8)));
typedef _Float16 f16x4 __attribute__((ext_vector_type(4)));
typedef float f32x2 __attribute__((ext_vector_type(2)));
typedef float f32x4 __attribute__((ext_vector_type(4)));
typedef float f32x16 __attribute__((ext_vector_type(16)));
typedef unsigned u32x2 __attribute__((ext_vector_type(2)));
typedef unsigned u32x4 __attribute__((ext_vector_type(4)));

#ifndef N_LAUNCH_MODE
#define N_LAUNCH_MODE 1
#endif
#ifndef ENABLE_SB
#define ENABLE_SB 1
#endif
#ifndef ENABLE_DSA
#define ENABLE_DSA 1
#endif

constexpr int NB = 16, SEQ = 2048, DM = 1024, MT = NB * SEQ, NPJ = 3328, NPJ_VALID = 3272, FF = 4096, NLAYER = 2;
constexpr int C_SBQ = 0, C_SBK = 512, C_SBV = 1024, C_DQ = 1536, C_DKV = 2560, C_IQ = 2688, C_IK = 3200, C_IW = 3264;
constexpr int NWAVES = 8, NTHR = 512;
constexpr float EPS = 1e-6f;
constexpr float LOG2E = 1.4426950408889634f;

constexpr size_t al256(size_t x) { return (x + 255) & ~(size_t)255; }
constexpr size_t WS_CTL = 0;
constexpr size_t CTL_BYTES = 65536;
constexpr size_t WS_MOD = WS_CTL + CTL_BYTES;
constexpr size_t WS_BIAS = WS_MOD + al256((size_t)2 * 16 * 6144 * 4);
constexpr size_t WS_SSQ = WS_BIAS + al256((size_t)8 * 2112 * 4);
constexpr size_t WS_BW = WS_SSQ + (size_t)4 * MT * 4;
constexpr size_t WS_WIN = WS_BW + (size_t)2 * 2 * 16 * 4096 * 4;
constexpr size_t WS_WOUT = WS_WIN + (size_t)2 * NPJ * DM * 2;
constexpr size_t WS_WUP = WS_WOUT + (size_t)2 * DM * DM * 2;
constexpr size_t WS_WDN = WS_WUP + (size_t)2 * FF * DM * 2;
constexpr size_t WS_WUV = WS_WDN + (size_t)2 * FF * DM * 2;
constexpr size_t WS_H = WS_WUV + (size_t)2 * 8 * 64 * 128 * 2;
constexpr size_t WS_KV = WS_H + (size_t)MT * DM * 2;
constexpr size_t WS_KVT = WS_KV + (size_t)MT * 128 * 2;
constexpr size_t WS_VTA = WS_KVT + (size_t)MT * 128 * 2;
constexpr size_t WS_MASK = WS_VTA + (size_t)MT * 512 * 2;
constexpr size_t WS_PROJ = WS_MASK + (size_t)MT * 64 * 4;
constexpr size_t WS_OBUF = WS_PROJ + (size_t)MT * NPJ * 2;
constexpr size_t WS_HID = WS_PROJ;
constexpr size_t WS_END = WS_OBUF + (size_t)MT * DM * 2;
static_assert((size_t)MT * FF * 2 <= WS_END - WS_PROJ, "HID overlay must fit");

constexpr int LDS_BYTES = 147456;
constexpr int LDS_MISC = 135168;

__device__ __forceinline__ float wave_sum(float v) {
    v += __shfl_xor(v, 32); v += __shfl_xor(v, 16); v += __shfl_xor(v, 8); v += __shfl_xor(v, 4); v += __shfl_xor(v, 2); v += __shfl_xor(v, 1); return v;
}
__device__ __forceinline__ float half_sum(float v) {
    v += __shfl_xor(v, 16); v += __shfl_xor(v, 8); v += __shfl_xor(v, 4); v += __shfl_xor(v, 2); v += __shfl_xor(v, 1); return v;
}

__device__ __forceinline__ int ltid() { int t = threadIdx.x; asm volatile("" : "+v"(t)); return t; }

__device__ __forceinline__ int wave_sum_i(int v) {
    v += __builtin_amdgcn_update_dpp(0, v, 0xB1, 0xf, 0xf, true);
    v += __builtin_amdgcn_update_dpp(0, v, 0x4E, 0xf, 0xf, true);
    v += __builtin_amdgcn_update_dpp(0, v, 0x141, 0xf, 0xf, true);
    v += __builtin_amdgcn_update_dpp(0, v, 0x140, 0xf, 0xf, true);
    return __builtin_amdgcn_readlane(v, 0) + __builtin_amdgcn_readlane(v, 16) + __builtin_amdgcn_readlane(v, 32) + __builtin_amdgcn_readlane(v, 48);
}

__device__ __forceinline__ int kperm16(int k) { return (k & ~12) | ((k & 8) >> 1) | ((k & 4) << 1); }
#define XB_TMO      128
#define XB_XCNT(j)  (256  + 64 * (j))
#define XB_XSUB(j)  (1280 + 64 * (j))
#define XB_XGEN(j)  (2304 + 64 * (j))
#define XB_TOP      3328
#define XB_TOPGEN   3392
#define XCD_BAR_WORDS 3456
#define XB_SPIN_CAP (1u << 18)

__device__ __forceinline__ unsigned xb_ld(unsigned* p)              { return __hip_atomic_load(p, __ATOMIC_RELAXED, __HIP_MEMORY_SCOPE_AGENT); }
__device__ __forceinline__ unsigned xb_add(unsigned* p, unsigned v) { return __hip_atomic_fetch_add(p, v, __ATOMIC_RELAXED, __HIP_MEMORY_SCOPE_AGENT); }
__device__ __forceinline__ unsigned xb_xcc_id() { return (unsigned)__builtin_amdgcn_s_getreg((3 << 11) | 20) & 0xFu; }
#define XB_SPIN(cond, bar) do { unsigned _sp = 0; while (cond) { __builtin_amdgcn_s_sleep(1); \
    if ((++_sp & 255u) == 0u) { if (xb_ld(&(bar)[XB_TMO])) break; if (_sp > XB_SPIN_CAP) { atomicAdd(&(bar)[XB_TMO], 1u); break; } } } } while (0)

struct XcdBarrier {
    unsigned* bar; unsigned x;
    volatile LAS unsigned* st;
};

__device__ __forceinline__ XcdBarrier xcd_barrier_post(unsigned* bar, volatile LAS unsigned* st) {
    XcdBarrier b; b.bar = bar; b.x = xb_xcc_id(); b.st = st;
    if (threadIdx.x == 0) (void)xb_add(&bar[XB_XCNT(b.x)], 1u);
    return b;
}
__device__ __forceinline__ void xcd_barrier_complete(unsigned* bar, unsigned x, unsigned& nloc, unsigned& nx) {
    const unsigned G = gridDim.x * gridDim.y * gridDim.z;
    unsigned sum, cnt, mine, sp = 0u;
    for (;;) {
        sum = 0u; cnt = 0u; mine = 0u;
#pragma unroll
        for (unsigned j = 0; j < 16; ++j) { const unsigned c = xb_ld(&bar[XB_XCNT(j)]); sum += c; cnt += (c > 0u) ? 1u : 0u; mine = (j == x) ? c : mine; }
        if (sum == G) break;
        __builtin_amdgcn_s_sleep(1);
        if ((++sp & 255u) == 0u) { if (xb_ld(&bar[XB_TMO])) break; if (sp > XB_SPIN_CAP) { atomicAdd(&bar[XB_TMO], 1u); break; } }
    }
    nloc = mine > 0u ? mine : 1u; nx = cnt > 0u ? cnt : 1u;
}

__device__ __forceinline__ void xcd_barrier(const XcdBarrier& b) {
    asm volatile("s_waitcnt vmcnt(0)" ::: "memory");
    __syncthreads();
    if (threadIdx.x == 0) {
        unsigned* bar = b.bar;
        __builtin_amdgcn_s_waitcnt(0);
        unsigned nloc = b.st[0], nx = b.st[1];
        if (nloc == 0u) { xcd_barrier_complete(bar, b.x, nloc, nx); b.st[0] = nloc; b.st[1] = nx; }
        const unsigned old = xb_add(&bar[XB_XSUB(b.x)], 1u);
        const unsigned gen = old / nloc;
        if (old + 1u == (gen + 1u) * nloc) {
            __builtin_amdgcn_fence(__ATOMIC_RELEASE, "agent");
            asm volatile("s_waitcnt vmcnt(0)" ::: "memory");
            const unsigned og = xb_add(&bar[XB_TOP], 1u);
            const unsigned tg = og / nx;
            if (og + 1u == (tg + 1u) * nx) xb_add(&bar[XB_TOPGEN], 1u);
            else XB_SPIN(xb_ld(&bar[XB_TOPGEN]) == tg, bar);
            __builtin_amdgcn_fence(__ATOMIC_ACQUIRE, "agent");
            xb_add(&bar[XB_XGEN(b.x)], 1u);
            asm volatile("s_waitcnt vmcnt(0)" ::: "memory");
        } else {
            XB_SPIN(xb_ld(&bar[XB_XGEN(b.x)]) == gen, bar);
            __builtin_amdgcn_fence(__ATOMIC_ACQUIRE, "agent");
            asm volatile("s_waitcnt vmcnt(0)" ::: "memory");
        }
    }
    __syncthreads();
}

namespace pg8 {
constexpr int BM = 256, BK = 64, HALF = 128, HTB = HALF * BK * 2  , STAGE_BYTES = 8 * HTB, NXCD = 8, WGM = 4;

__host__ __device__ __forceinline__ int lds_byte(int r, int c) { const int st = (r >> 4) * 2 + (c >> 5), rr = r & 15, cc = c & 31, ob = rr * 64 + cc * 2; return st * 1024 + (ob ^ (((ob >> 9) & 1) << 5)); }
__host__ __device__ __forceinline__ void stage_rc(int b, int& R, int& C) { const int st = b / 1024, sb = b % 1024, swz = sb ^ (((sb >> 9) & 1) << 5); R = (st >> 1) * 16 + swz / 64; C = (st & 1) * 32 + (swz % 64) / 2; }
__host__ __device__ __forceinline__ int perm32(int rho) { const int n = rho >> 4, i = rho & 15; return 8 * (i >> 2) + 4 * n + (i & 3); }

struct Unit { int pm, pn; };
struct Gemm { const f16* A; const f16* Bt; int M, N, K; };

struct StaticOrder {
    int nM, nN, nwg, G, c;
    __host__ __device__ void init(int M, int N, int G_, int c_) { nM = M / BM; nN = N / BM; nwg = nM * nN; G = G_; c = c_; }
    __host__ __device__ bool next(int i, Unit& u) const {
        const long L = (long)i * G + c; if (L >= nwg) return false;
        int wgid = (int)L;
#ifndef NO_XCD_REMAP
        { const int q = nwg / NXCD, r = nwg % NXCD, xcd = wgid % NXCD, off = wgid / NXCD; wgid = (xcd < r ? xcd * (q + 1) : r * (q + 1) + (xcd - r) * q) + off; }
#endif
        const int nig = WGM * nN, gid = wgid / nig, fm = gid * WGM, gsz = (nM - fm) < WGM ? (nM - fm) : WGM;
        u.pm = fm + ((wgid % nig) % gsz); u.pn = (wgid % nig) / gsz; return true;
    }
    __device__ __forceinline__ void a_ready(const Unit&) const {}
    __device__ __forceinline__ void done(const Unit&) const {}
};

struct EpiResid {
    static constexpr bool PERM = true, AFTER_DRAIN = false, PREFETCH = false;
    const float* base; float* out; const float* gate;
    __device__ __forceinline__ void operator()(const f32x4 (&acc)[2][2][4][2], const Unit& u, int wr, int wc, int fr, int fq) const {
        const int row0 = u.pm * BM + wr * 64 + fr; const int col0 = u.pn * BM + wc * 32 + 8 * fq;
        const float* gp = gate + (size_t)((u.pm * BM) >> 11) * 6144 + col0;
        f32x4 gv[2][2];
#pragma unroll
        for (int bj = 0; bj < 2; ++bj)
#pragma unroll
            for (int n = 0; n < 2; ++n) gv[bj][n] = *(const f32x4*)(gp + bj * HALF + 4 * n);
#pragma unroll
        for (int ai = 0; ai < 2; ++ai)
#pragma unroll
            for (int m = 0; m < 4; ++m) { const size_t ro = (size_t)(row0 + ai * HALF + m * 16) * DM + col0;
#pragma unroll
                for (int bj = 0; bj < 2; ++bj)
#pragma unroll
                    for (int n = 0; n < 2; ++n) { const f32x4 x = *(const f32x4*)(base + ro + bj * HALF + 4 * n);
                        *(f32x4*)(out + ro + bj * HALF + 4 * n) = x + gv[bj][n] * acc[ai][bj][m][n]; } }
    }
};
template <int ACT  > struct EpiF16N {
    static constexpr bool PERM = true, AFTER_DRAIN = false, PREFETCH = true;
    f16* O; int ldc; const float* ssq; const float* bw;
    __device__ __forceinline__ void prefetch(LAS unsigned char* aux, const Unit& u, int tid, int wid) const {
        const float* src = (tid < 256) ? ssq + u.pm * BM + tid : bw + (size_t)((u.pm * BM) >> 11) * 4096 + u.pn * BM + (tid - 256);
        __builtin_amdgcn_global_load_lds((const unsigned*)src, (LAS unsigned*)(aux + wid * 256), 4, 0, 0);
    }
    __device__ __forceinline__ void with_lds(const f32x4 (&acc)[2][2][4][2], const Unit& u, int wr, int wc, int fr, int fq, LAS unsigned char* aux) const {
        const int row0 = u.pm * BM + wr * 64 + fr; const int col0 = u.pn * BM + wc * 32 + 8 * fq;
        const LAS float* sq = (const LAS float*)aux; const LAS float* bl = (const LAS float*)(aux + 1024) + wc * 32 + 8 * fq;
        f32x4 bv[2][2];
#pragma unroll
        for (int bj = 0; bj < 2; ++bj)
#pragma unroll
            for (int n = 0; n < 2; ++n) bv[bj][n] = *(const LAS f32x4*)(bl + bj * HALF + 4 * n);
        float rs[2][4];
#pragma unroll
        for (int ai = 0; ai < 2; ++ai)
#pragma unroll
            for (int m = 0; m < 4; ++m) rs[ai][m] = rsqrtf(sq[wr * 64 + fr + ai * HALF + m * 16] * (1.0f / DM) + EPS);
#pragma unroll
        for (int ai = 0; ai < 2; ++ai)
#pragma unroll
            for (int m = 0; m < 4; ++m) { f16* rowp = O + (size_t)(row0 + ai * HALF + m * 16) * ldc + col0;
#pragma unroll
                for (int bj = 0; bj < 2; ++bj) { f32x4 v0 = acc[ai][bj][m][0] * rs[ai][m] + bv[bj][0], v1 = acc[ai][bj][m][1] * rs[ai][m] + bv[bj][1];
                    if (ACT == 1) {
#pragma unroll
                        for (int e = 0; e < 4; ++e) { const float a = fmaxf(v0[e], 0.f), b = fmaxf(v1[e], 0.f); v0[e] = a * a; v1[e] = b * b; } }
                    f16x8 w; w[0] = (f16)v0[0]; w[1] = (f16)v0[1]; w[2] = (f16)v0[2]; w[3] = (f16)v0[3]; w[4] = (f16)v1[0]; w[5] = (f16)v1[1]; w[6] = (f16)v1[2]; w[7] = (f16)v1[3];
                    *(f16x8*)(rowp + bj * HALF) = w; } }
    }
    __device__ __forceinline__ void operator()(const f32x4 (&)[2][2][4][2], const Unit&, int, int, int, int) const {}
};
struct EpiResidN {
    static constexpr bool PERM = true, AFTER_DRAIN = false, PREFETCH = false;
    const float* base; float* out; const float* gate; const float* gain; const float* scale; f16* An; float* ssq;
    __device__ __forceinline__ void operator()(const f32x4 (&acc)[2][2][4][2], const Unit& u, int wr, int wc, int fr, int fq) const {
        const int row0 = u.pm * BM + wr * 64 + fr; const int col0 = u.pn * BM + wc * 32 + 8 * fq;
        const size_t bo = (size_t)((u.pm * BM) >> 11) * 6144 + col0;
        f32x4 gv[2][2], al[2][2];
#pragma unroll
        for (int bj = 0; bj < 2; ++bj)
#pragma unroll
            for (int n = 0; n < 2; ++n) { gv[bj][n] = *(const f32x4*)(gate + bo + bj * HALF + 4 * n);
                const f32x4 g4 = *(const f32x4*)(gain + col0 + bj * HALF + 4 * n), s4 = *(const f32x4*)(scale + bo + bj * HALF + 4 * n); al[bj][n] = g4 * (1.0f + s4); }
#pragma unroll
        for (int ai = 0; ai < 2; ++ai)
#pragma unroll
            for (int m = 0; m < 4; ++m) { const int row = row0 + ai * HALF + m * 16; const size_t ro = (size_t)row * DM + col0; float sq = 0.f;
#pragma unroll
                for (int bj = 0; bj < 2; ++bj) {
                    const f32x4 x0 = *(const f32x4*)(base + ro + bj * HALF), x1 = *(const f32x4*)(base + ro + bj * HALF + 4);
                    const f32x4 y0 = x0 + gv[bj][0] * acc[ai][bj][m][0], y1 = x1 + gv[bj][1] * acc[ai][bj][m][1];
                    *(f32x4*)(out + ro + bj * HALF) = y0; *(f32x4*)(out + ro + bj * HALF + 4) = y1;
                    sq += ((y0[0] * y0[0] + y0[1] * y0[1]) + (y0[2] * y0[2] + y0[3] * y0[3])) + ((y1[0] * y1[0] + y1[1] * y1[1]) + (y1[2] * y1[2] + y1[3] * y1[3]));
                    const f32x4 z0 = y0 * al[bj][0], z1 = y1 * al[bj][1]; f16x8 zz;
                    zz[0] = (f16)z0[0]; zz[1] = (f16)z0[1]; zz[2] = (f16)z0[2]; zz[3] = (f16)z0[3]; zz[4] = (f16)z1[0]; zz[5] = (f16)z1[1]; zz[6] = (f16)z1[2]; zz[7] = (f16)z1[3];
                    *(f16x8*)(An + ro + bj * HALF) = zz; }
                sq += __shfl_xor(sq, 16); sq += __shfl_xor(sq, 32);
                if (fq == 0) __hip_atomic_fetch_add(ssq + row, sq, __ATOMIC_RELAXED, __HIP_MEMORY_SCOPE_AGENT); }
    }
};

template <class Epi, class Sched>
__device__ __forceinline__ void gemm_phase(LAS unsigned char* lds, const Gemm g, const Sched& S, const Epi& E) {
    const int tid = ltid(), wid = __builtin_amdgcn_readfirstlane(tid >> 6), lane = tid & 63, wr = wid >> 2, wc = wid & 3, fr = lane & 15, fq = lane >> 4;
    const int K = g.K, nt = K / BK;
    unsigned voffA[2], voffB[2];
#pragma unroll
    for (int i = 0; i < 2; ++i) { int R, C; stage_rc(tid * 16 + i * 8192, R, C); const int Rb = Epi::PERM ? ((R & ~31) + perm32(R & 31)) : R;
        voffA[i] = (unsigned)(R * K + C) * 2u; voffB[i] = (unsigned)(Rb * K + C) * 2u; }
    const size_t kstep = (size_t)(BK * 2);
    const size_t hstep = (size_t)HALF * K * 2;
    const size_t tstep = 2 * hstep;
    const unsigned ldsw = (unsigned)wid * 1024u;
    const int aoff = lds_byte(wr * 64 + fr, fq * 8), boff = lds_byte(wc * 32 + fr, fq * 8);
#define PG8_SA(b, h) (((b) * 2 + (h)) * HTB)
#define PG8_SB(b, h) ((4 + (b) * 2 + (h)) * HTB)
#define PG8_STAGE(bufoff, gbase, voff) do { _Pragma("unroll") for (int _i = 0; _i < 2; ++_i) \
        __builtin_amdgcn_global_load_lds((const unsigned*)((const char*)(gbase) + (voff)[_i]), (LAS unsigned*)(lds + (bufoff) + ldsw + _i * 8192), 16, 0, 0); } while (0)
#define PG8_LDA(dst, b, h) do { _Pragma("unroll") for (int m = 0; m < 4; ++m) _Pragma("unroll") for (int k = 0; k < 2; ++k) dst[m][k] = *(const LAS f16x8*)(lds + PG8_SA(b, h) + aoff + m * 2048 + k * 1024); } while (0)
#define PG8_LDB(dst, b, h) do { _Pragma("unroll") for (int n = 0; n < 2; ++n) _Pragma("unroll") for (int k = 0; k < 2; ++k) dst[n][k] = *(const LAS f16x8*)(lds + PG8_SB(b, h) + boff + n * 2048 + k * 1024); } while (0)
#define PG8_MMA(ai, bj, At, Bt) do { __builtin_amdgcn_s_setprio(1); _Pragma("unroll") for (int m = 0; m < 4; ++m) _Pragma("unroll") for (int n = 0; n < 2; ++n) _Pragma("unroll") for (int k = 0; k < 2; ++k) \
        acc[ai][bj][m][n] = __builtin_amdgcn_mfma_f32_16x16x32_f16(Bt[n][k], At[m][k], acc[ai][bj][m][n], 0, 0, 0); __builtin_amdgcn_s_setprio(0); } while (0)
#define PG8_WAIT_V(n) asm volatile("s_waitcnt vmcnt(" #n ")" ::: "memory")
#define PG8_WAIT_L(n) asm volatile("s_waitcnt lgkmcnt(" #n ")" ::: "memory")
#define PG8_BAR __builtin_amdgcn_s_barrier()
#define PG8_SCHED __builtin_amdgcn_sched_barrier(0)
    Unit cur, nxt; int ui = 0;
    if (!S.next(0, cur)) return;
    f32x4 acc[2][2][4][2];
#pragma unroll
    for (int a = 0; a < 2; ++a)
#pragma unroll
        for (int b = 0; b < 2; ++b)
#pragma unroll
            for (int m = 0; m < 4; ++m)
#pragma unroll
                for (int n = 0; n < 2; ++n) acc[a][b][m][n] = (f32x4){0.f, 0.f, 0.f, 0.f};
    f16x8 At[4][2], B0[2][2], B1[2][2];
    const char* cA = (const char*)g.A + (size_t)cur.pm * tstep; const char* cB = (const char*)g.Bt + (size_t)cur.pn * tstep;
    S.a_ready(cur);
    if constexpr (Epi::PREFETCH) E.prefetch(lds + STAGE_BYTES, cur, tid, wid);
    PG8_STAGE(PG8_SB(0, 0), cB, voffB); PG8_STAGE(PG8_SB(0, 1), cB + hstep, voffB); PG8_STAGE(PG8_SA(0, 0), cA, voffA); PG8_STAGE(PG8_SA(0, 1), cA + hstep, voffA);
    if (wr == 1) PG8_BAR;
    PG8_WAIT_V(2); PG8_BAR;
    PG8_STAGE(PG8_SB(1, 0), cB + kstep, voffB); PG8_STAGE(PG8_SA(1, 0), cA + kstep, voffA); PG8_STAGE(PG8_SB(1, 1), cB + hstep + kstep, voffB);
    PG8_WAIT_V(6); PG8_BAR;
    for (;;) {
        const bool has_next = S.next(ui + 1, nxt);
        const char* nA = has_next ? (const char*)g.A + (size_t)nxt.pm * tstep : cA; const char* nB = has_next ? (const char*)g.Bt + (size_t)nxt.pn * tstep : cB;
        for (int t = 0; t < nt; t += 2) {
            const bool last = (t == nt - 2);
            const char* a1 = cA + (size_t)(t + 1) * kstep;
            const char* a2 = last ? nA : cA + (size_t)(t + 2) * kstep; const char* b2 = last ? nB : cB + (size_t)(t + 2) * kstep;
            const char* a3 = a2 + kstep; const char* b3 = b2 + kstep;
            if (last && has_next) S.a_ready(nxt);
            PG8_LDB(B0, 0, 0); PG8_LDB(B1, 0, 1); PG8_SCHED; PG8_LDA(At, 0, 0); PG8_STAGE(PG8_SA(1, 1), a1 + hstep, voffA);
            PG8_WAIT_V(8); PG8_WAIT_L(0); PG8_BAR; PG8_MMA(0, 0, At, B0); PG8_MMA(0, 1, At, B1); PG8_BAR; PG8_SCHED;
            PG8_LDA(At, 0, 1); PG8_STAGE(PG8_SB(0, 0), b2, voffB); PG8_STAGE(PG8_SB(0, 1), b2 + hstep, voffB); PG8_STAGE(PG8_SA(0, 0), a2, voffA);
            PG8_WAIT_V(8); PG8_WAIT_L(0); PG8_BAR; PG8_MMA(1, 0, At, B0); PG8_MMA(1, 1, At, B1); PG8_BAR; PG8_SCHED;
            PG8_LDB(B0, 1, 0); PG8_LDB(B1, 1, 1); PG8_SCHED; PG8_LDA(At, 1, 0); PG8_STAGE(PG8_SA(0, 1), a2 + hstep, voffA);
            PG8_WAIT_V(8); PG8_WAIT_L(0); PG8_BAR; PG8_MMA(0, 0, At, B0); PG8_MMA(0, 1, At, B1); PG8_BAR; PG8_SCHED;
            PG8_LDA(At, 1, 1); PG8_STAGE(PG8_SB(1, 0), b3, voffB); PG8_STAGE(PG8_SB(1, 1), b3 + hstep, voffB); PG8_STAGE(PG8_SA(1, 0), a3, voffA);
            PG8_WAIT_V(8); PG8_WAIT_L(0); PG8_BAR; PG8_MMA(1, 0, At, B0); PG8_MMA(1, 1, At, B1); PG8_BAR; PG8_SCHED;
        }
#ifndef PG8_NOALIGN
        if (wr == 0) PG8_BAR;
#endif
        if constexpr (Epi::PREFETCH) E.with_lds(acc, cur, wr, wc, fr, fq, lds + STAGE_BYTES + (ui & 1) * 2048); else E(acc, cur, wr, wc, fr, fq);
        S.done(cur);
        if (!has_next) break;
#pragma unroll
        for (int a = 0; a < 2; ++a)
#pragma unroll
            for (int b = 0; b < 2; ++b)
#pragma unroll
                for (int m = 0; m < 4; ++m)
#pragma unroll
                    for (int n = 0; n < 2; ++n) acc[a][b][m][n] = (f32x4){0.f, 0.f, 0.f, 0.f};
        cur = nxt; cA = nA; cB = nB; ++ui;
        if constexpr (Epi::PREFETCH) E.prefetch(lds + STAGE_BYTES + (ui & 1) * 2048, cur, tid, wid);
#ifndef PG8_NOALIGN
        if (wr == 1) PG8_BAR;
#endif
    }
    PG8_WAIT_V(0);
#ifdef PG8_NOALIGN
    if (wr == 0) PG8_BAR;
#endif
    PG8_BAR;
#undef PG8_SA
#undef PG8_SB
#undef PG8_STAGE
#undef PG8_LDA
#undef PG8_LDB
#undef PG8_MMA
#undef PG8_WAIT_V
#undef PG8_WAIT_L
#undef PG8_BAR
#undef PG8_SCHED
}
}
struct Ptrs {
    const float *x, *c, *w_mod, *b_mod, *g_attn, *w_in, *kv_norm_g, *w_uv, *g_out_a, *g_out_b, *w_out, *g_mlp, *w_up, *w_down, *rel_bias, *g_final;
    float* out; unsigned char* ws;
};

__device__ __forceinline__ void conv_tile(float* T  , const float* src, int N, int K, int Nvalid, const float* ks0, const float* ks1, f16* dst, int tn, int tk) {
    const int tid = ltid();
#pragma unroll
    for (int i = 0; i < 8; ++i) {
        const int kk = (tid >> 6) + 8 * i, k = tk * 64 + kk, n = tn * 64 + (tid & 63);
        float v = (n < Nvalid) ? src[(size_t)k * N + n] : 0.f;
        if (ks0) v *= (k < 512 ? ks0[k] : ks1[k - 512]);
        T[kk * 65 + (tid & 63)] = v;
    }
    __syncthreads();
    { const int nn = tid >> 3, kc = (tid & 7) * 8; f16x8 o;
#pragma unroll
      for (int e = 0; e < 8; ++e) o[e] = (f16)T[(kc + e) * 65 + nn];
      *(f16x8*)(dst + (size_t)(tn * 64 + nn) * K + tk * 64 + kc) = o; }
    __syncthreads();
}

__device__ __forceinline__ int t5_bucket_dev(int rel) {
    const int n = rel < 0 ? -rel : rel; int bk;
    if (n < 8) bk = n; else if (n < 12) bk = 8; else if (n < 16) bk = 9; else if (n < 23) bk = 10; else if (n < 32) bk = 11; else if (n < 46) bk = 12; else if (n < 64) bk = 13; else if (n < 91) bk = 14; else bk = 15;
    return (rel > 0 ? 16 : 0) + bk;
}

__device__ __forceinline__ void prologue_phase(unsigned char* lds, const Ptrs& P, int G, int wg) {
    const int tid = ltid(), lane = tid & 63, wv = tid >> 6;
    unsigned char* ws = P.ws;
    float* T = (float*)lds;
    constexpr int T_IN = 52 * 16, T_OUT = 16 * 16, T_UP = 64 * 16, T_DN = 16 * 64, T_UV = 16, T_L = T_IN + T_OUT + T_UP + T_DN + T_UV;
    for (int u = wg; u < 2 * T_L; u += G) {
        const int l = u / T_L; int r = u % T_L;
        if (r < T_IN) { conv_tile(T, P.w_in + (size_t)l * DM * NPJ_VALID, NPJ_VALID, DM, NPJ_VALID, nullptr, nullptr, (f16*)(ws + WS_WIN) + (size_t)l * NPJ * DM, r / 16, r % 16); continue; }
        r -= T_IN;
        if (r < T_OUT) { conv_tile(T, P.w_out + (size_t)l * DM * DM, DM, DM, DM, P.g_out_a + l * 512, P.g_out_b + l * 512, (f16*)(ws + WS_WOUT) + (size_t)l * DM * DM, r / 16, r % 16); continue; }
        r -= T_OUT;
        if (r < T_UP) { conv_tile(T, P.w_up + (size_t)l * DM * FF, FF, DM, FF, nullptr, nullptr, (f16*)(ws + WS_WUP) + (size_t)l * FF * DM, r / 16, r % 16); continue; }
        r -= T_UP;
        if (r < T_DN) { conv_tile(T, P.w_down + (size_t)l * FF * DM, DM, FF, DM, nullptr, nullptr, (f16*)(ws + WS_WDN) + (size_t)l * DM * FF, r / 64, r % 64); continue; }
        r -= T_DN;
        { const int h = r >> 1; conv_tile(T, P.w_uv + ((size_t)l * 8 + h) * 128 * 64, 64, 128, 64, nullptr, nullptr, (f16*)(ws + WS_WUV) + ((size_t)l * 8 + h) * 64 * 128, 0, r & 1); }
    }
    { float* sq = (float*)(ws + WS_SSQ) + MT; for (size_t i = (size_t)wg * NTHR + tid; i < (size_t)3 * MT / 4; i += (size_t)G * NTHR) ((f32x4*)sq)[i] = (f32x4){0.f, 0.f, 0.f, 0.f}; }
    if (wg == G - 1) {
        float* BT = (float*)(ws + WS_BIAS);
        for (int i = tid; i < 8 * 2112; i += NTHR) { const int h = i / 2112, idx = i % 2112; const int bk = t5_bucket_dev(idx - 2047);
            BT[i] = (P.rel_bias[bk * 8 + h] - P.rel_bias[15 * 8 + h]) * LOG2E; }
    }
    __syncthreads();
    if (wg < 192) {
        float* SC = (float*)lds;
        float* RED = (float*)(lds + 65536);
        for (int i = tid; i < 16 * 1024; i += NTHR) { const int b = i >> 10, k = i & 1023; const float cv = P.c[i]; SC[k * 16 + b] = cv / (1.f + __expf(-cv)); }
        __syncthreads();
        for (int u = wg; u < 192; u += G) {
            const int l = u / 96, cb = u % 96, col = cb * 64 + lane;
            const float* wp = P.w_mod + (size_t)l * DM * 6144 + col;
            float acc[16];
#pragma unroll
            for (int b = 0; b < 16; ++b) acc[b] = 0.f;
            for (int k = wv * 128; k < wv * 128 + 128; ++k) {
                const float w = wp[(size_t)k * 6144];
                const f32x4 s0 = *(const f32x4*)(SC + k * 16), s1 = *(const f32x4*)(SC + k * 16 + 4), s2 = *(const f32x4*)(SC + k * 16 + 8), s3 = *(const f32x4*)(SC + k * 16 + 12);
#pragma unroll
                for (int e = 0; e < 4; ++e) { acc[e] += s0[e] * w; acc[4 + e] += s1[e] * w; acc[8 + e] += s2[e] * w; acc[12 + e] += s3[e] * w; }
            }
#pragma unroll
            for (int b = 0; b < 16; ++b) RED[(wv * 16 + b) * 64 + lane] = acc[b];
            __syncthreads();
            for (int i = tid; i < 1024; i += NTHR) { const int b = i >> 6, cc = i & 63; float s = P.b_mod[l * 6144 + cb * 64 + cc];
#pragma unroll
                for (int w8 = 0; w8 < 8; ++w8) s += RED[(w8 * 16 + b) * 64 + cc];
                ((float*)(ws + WS_MOD))[((size_t)l * 16 + b) * 6144 + cb * 64 + cc] = s; }
            __syncthreads();
        }
    }
}

__device__ __forceinline__ void final_norm_phase(const float* x, const float* gain, float* out, int G, int wg) {
    const int tid_ = ltid(); const int lane = tid_ & 63, wv = tid_ >> 6;
    for (int row = wg * NWAVES + wv; row < MT; row += G * NWAVES) {
        const float* xp = x + (size_t)row * DM + lane * 4;
        f32x4 v[4]; float ss = 0.f;
#pragma unroll
        for (int i = 0; i < 4; ++i) { v[i] = *(const f32x4*)(xp + i * 256); ss += v[i][0] * v[i][0] + v[i][1] * v[i][1] + v[i][2] * v[i][2] + v[i][3] * v[i][3]; }
        ss = wave_sum(ss);
        const float rstd = rsqrtf(ss * (1.0f / DM) + EPS);
#pragma unroll
        for (int i = 0; i < 4; ++i) { const int col = i * 256 + lane * 4; const f32x4 g4 = *(const f32x4*)(gain + col);
            *(f32x4*)(out + (size_t)row * DM + col) = v[i] * rstd * g4; }
    }
}

__device__ __forceinline__ void kvnorm_phase(unsigned char* lds, const f16* PROJ, const float* g, f16* KV, f16* KVT, int G, int wg) {
    const int tid = ltid();
    f16* T = (f16*)lds;
    for (int blk = wg; blk < MT / 64; blk += G) {
        const int tok = tid >> 3, ch = tid & 7; const size_t row = (size_t)blk * 64 + tok;
        const f16* p = PROJ + row * NPJ + C_DKV + ch * 16;
        const f16x8 a = *(const f16x8*)p, b = *(const f16x8*)(p + 8);
        float va[8], vb[8]; float ss = 0.f;
#pragma unroll
        for (int e = 0; e < 8; ++e) { va[e] = (float)a[e]; vb[e] = (float)b[e]; ss += va[e] * va[e] + vb[e] * vb[e]; }
        ss += __shfl_xor(ss, 4); ss += __shfl_xor(ss, 2); ss += __shfl_xor(ss, 1);
        const float rstd = rsqrtf(ss * (1.0f / 128.f) + EPS);
        f16x8 oa, ob;
#pragma unroll
        for (int e = 0; e < 8; ++e) { oa[e] = (f16)(va[e] * rstd * g[ch * 16 + e]); ob[e] = (f16)(vb[e] * rstd * g[ch * 16 + 8 + e]); }
        *(f16x8*)(KV + row * 128 + ch * 16) = oa; *(f16x8*)(KV + row * 128 + ch * 16 + 8) = ob;
        { const int tp = (tok & ~15) | kperm16(tok & 15);
#pragma unroll
        for (int e = 0; e < 8; ++e) { T[(ch * 16 + e) * 72 + tp] = oa[e]; T[(ch * 16 + 8 + e) * 72 + tp] = ob[e]; } }
        __syncthreads();
        { const int dim = tid >> 2, tc = (tid & 3) * 16; const int bb = (blk * 64) >> 11, t0 = (blk * 64) & 2047;
          const f16x8 x0 = *(const f16x8*)(T + dim * 72 + tc), x1 = *(const f16x8*)(T + dim * 72 + tc + 8);
          f16* q = KVT + ((size_t)bb * 128 + dim) * SEQ + t0 + tc;
          *(f16x8*)q = x0; *(f16x8*)(q + 8) = x1; }
        __syncthreads();
    }
}

__device__ __forceinline__ void prenorm0_phase(const float* x, const float* gain, const float* sc, f16* An, float* ssq, int G, int wg) {
    const int tid_ = ltid(); const int lane = tid_ & 63, wv = tid_ >> 6;
    for (int row = wg * NWAVES + wv; row < MT; row += G * NWAVES) {
        const int b = row >> 11; const float* xp = x + (size_t)row * DM + lane * 4;
        f32x4 v[4]; float ss = 0.f;
#pragma unroll
        for (int i = 0; i < 4; ++i) { v[i] = *(const f32x4*)(xp + i * 256); ss += v[i][0] * v[i][0] + v[i][1] * v[i][1] + v[i][2] * v[i][2] + v[i][3] * v[i][3]; }
        ss = wave_sum(ss);
        if (lane == 0) ssq[row] = ss;
#pragma unroll
        for (int i = 0; i < 4; ++i) { const int col = i * 256 + lane * 4;
            const f32x4 g4 = *(const f32x4*)(gain + col), s4 = *(const f32x4*)(sc + (size_t)b * 6144 + col);
            f16x4 o;
#pragma unroll
            for (int e = 0; e < 4; ++e) o[e] = (f16)(v[i][e] * (g4[e] * (1.f + s4[e])));
            *(f16x4*)(An + (size_t)row * DM + col) = o; }
    }
}

__device__ __forceinline__ void bw_phase(unsigned char* lds, const Ptrs& P, const float* MOD, float* BW, int G, int wg) {
    const int tid = ltid(), lane = tid & 63, wv = tid >> 6;
    float* SH = (float*)lds;
    float* RED = (float*)(lds + 65536);
    for (int u = wg; u < 2 * 116; u += G) {
        const int l = u / 116, r = u % 116, site = (r < 52) ? 0 : 1, cb = (site == 0) ? r : r - 52;
        const int N = (site == 0) ? NPJ_VALID : FF;
        const float* W = (site == 0) ? P.w_in + (size_t)l * DM * NPJ_VALID : P.w_up + (size_t)l * DM * FF;
        const float* shp = MOD + (size_t)l * 16 * 6144 + (site == 0 ? 0 : 3) * DM;
        __syncthreads();
        for (int i = tid; i < 16 * 1024; i += NTHR) { const int b = i >> 10, k = i & 1023; SH[k * 16 + b] = shp[(size_t)b * 6144 + k]; }
        __syncthreads();
        const int col = cb * 64 + lane; const bool ok = col < N;
        const float* wp = W + (ok ? col : 0);
        float acc[16];
#pragma unroll
        for (int b = 0; b < 16; ++b) acc[b] = 0.f;
        for (int k = wv * 128; k < wv * 128 + 128; ++k) {
            const float w = ok ? wp[(size_t)k * N] : 0.f;
            const f32x4 s0 = *(const f32x4*)(SH + k * 16), s1 = *(const f32x4*)(SH + k * 16 + 4), s2 = *(const f32x4*)(SH + k * 16 + 8), s3 = *(const f32x4*)(SH + k * 16 + 12);
#pragma unroll
            for (int e = 0; e < 4; ++e) { acc[e] += s0[e] * w; acc[4 + e] += s1[e] * w; acc[8 + e] += s2[e] * w; acc[12 + e] += s3[e] * w; }
        }
#pragma unroll
        for (int b = 0; b < 16; ++b) RED[(wv * 16 + b) * 64 + lane] = acc[b];
        __syncthreads();
        for (int i = tid; i < 1024; i += NTHR) { const int b = i >> 6, cc = i & 63; float s = 0.f;
#pragma unroll
            for (int w8 = 0; w8 < 8; ++w8) s += RED[(w8 * 16 + b) * 64 + cc];
            BW[(((size_t)l * 2 + site) * 16 + b) * 4096 + cb * 64 + cc] = s; }
    }
    __syncthreads();
}

__device__ __forceinline__ void vtrans_phase(unsigned char* lds, const f16* PROJ, f16* VTA, int G, int wg) {
    const int tid = ltid();
    f16* T = (f16*)lds;
    for (int blk = wg; blk < 16 * 8 * 32; blk += G) {
        const int bh = blk >> 5, tb = blk & 31, b = bh >> 3, h = bh & 7;
        const int tok = tid >> 3, ch = tid & 7;
        const f16x8 v = *(const f16x8*)(PROJ + ((size_t)b * SEQ + tb * 64 + tok) * NPJ + C_SBV + h * 64 + ch * 8);
        const int tp = (tok & ~15) | kperm16(tok & 15);
#pragma unroll
        for (int e = 0; e < 8; ++e) T[(ch * 8 + e) * 72 + tp] = v[e];
        __syncthreads();
        { const int dim = tid >> 3, kc = (tid & 7) * 8;
          *(f16x8*)(VTA + ((size_t)bh * 64 + dim) * SEQ + tb * 64 + kc) = *(const f16x8*)(T + dim * 72 + kc); }
        __syncthreads();
    }
}

#define SB_LOAD(KF, VF, HT) do { const int _ht = (HT) < 0 ? 0 : (HT); \
    _Pragma("unroll") for (int s = 0; s < 4; ++s) KF[s] = *(const f16x8*)(kp + (size_t)_ht * 32 * NPJ + 16 * s); \
    _Pragma("unroll") for (int d = 0; d < 2; ++d) _Pragma("unroll") for (int s = 0; s < 2; ++s) VF[d][s] = *(const f16x8*)(vp + (size_t)d * 32 * SEQ + _ht * 32 + 16 * s); } while (0)

#define SB_COMPUTE(KF, VF, HT) do { \
    f32x16 S; _Pragma("unroll") for (int r = 0; r < 16; ++r) S[r] = 0.f; \
    _Pragma("unroll") for (int s = 0; s < 4; ++s) S = __builtin_amdgcn_mfma_f32_32x32x16_f16(KF[s], qf[s], S, 0, 0, 0); \
    f32x16 om; \
    _Pragma("unroll") for (int r = 0; r < 16; ++r) { \
        const float zc = __builtin_amdgcn_fmed3f(S[r], -640.f, 640.f);                    \
        const float e1 = __builtin_amdgcn_exp2f(zc * (-0.125f * LOG2E));                  \
        const float be = __builtin_amdgcn_rcpf(1.0f + e1);                                \
        S[r] = be; om[r] = e1 * be; }                                                      \
    if ((HT) == rb) {                                                                      \
        const int kb = (HT) * 32 + 4 * hh; \
        _Pragma("unroll") for (int r = 0; r < 16; ++r) { const int key = kb + 8 * (r >> 2) + (r & 3); if (key >= q) { S[r] = 0.f; om[r] = 1.0f; } } } \
    float R = C; \
    _Pragma("unroll") for (int g = 3; g >= 0; --g) { \
        const float o0 = om[4 * g], o1 = om[4 * g + 1], o2 = om[4 * g + 2], o3 = om[4 * g + 3]; \
        const float gown = (o0 * o1) * (o2 * o3); \
        const float gp = __shfl_xor(gown, 32); \
        const float pre = hh ? R : R * gp; \
        const float p3 = pre, p2 = p3 * o3, p1 = p2 * o2, p0 = p1 * o1; \
        S[4 * g + 3] *= p3; S[4 * g + 2] *= p2; S[4 * g + 1] *= p1; S[4 * g] *= p0; \
        R = R * gown * gp; } \
    C = R; \
    f16x8 pf[2]; \
    _Pragma("unroll") for (int s = 0; s < 2; ++s) _Pragma("unroll") for (int e = 0; e < 8; ++e) pf[s][e] = (f16)S[8 * s + e]; \
    _Pragma("unroll") for (int d = 0; d < 2; ++d) _Pragma("unroll") for (int s = 0; s < 2; ++s) accO[d] = __builtin_amdgcn_mfma_f32_32x32x16_f16(VF[d][s], pf[s], accO[d], 0, 0, 0); \
    } while (0)

__device__ __forceinline__ void sb_attn_phase(unsigned char* lds, const f16* PROJ, const f16* VTA, f16* OBUF, int G, int wg) {
    const int tid = ltid(), lane = tid & 63, wv = tid >> 6, l32 = lane & 31, hh = lane >> 5;
    float* RED = (float*)(lds + 73728);
    int par = 0;
    for (int u = wg; u < 1024; u += G, par ^= 1) {
        const int b = 2 * (u & 7) + ((u >> 3) & 1), rb = 63 - (u >> 4), h = wv, bh = b * 8 + h;
        const size_t rowbase = (size_t)b * SEQ;
        const int r0 = rb * 32, q = r0 + l32;
        f16x8 qf[4];
        { const f16* qp = PROJ + (rowbase + q) * NPJ + C_SBQ + h * 64 + hh * 8;
#pragma unroll
          for (int s = 0; s < 4; ++s) qf[s] = *(const f16x8*)(qp + 16 * s); }
        const f16* kp = PROJ + (rowbase + l32) * NPJ + C_SBK + h * 64 + hh * 8;
        const f16* vp = VTA + ((size_t)bh * 64 + l32) * SEQ + 8 * hh;
        f32x16 accO[2];
#pragma unroll
        for (int d = 0; d < 2; ++d)
#pragma unroll
            for (int r = 0; r < 16; ++r) accO[d][r] = 0.f;
        float C = 1.0f;
        f16x8 kA[4], vA[2][2], kB[4], vB[2][2];
        int ht = rb;
        SB_LOAD(kA, vA, ht);
        for (;;) {
            SB_LOAD(kB, vB, ht - 1);
            SB_COMPUTE(kA, vA, ht);
            if (ht == 0 || __ballot(C >= 2.9e-8f) == 0ull) break;
            --ht;
            SB_LOAD(kA, vA, ht - 1);
            SB_COMPUTE(kB, vB, ht);
            if (ht == 0 || __ballot(C >= 2.9e-8f) == 0ull) break;
            --ht;
        }
        float ssq = 0.f;
#pragma unroll
        for (int d = 0; d < 2; ++d)
#pragma unroll
            for (int r = 0; r < 16; ++r) ssq += accO[d][r] * accO[d][r];
        ssq += __shfl_xor(ssq, 32);
        if (hh == 0) RED[(par * 8 + wv) * 32 + l32] = ssq;
        __syncthreads();
        float tot = 0.f;
#pragma unroll
        for (int w8 = 0; w8 < 8; ++w8) tot += RED[(par * 8 + w8) * 32 + l32];
        const float rstd = rsqrtf(tot * (1.0f / 512.f) + EPS);
        { f16* op = OBUF + (rowbase + q) * DM + h * 64 + 4 * hh;
#pragma unroll
          for (int d = 0; d < 2; ++d)
#pragma unroll
            for (int g = 0; g < 4; ++g) { f16x4 o; o[0] = (f16)(accO[d][4 * g] * rstd); o[1] = (f16)(accO[d][4 * g + 1] * rstd); o[2] = (f16)(accO[d][4 * g + 2] * rstd); o[3] = (f16)(accO[d][4 * g + 3] * rstd);
                *(f16x4*)(op + 32 * d + 8 * g) = o; } }
    }
}
constexpr int IDX_PITCH = 2052;
__device__ __forceinline__ unsigned radix_scan(const unsigned* hist, int lane, unsigned& digit, unsigned& rank) {
    const u32x4 b = *(const u32x4*)(hist + 4 * lane);
    const unsigned s = b[0] + b[1] + b[2] + b[3];
    unsigned p = s;
    p += (unsigned)__builtin_amdgcn_update_dpp(0, (int)p, 0x101, 0xf, 0xf, true);
    p += (unsigned)__builtin_amdgcn_update_dpp(0, (int)p, 0x102, 0xf, 0xf, true);
    p += (unsigned)__builtin_amdgcn_update_dpp(0, (int)p, 0x104, 0xf, 0xf, true);
    p += (unsigned)__builtin_amdgcn_update_dpp(0, (int)p, 0x108, 0xf, 0xf, true);
    { const unsigned t1 = __builtin_amdgcn_readlane(p, 16), t2 = __builtin_amdgcn_readlane(p, 32), t3 = __builtin_amdgcn_readlane(p, 48);
      p += (lane < 16) ? (t1 + t2 + t3) : (lane < 32) ? (t2 + t3) : (lane < 48) ? t3 : 0u; }
    const unsigned long long ge = __ballot(p >= rank);
    const int L = __popcll(ge) - 1;
    const unsigned pL = __builtin_amdgcn_readlane(p, L), sL = __builtin_amdgcn_readlane(s, L);
    unsigned r = rank - (pL - sL);
    const unsigned b3 = __builtin_amdgcn_readlane(b[3], L), b2 = __builtin_amdgcn_readlane(b[2], L), b1 = __builtin_amdgcn_readlane(b[1], L);
    unsigned k = 3, bc = b3;
    if (r > b3) { r -= b3; k = 2; bc = b2; if (r > b2) { r -= b2; k = 1; bc = b1; if (r > b1) { r -= b1; k = 0; bc = __builtin_amdgcn_readlane(b[0], L); } } }
    digit = 4u * (unsigned)L + k; rank = r; return bc;
}
template <int NJ> __device__ __forceinline__ unsigned topk_words(const float* row, int nadm, int lane, unsigned* hist, unsigned* hist_dummy) {
    unsigned uk[NJ];
#pragma unroll
    for (int j = 0; j < NJ; ++j) {
        const int key = 64 * j + lane;
        unsigned bits = 0u;
        if (key < nadm) { bits = __float_as_uint(row[key]); bits ^= (unsigned)(((int)bits >> 31) | 0x80000000); }
        uk[j] = bits;
    }
    unsigned rank = 256u, T = 0u, dg;
    unsigned* dummy = hist_dummy + lane;
    *(u32x4*)(hist + 4 * lane) = (u32x4){0u, 0u, 0u, 0u};
#pragma unroll
    for (int j = 0; j < NJ; ++j) __hip_atomic_fetch_add(hist + (uk[j] >> 24), 1u, __ATOMIC_RELAXED, __HIP_MEMORY_SCOPE_WORKGROUP);
    unsigned binc = radix_scan(hist, lane, dg, rank); T = dg << 24;
#pragma unroll
    for (int lv = 1; lv < 4; ++lv) {
        const int sh = 24 - 8 * lv;
        if (binc == rank) break;
        *(u32x4*)(hist + 4 * lane) = (u32x4){0u, 0u, 0u, 0u};
        const unsigned pre = T >> (sh + 8);
#pragma unroll
        for (int j = 0; j < NJ; ++j) { unsigned* dst = ((uk[j] >> (sh + 8)) == pre) ? hist + ((uk[j] >> sh) & 255u) : dummy;
            __hip_atomic_fetch_add(dst, 1u, __ATOMIC_RELAXED, __HIP_MEMORY_SCOPE_WORKGROUP); }
        binc = radix_scan(hist, lane, dg, rank); T |= dg << sh;
    }
    unsigned word = 0u;
    if (binc == rank) {
#pragma unroll
        for (int j = 0; j < NJ; ++j) {
            const unsigned long long sel = __ballot(uk[j] >= T);
            asm volatile("s_nop 3\n\tv_writelane_b32 %0, %1, %3\n\tv_writelane_b32 %0, %2, %4" : "+v"(word) : "s"((unsigned)sel), "s"((unsigned)(sel >> 32)), "n"(2 * j), "n"(2 * j + 1));
        }
    } else {
        int need = (int)rank;
#pragma unroll
        for (int j = 0; j < NJ; ++j) {
            unsigned long long sel = __ballot(uk[j] > T);
            unsigned long long em = __ballot(uk[j] == T);
            if (need > 0 && em != 0ull) {
                const int pc = __popcll(em);
                if (pc <= need) { sel |= em; need -= pc; }
                else { unsigned long long keep = 0ull; for (int i = 0; i < need; ++i) { const unsigned long long lowb = em & (0ull - em); keep |= lowb; em ^= lowb; } sel |= keep; need = 0; }
            }
            asm volatile("s_nop 3\n\tv_writelane_b32 %0, %1, %3\n\tv_writelane_b32 %0, %2, %4" : "+v"(word) : "s"((unsigned)sel), "s"((unsigned)(sel >> 32)), "n"(2 * j), "n"(2 * j + 1));
        }
    }
    return word;
}
__device__ __forceinline__ void indexer_phase(unsigned char* lds, const f16* PROJ, unsigned* MASK, int G, int wg, bool do_topk) {
    const int tid = ltid(), lane = tid & 63, wv = tid >> 6, l16 = lane & 15, lq = lane >> 4;
    float* SCR = (float*)lds;
    unsigned* hist = (unsigned*)(lds + 136192) + wv * 256;
    unsigned* hdum = (unsigned*)(lds + 136192 + 8192) + wv * 64;
    f16x8 qa[8][2]; f16x8 w8r[4]; f16x8 ka[4][2];
#define IDX_LOAD_UNIT(U) do { const int _b = 2 * ((U) & 7) + (((U) >> 3) & 1), _q0 = (127 - ((U) >> 4)) * 16; const size_t _rb = (size_t)_b * SEQ; \
        const f16* _qp = PROJ + (_rb + _q0 + l16) * NPJ + C_IQ + lq * 8; \
        _Pragma("unroll") for (int hd = 0; hd < 8; ++hd) _Pragma("unroll") for (int s_ = 0; s_ < 2; ++s_) qa[hd][s_] = *(const f16x8*)(_qp + hd * 64 + 32 * s_); \
        _Pragma("unroll") for (int r = 0; r < 4; ++r) w8r[r] = *(const f16x8*)(PROJ + (_rb + _q0 + 4 * lq + r) * NPJ + C_IW); \
        const int _c0 = (((64 * ((_q0 >> 6) + 1)) >> 4) + 7) >> 3; const f16* _kb = PROJ + (_rb + wv * 16 + l16) * NPJ + C_IK + lq * 8; \
        _Pragma("unroll") for (int j = 0; j < 4; ++j) { const int _it = (j < _c0 - 1) ? j : _c0 - 1; const f16* _kp = _kb + (size_t)_it * (128 * NPJ); ka[j][0] = *(const f16x8*)_kp; ka[j][1] = *(const f16x8*)(_kp + 32); } } while (0)
    if (wg < MT / 16) IDX_LOAD_UNIT(wg);
    for (int u = wg; u < MT / 16; u += G) {
        const int b = 2 * (u & 7) + ((u >> 3) & 1), qg = 127 - (u >> 4);
        const int q0 = qg * 16; const size_t rowbase = (size_t)b * SEQ;
        const int nadm = 64 * ((q0 >> 6) + 1);
        float wq[4][8];
#pragma unroll
        for (int r = 0; r < 4; ++r)
#pragma unroll
            for (int hd = 0; hd < 8; ++hd) wq[r][hd] = (float)w8r[r][hd] * (0.35355339059327373f * 0.125f);
        const int ntile = nadm >> 4;
        const int c0 = (ntile + 7) >> 3, cnt = (c0 + 3) & ~3;
        const f16* kbase = PROJ + (rowbase + wv * 16 + l16) * NPJ + C_IK + lq * 8;
        for (int i = 0; i < cnt; i += 4) {
#pragma unroll
            for (int j = 0; j < 4; ++j) {
                const int it = (i + j < c0 - 1) ? i + j : c0 - 1;
                f32x4 sc = {0.f, 0.f, 0.f, 0.f};
                f32x4 a[8];
#pragma unroll
                for (int hd = 0; hd < 8; ++hd) { a[hd] = (f32x4){0.f, 0.f, 0.f, 0.f}; a[hd] = __builtin_amdgcn_mfma_f32_16x16x32_f16(qa[hd][0], ka[j][0], a[hd], 0, 0, 0); }
#pragma unroll
                for (int hd = 0; hd < 8; ++hd) a[hd] = __builtin_amdgcn_mfma_f32_16x16x32_f16(qa[hd][1], ka[j][1], a[hd], 0, 0, 0);
                __builtin_amdgcn_sched_barrier(0);
#pragma unroll
                for (int hd = 0; hd < 8; ++hd)
#pragma unroll
                    for (int r = 0; r < 4; ++r) { const int bi = __float_as_int(a[hd][r]); sc[r] += wq[r][hd] * __int_as_float(bi > 0 ? bi : 0); }
                { const int itn = (i + j + 4 < c0 - 1) ? i + j + 4 : c0 - 1; const f16* kp = kbase + (size_t)itn * (128 * NPJ); ka[j][0] = *(const f16x8*)kp; ka[j][1] = *(const f16x8*)(kp + 32); }
#pragma unroll
                for (int r = 0; r < 4; ++r) SCR[(4 * lq + r) * IDX_PITCH + (wv + 8 * it) * 16 + l16] = sc[r] + 0.0f;
            }
        }
        __syncthreads();
        if (u + G < MT / 16) IDX_LOAD_UNIT(u + G);
#ifndef TOPK_REP
#define TOPK_REP 1
#endif
        if (do_topk) for (int qs = 0; qs < 2 * TOPK_REP; ++qs) {
            const int qq = 2 * wv + (qs & 1);
            unsigned* mrow = MASK + (rowbase + q0 + qq) * 64;
            unsigned word = 0u;
            if (nadm <= 256) {
                word = (lane * 32 < nadm) ? 0xFFFFFFFFu : 0u;
            } else {
                const float* row = SCR + qq * IDX_PITCH;
                if (nadm <= 512) word = topk_words<8>(row, nadm, lane, hist, hdum);
                else if (nadm <= 1024) word = topk_words<16>(row, nadm, lane, hist, hdum);
                else if (nadm <= 1536) word = topk_words<24>(row, nadm, lane, hist, hdum);
                else word = topk_words<32>(row, nadm, lane, hist, hdum);
            }
            mrow[lane] = word;
        }
        __syncthreads();
    }
}
__device__ __forceinline__ void dsa_attn_phase(unsigned char* lds, const f16* PROJ, const f16* KV, const f16* KVT, const unsigned* MASK, const float* BIAS2, const f16* WUVT, f16* OBUF, int G, int wg) {
    const int tid = ltid(), lane = tid & 63, wv = tid >> 6, l32 = lane & 31, hh = lane >> 5;
    f16* KlB = (f16*)lds;
    f16* VlB = (f16*)(lds + 2 * 17408);
    const int hd = wv;
    const float c1 = 0.08838834764831845f * LOG2E;
    const int skey = tid >> 3, skc = (tid & 7) * 16, sdim = tid >> 2, sdc = (tid & 3) * 16;
    f16x8 qraw[8], k0, k1, t0, t1;
#define DSA_UNIT_BQ(U, B_, QI_) do { if (G == 256) { const int _j = wg >> 4, _i = (U) >> 8; B_ = 2 * (wg & 7) + ((wg >> 3) & 1);     QI_ = (_i == 0) ? 63 - _j : (_i == 1) ? 32 + _j : (_i == 2) ? 31 - _j : _j; } \
        else { B_ = (U) & 15; QI_ = 63 - ((U) >> 4); } } while (0)
#define DSA_LOAD_UNIT(U) do { int _b, _qi; DSA_UNIT_BQ(U, _b, _qi); const size_t _rb = (size_t)_b * SEQ; \
        const f16* _qp = PROJ + (_rb + _qi * 32 + l32) * NPJ + C_DQ + hd * 128 + hh * 8; \
        _Pragma("unroll") for (int s_ = 0; s_ < 8; ++s_) qraw[s_] = *(const f16x8*)(_qp + 16 * s_); \
        const f16* _kv = KV + (_rb + skey) * 128 + skc; const f16* _kt = KVT + ((size_t)_b * 128 + sdim) * SEQ + sdc; \
        k0 = *(const f16x8*)_kv; k1 = *(const f16x8*)(_kv + 8); t0 = *(const f16x8*)_kt; t1 = *(const f16x8*)(_kt + 8); } while (0)
    float* BL = (float*)(lds + 77824) + wv * 256;
    { const float* bsrc = BIAS2 + hd * 2112 + 2047 - 192;
#pragma unroll
      for (int i = 0; i < 4; ++i) BL[lane + 64 * i] = bsrc[lane + 64 * i]; }
    float* RED = (float*)(lds + 73728 + 2048);
    int par = 0;
    for (int u = wg; u < 1024; u += G, par ^= 1) {
        int b, qi; DSA_UNIT_BQ(u, b, qi);
        DSA_LOAD_UNIT(u);
        const int q0 = qi * 32; const size_t rowbase = (size_t)b * SEQ;
        const int ntile = (q0 >> 6) + 1;
        f16x8 qf[8];
#pragma unroll
        for (int s = 0; s < 8; ++s)
#pragma unroll
            for (int e = 0; e < 8; ++e) qf[s][e] = (f16)((float)qraw[s][e] * c1);
        const unsigned* mrow = MASK + (rowbase + q0 + l32) * 64;
        const int q = q0 + l32;
        f32x16 accO[4];
#pragma unroll
        for (int d = 0; d < 4; ++d)
#pragma unroll
            for (int r = 0; r < 16; ++r) accO[d][r] = 0.f;
        float mrun = 0.f, lsum = 0.f;
        const f16* kvp = KV + (rowbase + skey) * 128 + skc;
        const f16* ktp = KVT + ((size_t)b * 128 + sdim) * SEQ + sdc;
        __syncthreads();
        { f16* Kw = KlB + skey * 136 + skc; f16* Vw = VlB + sdim * 72 + sdc;
          *(f16x8*)Kw = k0; *(f16x8*)(Kw + 8) = k1; *(f16x8*)Vw = t0; *(f16x8*)(Vw + 8) = t1; }
        __syncthreads();
        for (int kt = 0; kt < ntile; ++kt) {
            const f16* Kl = KlB + (kt & 1) * (64 * 136); const f16* Vl = VlB + (kt & 1) * (128 * 72);
            if (kt + 1 < ntile) { const f16* a = kvp + (size_t)(kt + 1) * 64 * 128; const f16* c = ktp + (kt + 1) * 64;
                k0 = *(const f16x8*)a; k1 = *(const f16x8*)(a + 8); t0 = *(const f16x8*)c; t1 = *(const f16x8*)(c + 8); }
            const u32x2 mw = *(const u32x2*)(mrow + 2 * kt);
            const bool near = (kt * 64 + 63 + 96 > q0);
            const float* bp = BL + 192 - q + kt * 64 + 4 * hh;
            f32x16 S0, S1;
            { const float ninit = -mrun;
#pragma unroll
              for (int r = 0; r < 16; ++r) { S0[r] = ninit; S1[r] = ninit; } }
#define DSA_QK(SX, T_) do { _Pragma("unroll") for (int s4 = 0; s4 < 8; s4 += 4) { f16x8 kf[4]; \
                _Pragma("unroll") for (int s = 0; s < 4; ++s) kf[s] = *(const f16x8*)(Kl + (32 * (T_) + l32) * 136 + 16 * (s4 + s) + 8 * hh); \
                __builtin_amdgcn_sched_barrier(0); __builtin_amdgcn_s_setprio(1); \
                _Pragma("unroll") for (int s = 0; s < 4; ++s) SX = __builtin_amdgcn_mfma_f32_32x32x16_f16(kf[s], qf[s4 + s], SX, 0, 0, 0); __builtin_amdgcn_s_setprio(0); } } while (0)
#define DSA_SOFTMAX(SX, SOTHER, T_, PF) do { \
                if (near) { _Pragma("unroll") for (int g = 0; g < 4; ++g) _Pragma("unroll") for (int e = 0; e < 4; ++e) SX[4 * g + e] += bp[32 * (T_) + 8 * g + e]; } \
                float tmax = SX[0]; _Pragma("unroll") for (int r = 1; r < 16; ++r) tmax = fmaxf(tmax, SX[r]); \
                const bool first = (kt == 0 && (T_) == 0); \
                if (first || __ballot(tmax > 8.0f) != 0ull) { \
                    const float tm2 = fmaxf(tmax, __shfl_xor(tmax, 32)); \
                    const float delta = (first || tm2 > 8.0f) ? tm2 : 0.f; \
                    const float alpha = __builtin_amdgcn_exp2f(-delta); \
                    mrun += delta; lsum *= alpha; \
                    _Pragma("unroll") for (int r = 0; r < 16; ++r) { SX[r] -= delta; if ((T_) == 0) SOTHER[r] -= delta; }     \
                    _Pragma("unroll") for (int d = 0; d < 4; ++d) _Pragma("unroll") for (int r = 0; r < 16; ++r) accO[d][r] *= alpha; } \
                const unsigned wsh = ((T_) == 0 ? mw[0] : mw[1]) >> (4 * hh); \
                float ps = 0.f; \
                _Pragma("unroll") for (int r = 0; r < 16; ++r) { \
                    const float p = __builtin_amdgcn_exp2f(SX[r]); float pm; \
                    asm("v_bfe_i32 %0, %1, %2, 1\n\tv_and_b32 %0, %0, %3" : "=&v"(pm) : "v"(wsh), "n"(8 * (r >> 2) + (r & 3)), "v"(p)); \
                    SX[r] = pm; ps += pm; } \
                lsum += ps; \
                _Pragma("unroll") for (int s = 0; s < 2; ++s) _Pragma("unroll") for (int e = 0; e < 8; ++e) PF[s][e] = (f16)SX[8 * s + e]; } while (0)
#define DSA_PV(PF, T_) do { _Pragma("unroll") for (int d2 = 0; d2 < 4; d2 += 2) { f16x8 vf[2][2]; \
                _Pragma("unroll") for (int d = 0; d < 2; ++d) _Pragma("unroll") for (int s = 0; s < 2; ++s) vf[d][s] = *(const f16x8*)(Vl + (32 * (d2 + d) + l32) * 72 + 32 * (T_) + 16 * s + 8 * hh); \
                __builtin_amdgcn_sched_barrier(0); __builtin_amdgcn_s_setprio(1); \
                _Pragma("unroll") for (int d = 0; d < 2; ++d) _Pragma("unroll") for (int s = 0; s < 2; ++s) accO[d2 + d] = __builtin_amdgcn_mfma_f32_32x32x16_f16(vf[d][s], PF[s], accO[d2 + d], 0, 0, 0); __builtin_amdgcn_s_setprio(0); } } while (0)
            DSA_QK(S0, 0); DSA_QK(S1, 1);
            { f16x8 pf0[2]; DSA_SOFTMAX(S0, S1, 0, pf0); DSA_PV(pf0, 0); }
            { f16x8 pf1[2]; DSA_SOFTMAX(S1, S0, 1, pf1); DSA_PV(pf1, 1); }
#undef DSA_QK
#undef DSA_SOFTMAX
#undef DSA_PV
            if (kt + 1 < ntile) { f16* Kw = KlB + ((kt + 1) & 1) * (64 * 136) + skey * 136 + skc; f16* Vw = VlB + ((kt + 1) & 1) * (128 * 72) + sdim * 72 + sdc;
                *(f16x8*)Kw = k0; *(f16x8*)(Kw + 8) = k1; *(f16x8*)Vw = t0; *(f16x8*)(Vw + 8) = t1; }
            __syncthreads();
        }
        const float ltot = lsum + __shfl_xor(lsum, 32);
        const float inv = 1.0f / ltot;
        f32x16 Z[2];
#pragma unroll
        for (int n = 0; n < 2; ++n)
#pragma unroll
            for (int r = 0; r < 16; ++r) Z[n][r] = 0.f;
#pragma unroll
        for (int dh = 0; dh < 2; ++dh) {
            f16x4 wlo[2][2][2], whi[2][2][2];
#pragma unroll
            for (int d = 0; d < 2; ++d)
#pragma unroll
                for (int s = 0; s < 2; ++s)
#pragma unroll
                    for (int n = 0; n < 2; ++n) {
                        const f16* wp = WUVT + ((size_t)hd * 64 + 32 * n + l32) * 128 + 32 * (2 * dh + d) + 16 * s + 4 * hh;
                        wlo[d][s][n] = *(const f16x4*)wp; whi[d][s][n] = *(const f16x4*)(wp + 8);
                    }
#pragma unroll
            for (int d = 0; d < 2; ++d)
#pragma unroll
                for (int s = 0; s < 2; ++s) {
                    f16x8 ob;
#pragma unroll
                    for (int e = 0; e < 8; ++e) ob[e] = (f16)(accO[2 * dh + d][8 * s + e] * inv);
#pragma unroll
                    for (int n = 0; n < 2; ++n) {
                        const f16x4 lo = wlo[d][s][n], hi = whi[d][s][n];
                        f16x8 wa; wa[0] = lo[0]; wa[1] = lo[1]; wa[2] = lo[2]; wa[3] = lo[3]; wa[4] = hi[0]; wa[5] = hi[1]; wa[6] = hi[2]; wa[7] = hi[3];
                        Z[n] = __builtin_amdgcn_mfma_f32_32x32x16_f16(wa, ob, Z[n], 0, 0, 0);
                    }
                }
        }
        float ssq = 0.f;
#pragma unroll
        for (int n = 0; n < 2; ++n)
#pragma unroll
            for (int r = 0; r < 16; ++r) ssq += Z[n][r] * Z[n][r];
        ssq += __shfl_xor(ssq, 32);
        if (hh == 0) RED[(par * 8 + wv) * 32 + l32] = ssq;
        __syncthreads();
        float tot = 0.f;
#pragma unroll
        for (int w8 = 0; w8 < 8; ++w8) tot += RED[(par * 8 + w8) * 32 + l32];
        const float rstd = rsqrtf(tot * (1.0f / 512.f) + EPS);
        { f16* op = OBUF + (rowbase + q) * DM + 512 + hd * 64 + 4 * hh;
#pragma unroll
          for (int n = 0; n < 2; ++n)
#pragma unroll
            for (int g = 0; g < 4; ++g) { f16x4 o; o[0] = (f16)(Z[n][4 * g] * rstd); o[1] = (f16)(Z[n][4 * g + 1] * rstd); o[2] = (f16)(Z[n][4 * g + 2] * rstd); o[3] = (f16)(Z[n][4 * g + 3] * rstd);
                *(f16x4*)(op + 32 * n + 8 * g) = o; } }
    }
}
constexpr int N_PHASES = 15;
struct Args { Ptrs p; int ph_lo, ph_hi; };

__global__ void __launch_bounds__(NTHR, 2) trunk_fwd(Args args) {
    extern __shared__ __attribute__((aligned(16))) unsigned char lds[];
    const Ptrs& P = args.p;
    unsigned char* ws = P.ws;
    const int G = gridDim.x, wg = blockIdx.x, tid = threadIdx.x;
    const int lo = args.ph_lo, hi = args.ph_hi;
    const bool multi = (hi - lo) > 1;
    XcdBarrier bar; bar.bar = (unsigned*)(ws + WS_CTL); bar.x = 0; bar.st = nullptr;
    if (multi) {
        if (tid < 4) ((LAS unsigned*)(lds + LDS_MISC))[tid] = 0u;
        __syncthreads();
        bar = xcd_barrier_post((unsigned*)(ws + WS_CTL), (volatile LAS unsigned*)(lds + LDS_MISC));
    }
#ifndef REP_IDX
#define REP_IDX 1
#endif
#ifndef REP_IDX_SCORE_ONLY
#define REP_IDX_SCORE_ONLY 0
#endif
#ifndef REP_SB
#define REP_SB 1
#endif
#ifndef REP_DSA
#define REP_DSA 1
#endif
#ifndef REP_GIN
#define REP_GIN 1
#endif
#ifndef REP_GUP
#define REP_GUP 1
#endif
#ifndef PHMASK
#define PHMASK 0xFFFFF
#endif
#define IN(k) (lo <= (k) && (k) < hi)
#define PM(j) ((PHMASK >> (j)) & 1)
#define SEAM(k) do { if (IN(k) && IN((k) + 1)) xcd_barrier(bar); } while (0)
    float* MOD = (float*)(ws + WS_MOD);
    f16* H = (f16*)(ws + WS_H); f16* PROJ = (f16*)(ws + WS_PROJ); f16* OBUF = (f16*)(ws + WS_OBUF); f16* HID = (f16*)(ws + WS_HID);
    f16* KV = (f16*)(ws + WS_KV); f16* KVT = (f16*)(ws + WS_KVT); f16* VTA = (f16*)(ws + WS_VTA); unsigned* MASK = (unsigned*)(ws + WS_MASK);
    float* X = P.out;

    float* SSQ = (float*)(ws + WS_SSQ); float* BW = (float*)(ws + WS_BW);
    if (PM(0) && IN(0)) { prologue_phase(lds, P, G, wg); SEAM(0); }
    if (PM(1) && IN(1)) {
        bw_phase(lds, P, MOD, BW, G, wg);
        prenorm0_phase(P.x, P.g_attn, MOD + 1 * DM, H, SSQ, G, wg);
        SEAM(1);
    }

    for (int l = 0; l < NLAYER; ++l) {
        const int pb = 2 + 6 * l;
        const float* modl = MOD + (size_t)l * 16 * 6144;
        const float* xin = (l == 0) ? P.x : X;
        const float* ssq1 = SSQ + (size_t)(l == 0 ? 0 : 2) * MT;
        float* ssq2 = SSQ + (size_t)(l == 0 ? 1 : 3) * MT;
        if (PM(2) && IN(pb + 0)) {
            pg8::Gemm g{H, (const f16*)(ws + WS_WIN) + (size_t)l * NPJ * DM, MT, NPJ, DM}; pg8::StaticOrder S; S.init(MT, NPJ, G, wg);
            pg8::EpiF16N<0> E{PROJ, NPJ, ssq1, BW + (size_t)(l * 2 + 0) * 16 * 4096};
            for (int rep = 0; rep < REP_GIN; ++rep) pg8::gemm_phase<pg8::EpiF16N<0>, pg8::StaticOrder>((LAS unsigned char*)lds, g, S, E);
            SEAM(pb + 0);
        }
        if (PM(3) && IN(pb + 1)) {
#if ENABLE_DSA
            kvnorm_phase(lds, PROJ, P.kv_norm_g + l * 128, KV, KVT, G, wg);
            __syncthreads();
#endif
#if ENABLE_SB
            vtrans_phase(lds, PROJ, VTA, G, wg);
            __syncthreads();
#endif
#if ENABLE_DSA
            for (int rep = 0; rep < REP_IDX; ++rep) { indexer_phase(lds, PROJ, MASK, G, wg, rep == 0 || !REP_IDX_SCORE_ONLY); __syncthreads(); }
#endif
            SEAM(pb + 1);
        }
        if (PM(4) && IN(pb + 2)) {
            for (int rep = 0; rep < REP_SB; ++rep) { sb_attn_phase(lds, PROJ, VTA, OBUF, G, wg); }
            for (int rep = 0; rep < REP_DSA; ++rep) { __syncthreads(); dsa_attn_phase(lds, PROJ, KV, KVT, MASK, (const float*)(ws + WS_BIAS), (const f16*)(ws + WS_WUV) + (size_t)l * 8 * 64 * 128, OBUF, G, wg); }
            SEAM(pb + 2);
        }
        if (PM(6) && IN(pb + 3)) {
            pg8::Gemm g{OBUF, (const f16*)(ws + WS_WOUT) + (size_t)l * DM * DM, MT, DM, DM}; pg8::StaticOrder S; S.init(MT, DM, G, wg);
            pg8::EpiResidN E{xin, X, modl + 2 * DM, P.g_mlp + l * DM, modl + 4 * DM, H, ssq2};
            pg8::gemm_phase<pg8::EpiResidN, pg8::StaticOrder>((LAS unsigned char*)lds, g, S, E);
            SEAM(pb + 3);
        }
        if (PM(8) && IN(pb + 4)) {
            pg8::Gemm g{H, (const f16*)(ws + WS_WUP) + (size_t)l * FF * DM, MT, FF, DM}; pg8::StaticOrder S; S.init(MT, FF, G, wg);
            pg8::EpiF16N<1> E{HID, FF, ssq2, BW + (size_t)(l * 2 + 1) * 16 * 4096};
            for (int rep = 0; rep < REP_GUP; ++rep) pg8::gemm_phase<pg8::EpiF16N<1>, pg8::StaticOrder>((LAS unsigned char*)lds, g, S, E);
            SEAM(pb + 4);
        }
        if (PM(9) && IN(pb + 5)) {
            pg8::Gemm g{HID, (const f16*)(ws + WS_WDN) + (size_t)l * DM * FF, MT, DM, FF}; pg8::StaticOrder S; S.init(MT, DM, G, wg);
            if (l == 0) {
                pg8::EpiResidN E{X, X, modl + 5 * DM, P.g_attn + DM, MOD + (size_t)16 * 6144 + 1 * DM, H, SSQ + (size_t)2 * MT};
                pg8::gemm_phase<pg8::EpiResidN, pg8::StaticOrder>((LAS unsigned char*)lds, g, S, E);
            } else {
                pg8::EpiResid E{X, X, modl + 5 * DM};
                pg8::gemm_phase<pg8::EpiResid, pg8::StaticOrder>((LAS unsigned char*)lds, g, S, E);
            }
            SEAM(pb + 5);
        }
    }
    if (PM(10) && IN(14)) { final_norm_phase(X, P.g_final, P.out, G, wg); }
#undef IN
#undef SEAM
}

extern "C" void kernel_launch(void* const* d_in, const int* in_sizes, int n_in, void* d_out, int out_size, void* d_ws, size_t ws_size, hipStream_t stream) {
    static int grid = 0;
    if (grid == 0) {
        if (n_in != 16 || in_sizes[0] != MT * DM || out_size != MT * DM || ws_size < WS_END) {
            fprintf(stderr, "kernel_launch: unexpected shapes: n_in %d in0 %d out %d ws %zu (need %zu)\n", n_in, n_in > 0 ? in_sizes[0] : -1, out_size, ws_size, (size_t)WS_END); grid = -1; return; }
        int dev = 0, cus = 0, per_cu = 0;
        if (hipGetDevice(&dev) != hipSuccess || hipDeviceGetAttribute(&cus, hipDeviceAttributeMultiprocessorCount, dev) != hipSuccess) { grid = -1; return; }
        if (hipFuncSetAttribute((const void*)trunk_fwd, hipFuncAttributeMaxDynamicSharedMemorySize, LDS_BYTES) != hipSuccess) { fprintf(stderr, "kernel_launch: hipFuncSetAttribute failed\n"); grid = -1; return; }
        if (hipOccupancyMaxActiveBlocksPerMultiprocessor(&per_cu, (const void*)trunk_fwd, NTHR, LDS_BYTES) != hipSuccess || per_cu < 1) fprintf(stderr, "kernel_launch: occupancy query says %d\n", per_cu);
        (void)hipGetLastError();
        grid = cus;
    }
    if (grid < 0) return;
    (void)hipMemsetAsync((char*)d_ws + WS_CTL, 0, CTL_BYTES, stream);
    Args a{};
    a.p.x = (const float*)d_in[0]; a.p.c = (const float*)d_in[1]; a.p.w_mod = (const float*)d_in[2]; a.p.b_mod = (const float*)d_in[3]; a.p.g_attn = (const float*)d_in[4];
    a.p.w_in = (const float*)d_in[5]; a.p.kv_norm_g = (const float*)d_in[6]; a.p.w_uv = (const float*)d_in[7]; a.p.g_out_a = (const float*)d_in[8]; a.p.g_out_b = (const float*)d_in[9];
    a.p.w_out = (const float*)d_in[10]; a.p.g_mlp = (const float*)d_in[11]; a.p.w_up = (const float*)d_in[12]; a.p.w_down = (const float*)d_in[13]; a.p.rel_bias = (const float*)d_in[14];
    a.p.g_final = (const float*)d_in[15]; a.p.out = (float*)d_out; a.p.ws = (unsigned char*)d_ws;
#if N_LAUNCH_MODE == 1
    a.ph_lo = 0; a.ph_hi = N_PHASES;
    hipLaunchKernelGGL(trunk_fwd, dim3(grid), dim3(NTHR), LDS_BYTES, stream, a);
#else
    for (int ph = 0; ph < N_PHASES; ++ph) { a.ph_lo = ph; a.ph_hi = ph + 1; hipLaunchKernelGGL(trunk_fwd, dim3(grid), dim3(NTHR), LDS_BYTES, stream, a); }
#endif
}
```

```cpp
#include <hip/hip_runtime.h>
#include <cstdio>
#include <cstdint>

#define LAS __attribute__((address_space(3)))
typedef _Float16 f16;
typedef _Float16 f16x8 __attribute__((ext_vector_type(8)));
typedef _Float16 f16x4 __attribute__((ext_vector_type(4)));
typedef float f32x2 __attribute__((ext_vector_type(2)));
typedef float f32x4 __attribute__((ext_vector_type(4)));
typedef float f32x16 __attribute__((ext_vector_type(16)));
typedef unsigned u32x2 __attribute__((ext_vector_type(2)));
typedef unsigned u32x4 __attribute__((ext_vector_type(4)));

#ifndef N_LAUNCH_MODE
#define N_LAUNCH_MODE 1
#endif
#ifndef ENABLE_SB
#define ENABLE_SB 1
#endif
#ifndef ENABLE_DSA
#define ENABLE_DSA 1
#endif

constexpr int NB = 16, SEQ = 2048, DM = 1024, MT = NB * SEQ, NPJ = 3328, NPJ_VALID = 3272, FF = 4096, NLAYER = 2;
constexpr int C_SBQ = 0, C_SBK = 512, C_SBV = 1024, C_DQ = 1536, C_DKV = 2560, C_IQ = 2688, C_IK = 3200, C_IW = 3264;
constexpr int NWAVES = 8, NTHR = 512;
constexpr float EPS = 1e-6f;
constexpr float LOG2E = 1.4426950408889634f;

constexpr size_t al256(size_t x) { return (x + 255) & ~(size_t)255; }
constexpr size_t WS_CTL = 0;
constexpr size_t CTL_BYTES = 65536;
constexpr size_t WS_MOD = WS_CTL + CTL_BYTES;
constexpr size_t WS_BIAS = WS_MOD + al256((size_t)2 * 16 * 6144 * 4);
constexpr size_t WS_SSQ = WS_BIAS + al256((size_t)8 * 2112 * 4);
constexpr size_t WS_BW = WS_SSQ + (size_t)4 * MT * 4;
constexpr size_t WS_WIN = WS_BW + (size_t)2 * 2 * 16 * 4096 * 4;
constexpr size_t WS_WOUT = WS_WIN + (size_t)2 * NPJ * DM * 2;
constexpr size_t WS_WUP = WS_WOUT + (size_t)2 * DM * DM * 2;
constexpr size_t WS_WDN = WS_WUP + (size_t)2 * FF * DM * 2;
constexpr size_t WS_WUV = WS_WDN + (size_t)2 * FF * DM * 2;
constexpr size_t WS_H = WS_WUV + (size_t)2 * 8 * 64 * 128 * 2;
constexpr size_t WS_KV = WS_H + (size_t)MT * DM * 2;
constexpr size_t WS_KVT = WS_KV + (size_t)MT * 128 * 2;
constexpr size_t WS_VTA = WS_KVT + (size_t)MT * 128 * 2;
constexpr size_t WS_MASK = WS_VTA + (size_t)MT * 512 * 2;
constexpr size_t WS_PROJ = WS_MASK + (size_t)MT * 64 * 4;
constexpr size_t WS_OBUF = WS_PROJ + (size_t)MT * NPJ * 2;
constexpr size_t WS_HID = WS_PROJ;
constexpr size_t WS_END = WS_OBUF + (size_t)MT * DM * 2;
static_assert((size_t)MT * FF * 2 <= WS_END - WS_PROJ, "HID overlay must fit");

constexpr int LDS_BYTES = 147456;
constexpr int LDS_MISC = 135168;

__device__ __forceinline__ float wave_sum(float v) {
    v += __shfl_xor(v, 32); v += __shfl_xor(v, 16); v += __shfl_xor(v, 8); v += __shfl_xor(v, 4); v += __shfl_xor(v, 2); v += __shfl_xor(v, 1); return v;
}
__device__ __forceinline__ float half_sum(float v) {
    v += __shfl_xor(v, 16); v += __shfl_xor(v, 8); v += __shfl_xor(v, 4); v += __shfl_xor(v, 2); v += __shfl_xor(v, 1); return v;
}

__device__ __forceinline__ int ltid() { int t = threadIdx.x; asm volatile("" : "+v"(t)); return t; }

__device__ __forceinline__ int wave_sum_i(int v) {
    v += __builtin_amdgcn_update_dpp(0, v, 0xB1, 0xf, 0xf, true);
    v += __builtin_amdgcn_update_dpp(0, v, 0x4E, 0xf, 0xf, true);
    v += __builtin_amdgcn_update_dpp(0, v, 0x141, 0xf, 0xf, true);
    v += __builtin_amdgcn_update_dpp(0, v, 0x140, 0xf, 0xf, true);
    return __builtin_amdgcn_readlane(v, 0) + __builtin_amdgcn_readlane(v, 16) + __builtin_amdgcn_readlane(v, 32) + __builtin_amdgcn_readlane(v, 48);
}

__device__ __forceinline__ int kperm16(int k) { return (k & ~12) | ((k & 8) >> 1) | ((k & 4) << 1); }
#define XB_TMO      128
#define XB_XCNT(j)  (256  + 64 * (j))
#define XB_XSUB(j)  (1280 + 64 * (j))
#define XB_XGEN(j)  (2304 + 64 * (j))
#define XB_TOP      3328
#define XB_TOPGEN   3392
#define XCD_BAR_WORDS 3456
#define XB_SPIN_CAP (1u << 18)

__device__ __forceinline__ unsigned xb_ld(unsigned* p)              { return __hip_atomic_load(p, __ATOMIC_RELAXED, __HIP_MEMORY_SCOPE_AGENT); }
__device__ __forceinline__ unsigned xb_add(unsigned* p, unsigned v) { return __hip_atomic_fetch_add(p, v, __ATOMIC_RELAXED, __HIP_MEMORY_SCOPE_AGENT); }
__device__ __forceinline__ unsigned xb_xcc_id() { return (unsigned)__builtin_amdgcn_s_getreg((3 << 11) | 20) & 0xFu; }
#define XB_SPIN(cond, bar) do { unsigned _sp = 0; while (cond) { __builtin_amdgcn_s_sleep(1); \
    if ((++_sp & 255u) == 0u) { if (xb_ld(&(bar)[XB_TMO])) break; if (_sp > XB_SPIN_CAP) { atomicAdd(&(bar)[XB_TMO], 1u); break; } } } } while (0)

struct XcdBarrier {
    unsigned* bar; unsigned x;
    volatile LAS unsigned* st;
};

__device__ __forceinline__ XcdBarrier xcd_barrier_post(unsigned* bar, volatile LAS unsigned* st) {
    XcdBarrier b; b.bar = bar; b.x = xb_xcc_id(); b.st = st;
    if (threadIdx.x == 0) (void)xb_add(&bar[XB_XCNT(b.x)], 1u);
    return b;
}
__device__ __forceinline__ void xcd_barrier_complete(unsigned* bar, unsigned x, unsigned& nloc, unsigned& nx) {
    const unsigned G = gridDim.x * gridDim.y * gridDim.z;
    unsigned sum, cnt, mine, sp = 0u;
    for (;;) {
        sum = 0u; cnt = 0u; mine = 0u;
#pragma unroll
        for (unsigned j = 0; j < 16; ++j) { const unsigned c = xb_ld(&bar[XB_XCNT(j)]); sum += c; cnt += (c > 0u) ? 1u : 0u; mine = (j == x) ? c : mine; }
        if (sum == G) break;
        __builtin_amdgcn_s_sleep(1);
        if ((++sp & 255u) == 0u) { if (xb_ld(&bar[XB_TMO])) break; if (sp > XB_SPIN_CAP) { atomicAdd(&bar[XB_TMO], 1u); break; } }
    }
    nloc = mine > 0u ? mine : 1u; nx = cnt > 0u ? cnt : 1u;
}

__device__ __forceinline__ void xcd_barrier(const XcdBarrier& b) {
    asm volatile("s_waitcnt vmcnt(0)" ::: "memory");
    __syncthreads();
    if (threadIdx.x == 0) {
        unsigned* bar = b.bar;
        __builtin_amdgcn_s_waitcnt(0);
        unsigned nloc = b.st[0], nx = b.st[1];
        if (nloc == 0u) { xcd_barrier_complete(bar, b.x, nloc, nx); b.st[0] = nloc; b.st[1] = nx; }
        const unsigned old = xb_add(&bar[XB_XSUB(b.x)], 1u);
        const unsigned gen = old / nloc;
        if (old + 1u == (gen + 1u) * nloc) {
            __builtin_amdgcn_fence(__ATOMIC_RELEASE, "agent");
            asm volatile("s_waitcnt vmcnt(0)" ::: "memory");
            const unsigned og = xb_add(&bar[XB_TOP], 1u);
            const unsigned tg = og / nx;
            if (og + 1u == (tg + 1u) * nx) xb_add(&bar[XB_TOPGEN], 1u);
            else XB_SPIN(xb_ld(&bar[XB_TOPGEN]) == tg, bar);
            __builtin_amdgcn_fence(__ATOMIC_ACQUIRE, "agent");
            xb_add(&bar[XB_XGEN(b.x)], 1u);
            asm volatile("s_waitcnt vmcnt(0)" ::: "memory");
        } else {
            XB_SPIN(xb_ld(&bar[XB_XGEN(b.x)]) == gen, bar);
            __builtin_amdgcn_fence(__ATOMIC_ACQUIRE, "agent");
            asm volatile("s_waitcnt vmcnt(0)" ::: "memory");
        }
    }
    __syncthreads();
}

namespace pg8 {
constexpr int BM = 256, BK = 64, HALF = 128, HTB = HALF * BK * 2  , STAGE_BYTES = 8 * HTB, NXCD = 8, WGM = 4;

__host__ __device__ __forceinline__ int lds_byte(int r, int c) { const int st = (r >> 4) * 2 + (c >> 5), rr = r & 15, cc = c & 31, ob = rr * 64 + cc * 2; return st * 1024 + (ob ^ (((ob >> 9) & 1) << 5)); }
__host__ __device__ __forceinline__ void stage_rc(int b, int& R, int& C) { const int st = b / 1024, sb = b % 1024, swz = sb ^ (((sb >> 9) & 1) << 5); R = (st >> 1) * 16 + swz / 64; C = (st & 1) * 32 + (swz % 64) / 2; }
__host__ __device__ __forceinline__ int perm32(int rho) { const int n = rho >> 4, i = rho & 15; return 8 * (i >> 2) + 4 * n + (i & 3); }

struct Unit { int pm, pn; };
struct Gemm { const f16* A; const f16* Bt; int M, N, K; };

struct StaticOrder {
    int nM, nN, nwg, G, c;
    __host__ __device__ void init(int M, int N, int G_, int c_) { nM = M / BM; nN = N / BM; nwg = nM * nN; G = G_; c = c_; }
    __host__ __device__ bool next(int i, Unit& u) const {
        const long L = (long)i * G + c; if (L >= nwg) return false;
        int wgid = (int)L;
#ifndef NO_XCD_REMAP
        { const int q = nwg / NXCD, r = nwg % NXCD, xcd = wgid % NXCD, off = wgid / NXCD; wgid = (xcd < r ? xcd * (q + 1) : r * (q + 1) + (xcd - r) * q) + off; }
#endif
        const int nig = WGM * nN, gid = wgid / nig, fm = gid * WGM, gsz = (nM - fm) < WGM ? (nM - fm) : WGM;
        u.pm = fm + ((wgid % nig) % gsz); u.pn = (wgid % nig) / gsz; return true;
    }
    __device__ __forceinline__ void a_ready(const Unit&) const {}
    __device__ __forceinline__ void done(const Unit&) const {}
};

struct EpiResid {
    static constexpr bool PERM = true, AFTER_DRAIN = false, PREFETCH = false;
    const float* base; float* out; const float* gate;
    __device__ __forceinline__ void operator()(const f32x4 (&acc)[2][2][4][2], const Unit& u, int wr, int wc, int fr, int fq) const {
        const int row0 = u.pm * BM + wr * 64 + fr; const int col0 = u.pn * BM + wc * 32 + 8 * fq;
        const float* gp = gate + (size_t)((u.pm * BM) >> 11) * 6144 + col0;
        f32x4 gv[2][2];
#pragma unroll
        for (int bj = 0; bj < 2; ++bj)
#pragma unroll
            for (int n = 0; n < 2; ++n) gv[bj][n] = *(const f32x4*)(gp + bj * HALF + 4 * n);
#pragma unroll
        for (int ai = 0; ai < 2; ++ai)
#pragma unroll
            for (int m = 0; m < 4; ++m) { const size_t ro = (size_t)(row0 + ai * HALF + m * 16) * DM + col0;
#pragma unroll
                for (int bj = 0; bj < 2; ++bj)
#pragma unroll
                    for (int n = 0; n < 2; ++n) { const f32x4 x = *(const f32x4*)(base + ro + bj * HALF + 4 * n);
                        *(f32x4*)(out + ro + bj * HALF + 4 * n) = x + gv[bj][n] * acc[ai][bj][m][n]; } }
    }
};
template <int ACT  > struct EpiF16N {
    static constexpr bool PERM = true, AFTER_DRAIN = false, PREFETCH = true;
    f16* O; int ldc; const float* ssq; const float* bw;
    __device__ __forceinline__ void prefetch(LAS unsigned char* aux, const Unit& u, int tid, int wid) const {
        const float* src = (tid < 256) ? ssq + u.pm * BM + tid : bw + (size_t)((u.pm * BM) >> 11) * 4096 + u.pn * BM + (tid - 256);
        __builtin_amdgcn_global_load_lds((const unsigned*)src, (LAS unsigned*)(aux + wid * 256), 4, 0, 0);
    }
    __device__ __forceinline__ void with_lds(const f32x4 (&acc)[2][2][4][2], const Unit& u, int wr, int wc, int fr, int fq, LAS unsigned char* aux) const {
        const int row0 = u.pm * BM + wr * 64 + fr; const int col0 = u.pn * BM + wc * 32 + 8 * fq;
        const LAS float* sq = (const LAS float*)aux; const LAS float* bl = (const LAS float*)(aux + 1024) + wc * 32 + 8 * fq;
        f32x4 bv[2][2];
#pragma unroll
        for (int bj = 0; bj < 2; ++bj)
#pragma unroll
            for (int n = 0; n < 2; ++n) bv[bj][n] = *(const LAS f32x4*)(bl + bj * HALF + 4 * n);
        float rs[2][4];
#pragma unroll
        for (int ai = 0; ai < 2; ++ai)
#pragma unroll
            for (int m = 0; m < 4; ++m) rs[ai][m] = rsqrtf(sq[wr * 64 + fr + ai * HALF + m * 16] * (1.0f / DM) + EPS);
#pragma unroll
        for (int ai = 0; ai < 2; ++ai)
#pragma unroll
            for (int m = 0; m < 4; ++m) { f16* rowp = O + (size_t)(row0 + ai * HALF + m * 16) * ldc + col0;
#pragma unroll
                for (int bj = 0; bj < 2; ++bj) { f32x4 v0 = acc[ai][bj][m][0] * rs[ai][m] + bv[bj][0], v1 = acc[ai][bj][m][1] * rs[ai][m] + bv[bj][1];
                    if (ACT == 1) {
#pragma unroll
                        for (int e = 0; e < 4; ++e) { const float a = fmaxf(v0[e], 0.f), b = fmaxf(v1[e], 0.f); v0[e] = a * a; v1[e] = b * b; } }
                    f16x8 w; w[0] = (f16)v0[0]; w[1] = (f16)v0[1]; w[2] = (f16)v0[2]; w[3] = (f16)v0[3]; w[4] = (f16)v1[0]; w[5] = (f16)v1[1]; w[6] = (f16)v1[2]; w[7] = (f16)v1[3];
                    *(f16x8*)(rowp + bj * HALF) = w; } }
    }
    __device__ __forceinline__ void operator()(const f32x4 (&)[2][2][4][2], const Unit&, int, int, int, int) const {}
};
struct EpiResidN {
    static constexpr bool PERM = true, AFTER_DRAIN = false, PREFETCH = false;
    const float* base; float* out; const float* gate; const float* gain; const float* scale; f16* An; float* ssq;
    __device__ __forceinline__ void operator()(const f32x4 (&acc)[2][2][4][2], const Unit& u, int wr, int wc, int fr, int fq) const {
        const int row0 = u.pm * BM + wr * 64 + fr; const int col0 = u.pn * BM + wc * 32 + 8 * fq;
        const size_t bo = (size_t)((u.pm * BM) >> 11) * 6144 + col0;
        f32x4 gv[2][2], al[2][2];
#pragma unroll
        for (int bj = 0; bj < 2; ++bj)
#pragma unroll
            for (int n = 0; n < 2; ++n) { gv[bj][n] = *(const f32x4*)(gate + bo + bj * HALF + 4 * n);
                const f32x4 g4 = *(const f32x4*)(gain + col0 + bj * HALF + 4 * n), s4 = *(const f32x4*)(scale + bo + bj * HALF + 4 * n); al[bj][n] = g4 * (1.0f + s4); }
#pragma unroll
        for (int ai = 0; ai < 2; ++ai)
#pragma unroll
            for (int m = 0; m < 4; ++m) { const int row = row0 + ai * HALF + m * 16; const size_t ro = (size_t)row * DM + col0; float sq = 0.f;
#pragma unroll
                for (int bj = 0; bj < 2; ++bj) {
                    const f32x4 x0 = *(const f32x4*)(base + ro + bj * HALF), x1 = *(const f32x4*)(base + ro + bj * HALF + 4);
                    const f32x4 y0 = x0 + gv[bj][0] * acc[ai][bj][m][0], y1 = x1 + gv[bj][1] * acc[ai][bj][m][1];
                    *(f32x4*)(out + ro + bj * HALF) = y0; *(f32x4*)(out + ro + bj * HALF + 4) = y1;
                    sq += ((y0[0] * y0[0] + y0[1] * y0[1]) + (y0[2] * y0[2] + y0[3] * y0[3])) + ((y1[0] * y1[0] + y1[1] * y1[1]) + (y1[2] * y1[2] + y1[3] * y1[3]));
                    const f32x4 z0 = y0 * al[bj][0], z1 = y1 * al[bj][1]; f16x8 zz;
                    zz[0] = (f16)z0[0]; zz[1] = (f16)z0[1]; zz[2] = (f16)z0[2]; zz[3] = (f16)z0[3]; zz[4] = (f16)z1[0]; zz[5] = (f16)z1[1]; zz[6] = (f16)z1[2]; zz[7] = (f16)z1[3];
                    *(f16x8*)(An + ro + bj * HALF) = zz; }
                sq += __shfl_xor(sq, 16); sq += __shfl_xor(sq, 32);
                if (fq == 0) __hip_atomic_fetch_add(ssq + row, sq, __ATOMIC_RELAXED, __HIP_MEMORY_SCOPE_AGENT); }
    }
};

template <class Epi, class Sched>
__device__ __forceinline__ void gemm_phase(LAS unsigned char* lds, const Gemm g, const Sched& S, const Epi& E) {
    const int tid = ltid(), wid = __builtin_amdgcn_readfirstlane(tid >> 6), lane = tid & 63, wr = wid >> 2, wc = wid & 3, fr = lane & 15, fq = lane >> 4;
    const int K = g.K, nt = K / BK;
    unsigned voffA[2], voffB[2];
#pragma unroll
    for (int i = 0; i < 2; ++i) { int R, C; stage_rc(tid * 16 + i * 8192, R, C); const int Rb = Epi::PERM ? ((R & ~31) + perm32(R & 31)) : R;
        voffA[i] = (unsigned)(R * K + C) * 2u; voffB[i] = (unsigned)(Rb * K + C) * 2u; }
    const size_t kstep = (size_t)(BK * 2);
    const size_t hstep = (size_t)HALF * K * 2;
    const size_t tstep = 2 * hstep;
    const unsigned ldsw = (unsigned)wid * 1024u;
    const int aoff = lds_byte(wr * 64 + fr, fq * 8), boff = lds_byte(wc * 32 + fr, fq * 8);
#define PG8_SA(b, h) (((b) * 2 + (h)) * HTB)
#define PG8_SB(b, h) ((4 + (b) * 2 + (h)) * HTB)
#define PG8_STAGE(bufoff, gbase, voff) do { _Pragma("unroll") for (int _i = 0; _i < 2; ++_i) \
        __builtin_amdgcn_global_load_lds((const unsigned*)((const char*)(gbase) + (voff)[_i]), (LAS unsigned*)(lds + (bufoff) + ldsw + _i * 8192), 16, 0, 0); } while (0)
#define PG8_LDA(dst, b, h) do { _Pragma("unroll") for (int m = 0; m < 4; ++m) _Pragma("unroll") for (int k = 0; k < 2; ++k) dst[m][k] = *(const LAS f16x8*)(lds + PG8_SA(b, h) + aoff + m * 2048 + k * 1024); } while (0)
#define PG8_LDB(dst, b, h) do { _Pragma("unroll") for (int n = 0; n < 2; ++n) _Pragma("unroll") for (int k = 0; k < 2; ++k) dst[n][k] = *(const LAS f16x8*)(lds + PG8_SB(b, h) + boff + n * 2048 + k * 1024); } while (0)
#define PG8_MMA(ai, bj, At, Bt) do { __builtin_amdgcn_s_setprio(1); _Pragma("unroll") for (int m = 0; m < 4; ++m) _Pragma("unroll") for (int n = 0; n < 2; ++n) _Pragma("unroll") for (int k = 0; k < 2; ++k) \
        acc[ai][bj][m][n] = __builtin_amdgcn_mfma_f32_16x16x32_f16(Bt[n][k], At[m][k], acc[ai][bj][m][n], 0, 0, 0); __builtin_amdgcn_s_setprio(0); } while (0)
#define PG8_WAIT_V(n) asm volatile("s_waitcnt vmcnt(" #n ")" ::: "memory")
#define PG8_WAIT_L(n) asm volatile("s_waitcnt lgkmcnt(" #n ")" ::: "memory")
#define PG8_BAR __builtin_amdgcn_s_barrier()
#define PG8_SCHED __builtin_amdgcn_sched_barrier(0)
    Unit cur, nxt; int ui = 0;
    if (!S.next(0, cur)) return;
    f32x4 acc[2][2][4][2];
#pragma unroll
    for (int a = 0; a < 2; ++a)
#pragma unroll
        for (int b = 0; b < 2; ++b)
#pragma unroll
            for (int m = 0; m < 4; ++m)
#pragma unroll
                for (int n = 0; n < 2; ++n) acc[a][b][m][n] = (f32x4){0.f, 0.f, 0.f, 0.f};
    f16x8 At[4][2], B0[2][2], B1[2][2];
    const char* cA = (const char*)g.A + (size_t)cur.pm * tstep; const char* cB = (const char*)g.Bt + (size_t)cur.pn * tstep;
    S.a_ready(cur);
    if constexpr (Epi::PREFETCH) E.prefetch(lds + STAGE_BYTES, cur, tid, wid);
    PG8_STAGE(PG8_SB(0, 0), cB, voffB); PG8_STAGE(PG8_SB(0, 1), cB + hstep, voffB); PG8_STAGE(PG8_SA(0, 0), cA, voffA); PG8_STAGE(PG8_SA(0, 1), cA + hstep, voffA);
    if (wr == 1) PG8_BAR;
    PG8_WAIT_V(2); PG8_BAR;
    PG8_STAGE(PG8_SB(1, 0), cB + kstep, voffB); PG8_STAGE(PG8_SA(1, 0), cA + kstep, voffA); PG8_STAGE(PG8_SB(1, 1), cB + hstep + kstep, voffB);
    PG8_WAIT_V(6); PG8_BAR;
    for (;;) {
        const bool has_next = S.next(ui + 1, nxt);
        const char* nA = has_next ? (const char*)g.A + (size_t)nxt.pm * tstep : cA; const char* nB = has_next ? (const char*)g.Bt + (size_t)nxt.pn * tstep : cB;
        for (int t = 0; t < nt; t += 2) {
            const bool last = (t == nt - 2);
            const char* a1 = cA + (size_t)(t + 1) * kstep;
            const char* a2 = last ? nA : cA + (size_t)(t + 2) * kstep; const char* b2 = last ? nB : cB + (size_t)(t + 2) * kstep;
            const char* a3 = a2 + kstep; const char* b3 = b2 + kstep;
            if (last && has_next) S.a_ready(nxt);
            PG8_LDB(B0, 0, 0); PG8_LDB(B1, 0, 1); PG8_SCHED; PG8_LDA(At, 0, 0); PG8_STAGE(PG8_SA(1, 1), a1 + hstep, voffA);
            PG8_WAIT_V(8); PG8_WAIT_L(0); PG8_BAR; PG8_MMA(0, 0, At, B0); PG8_MMA(0, 1, At, B1); PG8_BAR; PG8_SCHED;
            PG8_LDA(At, 0, 1); PG8_STAGE(PG8_SB(0, 0), b2, voffB); PG8_STAGE(PG8_SB(0, 1), b2 + hstep, voffB); PG8_STAGE(PG8_SA(0, 0), a2, voffA);
            PG8_WAIT_V(8); PG8_WAIT_L(0); PG8_BAR; PG8_MMA(1, 0, At, B0); PG8_MMA(1, 1, At, B1); PG8_BAR; PG8_SCHED;
            PG8_LDB(B0, 1, 0); PG8_LDB(B1, 1, 1); PG8_SCHED; PG8_LDA(At, 1, 0); PG8_STAGE(PG8_SA(0, 1), a2 + hstep, voffA);
            PG8_WAIT_V(8); PG8_WAIT_L(0); PG8_BAR; PG8_MMA(0, 0, At, B0); PG8_MMA(0, 1, At, B1); PG8_BAR; PG8_SCHED;
            PG8_LDA(At, 1, 1); PG8_STAGE(PG8_SB(1, 0), b3, voffB); PG8_STAGE(PG8_SB(1, 1), b3 + hstep, voffB); PG8_STAGE(PG8_SA(1, 0), a3, voffA);
            PG8_WAIT_V(8); PG8_WAIT_L(0); PG8_BAR; PG8_MMA(1, 0, At, B0); PG8_MMA(1, 1, At, B1); PG8_BAR; PG8_SCHED;
        }
#ifndef PG8_NOALIGN
        if (wr == 0) PG8_BAR;
#endif
        if constexpr (Epi::PREFETCH) E.with_lds(acc, cur, wr, wc, fr, fq, lds + STAGE_BYTES + (ui & 1) * 2048); else E(acc, cur, wr, wc, fr, fq);
        S.done(cur);
        if (!has_next) break;
#pragma unroll
        for (int a = 0; a < 2; ++a)
#pragma unroll
            for (int b = 0; b < 2; ++b)
#pragma unroll
                for (int m = 0; m < 4; ++m)
#pragma unroll
                    for (int n = 0; n < 2; ++n) acc[a][b][m][n] = (f32x4){0.f, 0.f, 0.f, 0.f};
        cur = nxt; cA = nA; cB = nB; ++ui;
        if constexpr (Epi::PREFETCH) E.prefetch(lds + STAGE_BYTES + (ui & 1) * 2048, cur, tid, wid);
#ifndef PG8_NOALIGN
        if (wr == 1) PG8_BAR;
#endif
    }
    PG8_WAIT_V(0);
#ifdef PG8_NOALIGN
    if (wr == 0) PG8_BAR;
#endif
    PG8_BAR;
#undef PG8_SA
#undef PG8_SB
#undef PG8_STAGE
#undef PG8_LDA
#undef PG8_LDB
#undef PG8_MMA
#undef PG8_WAIT_V
#undef PG8_WAIT_L
#undef PG8_BAR
#undef PG8_SCHED
}
}
struct Ptrs {
    const float *x, *c, *w_mod, *b_mod, *g_attn, *w_in, *kv_norm_g, *w_uv, *g_out_a, *g_out_b, *w_out, *g_mlp, *w_up, *w_down, *rel_bias, *g_final;
    float* out; unsigned char* ws;
};

__device__ __forceinline__ void conv_tile(float* T  , const float* src, int N, int K, int Nvalid, const float* ks0, const float* ks1, f16* dst, int tn, int tk) {
    const int tid = ltid();
#pragma unroll
    for (int i = 0; i < 8; ++i) {
        const int kk = (tid >> 6) + 8 * i, k = tk * 64 + kk, n = tn * 64 + (tid & 63);
        float v = (n < Nvalid) ? src[(size_t)k * N + n] : 0.f;
        if (ks0) v *= (k < 512 ? ks0[k] : ks1[k - 512]);
        T[kk * 65 + (tid & 63)] = v;
    }
    __syncthreads();
    { const int nn = tid >> 3, kc = (tid & 7) * 8; f16x8 o;
#pragma unroll
      for (int e = 0; e < 8; ++e) o[e] = (f16)T[(kc + e) * 65 + nn];
      *(f16x8*)(dst + (size_t)(tn * 64 + nn) * K + tk * 64 + kc) = o; }
    __syncthreads();
}

__device__ __forceinline__ int t5_bucket_dev(int rel) {
    const int n = rel < 0 ? -rel : rel; int bk;
    if (n < 8) bk = n; else if (n < 12) bk = 8; else if (n < 16) bk = 9; else if (n < 23) bk = 10; else if (n < 32) bk = 11; else if (n < 46) bk = 12; else if (n < 64) bk = 13; else if (n < 91) bk = 14; else bk = 15;
    return (rel > 0 ? 16 : 0) + bk;
}

__device__ __forceinline__ void prologue_phase(unsigned char* lds, const Ptrs& P, int G, int wg) {
    const int tid = ltid(), lane = tid & 63, wv = tid >> 6;
    unsigned char* ws = P.ws;
    float* T = (float*)lds;
    constexpr int T_IN = 52 * 16, T_OUT = 16 * 16, T_UP = 64 * 16, T_DN = 16 * 64, T_UV = 16, T_L = T_IN + T_OUT + T_UP + T_DN + T_UV;
    for (int u = wg; u < 2 * T_L; u += G) {
        const int l = u / T_L; int r = u % T_L;
        if (r < T_IN) { conv_tile(T, P.w_in + (size_t)l * DM * NPJ_VALID, NPJ_VALID, DM, NPJ_VALID, nullptr, nullptr, (f16*)(ws + WS_WIN) + (size_t)l * NPJ * DM, r / 16, r % 16); continue; }
        r -= T_IN;
        if (r < T_OUT) { conv_tile(T, P.w_out + (size_t)l * DM * DM, DM, DM, DM, P.g_out_a + l * 512, P.g_out_b + l * 512, (f16*)(ws + WS_WOUT) + (size_t)l * DM * DM, r / 16, r % 16); continue; }
        r -= T_OUT;
        if (r < T_UP) { conv_tile(T, P.w_up + (size_t)l * DM * FF, FF, DM, FF, nullptr, nullptr, (f16*)(ws + WS_WUP) + (size_t)l * FF * DM, r / 16, r % 16); continue; }
        r -= T_UP;
        if (r < T_DN) { conv_tile(T, P.w_down + (size_t)l * FF * DM, DM, FF, DM, nullptr, nullptr, (f16*)(ws + WS_WDN) + (size_t)l * DM * FF, r / 64, r % 64); continue; }
        r -= T_DN;
        { const int h = r >> 1; conv_tile(T, P.w_uv + ((size_t)l * 8 + h) * 128 * 64, 64, 128, 64, nullptr, nullptr, (f16*)(ws + WS_WUV) + ((size_t)l * 8 + h) * 64 * 128, 0, r & 1); }
    }
    { float* sq = (float*)(ws + WS_SSQ) + MT; for (size_t i = (size_t)wg * NTHR + tid; i < (size_t)3 * MT / 4; i += (size_t)G * NTHR) ((f32x4*)sq)[i] = (f32x4){0.f, 0.f, 0.f, 0.f}; }
    if (wg == G - 1) {
        float* BT = (float*)(ws + WS_BIAS);
        for (int i = tid; i < 8 * 2112; i += NTHR) { const int h = i / 2112, idx = i % 2112; const int bk = t5_bucket_dev(idx - 2047);
            BT[i] = (P.rel_bias[bk * 8 + h] - P.rel_bias[15 * 8 + h]) * LOG2E; }
    }
    __syncthreads();
    if (wg < 192) {
        float* SC = (float*)lds;
        float* RED = (float*)(lds + 65536);
        for (int i = tid; i < 16 * 1024; i += NTHR) { const int b = i >> 10, k = i & 1023; const float cv = P.c[i]; SC[k * 16 + b] = cv / (1.f + __expf(-cv)); }
        __syncthreads();
        for (int u = wg; u < 192; u += G) {
            const int l = u / 96, cb = u % 96, col = cb * 64 + lane;
            const float* wp = P.w_mod + (size_t)l * DM * 6144 + col;
            float acc[16];
#pragma unroll
            for (int b = 0; b < 16; ++b) acc[b] = 0.f;
            for (int k = wv * 128; k < wv * 128 + 128; ++k) {
                const float w = wp[(size_t)k * 6144];
                const f32x4 s0 = *(const f32x4*)(SC + k * 16), s1 = *(const f32x4*)(SC + k * 16 + 4), s2 = *(const f32x4*)(SC + k * 16 + 8), s3 = *(const f32x4*)(SC + k * 16 + 12);
#pragma unroll
                for (int e = 0; e < 4; ++e) { acc[e] += s0[e] * w; acc[4 + e] += s1[e] * w; acc[8 + e] += s2[e] * w; acc[12 + e] += s3[e] * w; }
            }
#pragma unroll
            for (int b = 0; b < 16; ++b) RED[(wv * 16 + b) * 64 + lane] = acc[b];
            __syncthreads();
            for (int i = tid; i < 1024; i += NTHR) { const int b = i >> 6, cc = i & 63; float s = P.b_mod[l * 6144 + cb * 64 + cc];
#pragma unroll
                for (int w8 = 0; w8 < 8; ++w8) s += RED[(w8 * 16 + b) * 64 + cc];
                ((float*)(ws + WS_MOD))[((size_t)l * 16 + b) * 6144 + cb * 64 + cc] = s; }
            __syncthreads();
        }
    }
}

__device__ __forceinline__ void final_norm_phase(const float* x, const float* gain, float* out, int G, int wg) {
    const int tid_ = ltid(); const int lane = tid_ & 63, wv = tid_ >> 6;
    for (int row = wg * NWAVES + wv; row < MT; row += G * NWAVES) {
        const float* xp = x + (size_t)row * DM + lane * 4;
        f32x4 v[4]; float ss = 0.f;
#pragma unroll
        for (int i = 0; i < 4; ++i) { v[i] = *(const f32x4*)(xp + i * 256); ss += v[i][0] * v[i][0] + v[i][1] * v[i][1] + v[i][2] * v[i][2] + v[i][3] * v[i][3]; }
        ss = wave_sum(ss);
        const float rstd = rsqrtf(ss * (1.0f / DM) + EPS);
#pragma unroll
        for (int i = 0; i < 4; ++i) { const int col = i * 256 + lane * 4; const f32x4 g4 = *(const f32x4*)(gain + col);
            *(f32x4*)(out + (size_t)row * DM + col) = v[i] * rstd * g4; }
    }
}

__device__ __forceinline__ void kvnorm_phase(unsigned char* lds, const f16* PROJ, const float* g, f16* KV, f16* KVT, int G, int wg) {
    const int tid = ltid();
    f16* T = (f16*)lds;
    for (int blk = wg; blk < MT / 64; blk += G) {
        const int tok = tid >> 3, ch = tid & 7; const size_t row = (size_t)blk * 64 + tok;
        const f16* p = PROJ + row * NPJ + C_DKV + ch * 16;
        const f16x8 a = *(const f16x8*)p, b = *(const f16x8*)(p + 8);
        float va[8], vb[8]; float ss = 0.f;
#pragma unroll
        for (int e = 0; e < 8; ++e) { va[e] = (float)a[e]; vb[e] = (float)b[e]; ss += va[e] * va[e] + vb[e] * vb[e]; }
        ss += __shfl_xor(ss, 4); ss += __shfl_xor(ss, 2); ss += __shfl_xor(ss, 1);
        const float rstd = rsqrtf(ss * (1.0f / 128.f) + EPS);
        f16x8 oa, ob;
#pragma unroll
        for (int e = 0; e < 8; ++e) { oa[e] = (f16)(va[e] * rstd * g[ch * 16 + e]); ob[e] = (f16)(vb[e] * rstd * g[ch * 16 + 8 + e]); }
        *(f16x8*)(KV + row * 128 + ch * 16) = oa; *(f16x8*)(KV + row * 128 + ch * 16 + 8) = ob;
        { const int tp = (tok & ~15) | kperm16(tok & 15);
#pragma unroll
        for (int e = 0; e < 8; ++e) { T[(ch * 16 + e) * 72 + tp] = oa[e]; T[(ch * 16 + 8 + e) * 72 + tp] = ob[e]; } }
        __syncthreads();
        { const int dim = tid >> 2, tc = (tid & 3) * 16; const int bb = (blk * 64) >> 11, t0 = (blk * 64) & 2047;
          const f16x8 x0 = *(const f16x8*)(T + dim * 72 + tc), x1 = *(const f16x8*)(T + dim * 72 + tc + 8);
          f16* q = KVT + ((size_t)bb * 128 + dim) * SEQ + t0 + tc;
          *(f16x8*)q = x0; *(f16x8*)(q + 8) = x1; }
        __syncthreads();
    }
}

__device__ __forceinline__ void prenorm0_phase(const float* x, const float* gain, const float* sc, f16* An, float* ssq, int G, int wg) {
    const int tid_ = ltid(); const int lane = tid_ & 63, wv = tid_ >> 6;
    for (int row = wg * NWAVES + wv; row < MT; row += G * NWAVES) {
        const int b = row >> 11; const float* xp = x + (size_t)row * DM + lane * 4;
        f32x4 v[4]; float ss = 0.f;
#pragma unroll
        for (int i = 0; i < 4; ++i) { v[i] = *(const f32x4*)(xp + i * 256); ss += v[i][0] * v[i][0] + v[i][1] * v[i][1] + v[i][2] * v[i][2] + v[i][3] * v[i][3]; }
        ss = wave_sum(ss);
        if (lane == 0) ssq[row] = ss;
#pragma unroll
        for (int i = 0; i < 4; ++i) { const int col = i * 256 + lane * 4;
            const f32x4 g4 = *(const f32x4*)(gain + col), s4 = *(const f32x4*)(sc + (size_t)b * 6144 + col);
            f16x4 o;
#pragma unroll
            for (int e = 0; e < 4; ++e) o[e] = (f16)(v[i][e] * (g4[e] * (1.f + s4[e])));
            *(f16x4*)(An + (size_t)row * DM + col) = o; }
    }
}

__device__ __forceinline__ void bw_phase(unsigned char* lds, const Ptrs& P, const float* MOD, float* BW, int G, int wg) {
    const int tid = ltid(), lane = tid & 63, wv = tid >> 6;
    float* SH = (float*)lds;
    float* RED = (float*)(lds + 65536);
    for (int u = wg; u < 2 * 116; u += G) {
        const int l = u / 116, r = u % 116, site = (r < 52) ? 0 : 1, cb = (site == 0) ? r : r - 52;
        const int N = (site == 0) ? NPJ_VALID : FF;
        const float* W = (site == 0) ? P.w_in + (size_t)l * DM * NPJ_VALID : P.w_up + (size_t)l * DM * FF;
        const float* shp = MOD + (size_t)l * 16 * 6144 + (site == 0 ? 0 : 3) * DM;
        __syncthreads();
        for (int i = tid; i < 16 * 1024; i += NTHR) { const int b = i >> 10, k = i & 1023; SH[k * 16 + b] = shp[(size_t)b * 6144 + k]; }
        __syncthreads();
        const int col = cb * 64 + lane; const bool ok = col < N;
        const float* wp = W + (ok ? col : 0);
        float acc[16];
#pragma unroll
        for (int b = 0; b < 16; ++b) acc[b] = 0.f;
        for (int k = wv * 128; k < wv * 128 + 128; ++k) {
            const float w = ok ? wp[(size_t)k * N] : 0.f;
            const f32x4 s0 = *(const f32x4*)(SH + k * 16), s1 = *(const f32x4*)(SH + k * 16 + 4), s2 = *(const f32x4*)(SH + k * 16 + 8), s3 = *(const f32x4*)(SH + k * 16 + 12);
#pragma unroll
            for (int e = 0; e < 4; ++e) { acc[e] += s0[e] * w; acc[4 + e] += s1[e] * w; acc[8 + e] += s2[e] * w; acc[12 + e] += s3[e] * w; }
        }
#pragma unroll
        for (int b = 0; b < 16; ++b) RED[(wv * 16 + b) * 64 + lane] = acc[b];
        __syncthreads();
        for (int i = tid; i < 1024; i += NTHR) { const int b = i >> 6, cc = i & 63; float s = 0.f;
#pragma unroll
            for (int w8 = 0; w8 < 8; ++w8) s += RED[(w8 * 16 + b) * 64 + cc];
            BW[(((size_t)l * 2 + site) * 16 + b) * 4096 + cb * 64 + cc] = s; }
    }
    __syncthreads();
}

__device__ __forceinline__ void vtrans_phase(unsigned char* lds, const f16* PROJ, f16* VTA, int G, int wg) {
    const int tid = ltid();
    f16* T = (f16*)lds;
    for (int blk = wg; blk < 16 * 8 * 32; blk += G) {
        const int bh = blk >> 5, tb = blk & 31, b = bh >> 3, h = bh & 7;
        const int tok = tid >> 3, ch = tid & 7;
        const f16x8 v = *(const f16x8*)(PROJ + ((size_t)b * SEQ + tb * 64 + tok) * NPJ + C_SBV + h * 64 + ch * 8);
        const int tp = (tok & ~15) | kperm16(tok & 15);
#pragma unroll
        for (int e = 0; e < 8; ++e) T[(ch * 8 + e) * 72 + tp] = v[e];
        __syncthreads();
        { const int dim = tid >> 3, kc = (tid & 7) * 8;
          *(f16x8*)(VTA + ((size_t)bh * 64 + dim) * SEQ + tb * 64 + kc) = *(const f16x8*)(T + dim * 72 + kc); }
        __syncthreads();
    }
}

#define SB_LOAD(KF, VF, HT) do { const int _ht = (HT) < 0 ? 0 : (HT); \
    _Pragma("unroll") for (int s = 0; s < 4; ++s) KF[s] = *(const f16x8*)(kp + (size_t)_ht * 32 * NPJ + 16 * s); \
    _Pragma("unroll") for (int d = 0; d < 2; ++d) _Pragma("unroll") for (int s = 0; s < 2; ++s) VF[d][s] = *(const f16x8*)(vp + (size_t)d * 32 * SEQ + _ht * 32 + 16 * s); } while (0)

#define SB_COMPUTE(KF, VF, HT) do { \
    f32x16 S; _Pragma("unroll") for (int r = 0; r < 16; ++r) S[r] = 0.f; \
    _Pragma("unroll") for (int s = 0; s < 4; ++s) S = __builtin_amdgcn_mfma_f32_32x32x16_f16(KF[s], qf[s], S, 0, 0, 0); \
    f32x16 om; \
    _Pragma("unroll") for (int r = 0; r < 16; ++r) { \
        const float zc = __builtin_amdgcn_fmed3f(S[r], -640.f, 640.f);                    \
        const float e1 = __builtin_amdgcn_exp2f(zc * (-0.125f * LOG2E));                  \
        const float be = __builtin_amdgcn_rcpf(1.0f + e1);                                \
        S[r] = be; om[r] = e1 * be; }                                                      \
    if ((HT) == rb) {                                                                      \
        const int kb = (HT) * 32 + 4 * hh; \
        _Pragma("unroll") for (int r = 0; r < 16; ++r) { const int key = kb + 8 * (r >> 2) + (r & 3); if (key >= q) { S[r] = 0.f; om[r] = 1.0f; } } } \
    float R = C; \
    _Pragma("unroll") for (int g = 3; g >= 0; --g) { \
        const float o0 = om[4 * g], o1 = om[4 * g + 1], o2 = om[4 * g + 2], o3 = om[4 * g + 3]; \
        const float gown = (o0 * o1) * (o2 * o3); \
        const float gp = __shfl_xor(gown, 32); \
        const float pre = hh ? R : R * gp; \
        const float p3 = pre, p2 = p3 * o3, p1 = p2 * o2, p0 = p1 * o1; \
        S[4 * g + 3] *= p3; S[4 * g + 2] *= p2; S[4 * g + 1] *= p1; S[4 * g] *= p0; \
        R = R * gown * gp; } \
    C = R; \
    f16x8 pf[2]; \
    _Pragma("unroll") for (int s = 0; s < 2; ++s) _Pragma("unroll") for (int e = 0; e < 8; ++e) pf[s][e] = (f16)S[8 * s + e]; \
    _Pragma("unroll") for (int d = 0; d < 2; ++d) _Pragma("unroll") for (int s = 0; s < 2; ++s) accO[d] = __builtin_amdgcn_mfma_f32_32x32x16_f16(VF[d][s], pf[s], accO[d], 0, 0, 0); \
    } while (0)

__device__ __forceinline__ void sb_attn_phase(unsigned char* lds, const f16* PROJ, const f16* VTA, f16* OBUF, int G, int wg) {
    const int tid = ltid(), lane = tid & 63, wv = tid >> 6, l32 = lane & 31, hh = lane >> 5;
    float* RED = (float*)(lds + 73728);
    int par = 0;
    f16x8 qn[4], kA[4], vA[2][2], kB[4], vB[2][2];
#define SB_UNIT_LOAD(U) do { const int _b = 2 * ((U) & 7) + (((U) >> 3) & 1), _rb = 63 - ((U) >> 4), _bh = _b * 8 + wv; const size_t _rw = (size_t)_b * SEQ; \
        const f16* _qp = PROJ + (_rw + _rb * 32 + l32) * NPJ + C_SBQ + wv * 64 + hh * 8; \
        _Pragma("unroll") for (int s = 0; s < 4; ++s) qn[s] = *(const f16x8*)(_qp + 16 * s); \
        const f16* kp = PROJ + (_rw + l32) * NPJ + C_SBK + wv * 64 + hh * 8; const f16* vp = VTA + ((size_t)_bh * 64 + l32) * SEQ + 8 * hh; \
        SB_LOAD(kA, vA, _rb); } while (0)
    if (wg < 1024) SB_UNIT_LOAD(wg);
    for (int u = wg; u < 1024; u += G, par ^= 1) {
        const int b = 2 * (u & 7) + ((u >> 3) & 1), rb = 63 - (u >> 4), h = wv, bh = b * 8 + h;
        const size_t rowbase = (size_t)b * SEQ;
        const int r0 = rb * 32, q = r0 + l32;
        f16x8 qf[4];
#pragma unroll
        for (int s = 0; s < 4; ++s) qf[s] = qn[s];
        const f16* kp = PROJ + (rowbase + l32) * NPJ + C_SBK + h * 64 + hh * 8;
        const f16* vp = VTA + ((size_t)bh * 64 + l32) * SEQ + 8 * hh;
        f32x16 accO[2];
#pragma unroll
        for (int d = 0; d < 2; ++d)
#pragma unroll
            for (int r = 0; r < 16; ++r) accO[d][r] = 0.f;
        float C = 1.0f;
        int ht = rb;
        for (;;) {
            SB_LOAD(kB, vB, ht - 1);
            SB_COMPUTE(kA, vA, ht);
            if (ht == 0 || __ballot(C >= 2.9e-8f) == 0ull) break;
            --ht;
            SB_LOAD(kA, vA, ht - 1);
            SB_COMPUTE(kB, vB, ht);
            if (ht == 0 || __ballot(C >= 2.9e-8f) == 0ull) break;
            --ht;
        }
        if (u + G < 1024) SB_UNIT_LOAD(u + G);
        float ssq = 0.f;
#pragma unroll
        for (int d = 0; d < 2; ++d)
#pragma unroll
            for (int r = 0; r < 16; ++r) ssq += accO[d][r] * accO[d][r];
        ssq += __shfl_xor(ssq, 32);
        if (hh == 0) RED[(par * 8 + wv) * 32 + l32] = ssq;
        __syncthreads();
        float tot = 0.f;
#pragma unroll
        for (int w8 = 0; w8 < 8; ++w8) tot += RED[(par * 8 + w8) * 32 + l32];
        const float rstd = rsqrtf(tot * (1.0f / 512.f) + EPS);
        { f16* op = OBUF + (rowbase + q) * DM + h * 64 + 4 * hh;
#pragma unroll
          for (int d = 0; d < 2; ++d)
#pragma unroll
            for (int g = 0; g < 4; ++g) { f16x4 o; o[0] = (f16)(accO[d][4 * g] * rstd); o[1] = (f16)(accO[d][4 * g + 1] * rstd); o[2] = (f16)(accO[d][4 * g + 2] * rstd); o[3] = (f16)(accO[d][4 * g + 3] * rstd);
                *(f16x4*)(op + 32 * d + 8 * g) = o; } }
    }
}
constexpr int IDX_PITCH = 2052;
__device__ __forceinline__ unsigned radix_scan(const unsigned* hist, int lane, unsigned& digit, unsigned& rank) {
    const u32x4 b = *(const u32x4*)(hist + 4 * lane);
    const unsigned s = b[0] + b[1] + b[2] + b[3];
    unsigned p = s;
    p += (unsigned)__builtin_amdgcn_update_dpp(0, (int)p, 0x101, 0xf, 0xf, true);
    p += (unsigned)__builtin_amdgcn_update_dpp(0, (int)p, 0x102, 0xf, 0xf, true);
    p += (unsigned)__builtin_amdgcn_update_dpp(0, (int)p, 0x104, 0xf, 0xf, true);
    p += (unsigned)__builtin_amdgcn_update_dpp(0, (int)p, 0x108, 0xf, 0xf, true);
    { const unsigned t1 = __builtin_amdgcn_readlane(p, 16), t2 = __builtin_amdgcn_readlane(p, 32), t3 = __builtin_amdgcn_readlane(p, 48);
      p += (lane < 16) ? (t1 + t2 + t3) : (lane < 32) ? (t2 + t3) : (lane < 48) ? t3 : 0u; }
    const unsigned long long ge = __ballot(p >= rank);
    const int L = __popcll(ge) - 1;
    const unsigned pL = __builtin_amdgcn_readlane(p, L), sL = __builtin_amdgcn_readlane(s, L);
    unsigned r = rank - (pL - sL);
    const unsigned b3 = __builtin_amdgcn_readlane(b[3], L), b2 = __builtin_amdgcn_readlane(b[2], L), b1 = __builtin_amdgcn_readlane(b[1], L);
    unsigned k = 3, bc = b3;
    if (r > b3) { r -= b3; k = 2; bc = b2; if (r > b2) { r -= b2; k = 1; bc = b1; if (r > b1) { r -= b1; k = 0; bc = __builtin_amdgcn_readlane(b[0], L); } } }
    digit = 4u * (unsigned)L + k; rank = r; return bc;
}
template <int NJ> __device__ __forceinline__ unsigned topk_words(const float* row, int nadm, int lane, unsigned* hist, unsigned* hist_dummy) {
    unsigned uk[NJ];
#pragma unroll
    for (int j = 0; j < NJ; ++j) {
        const int key = 64 * j + lane;
        unsigned bits = 0u;
        if (key < nadm) { bits = __float_as_uint(row[key]); bits ^= (unsigned)(((int)bits >> 31) | 0x80000000); }
        uk[j] = bits;
    }
    unsigned rank = 256u, T = 0u, dg;
    unsigned* dummy = hist_dummy + lane;
    *(u32x4*)(hist + 4 * lane) = (u32x4){0u, 0u, 0u, 0u};
#pragma unroll
    for (int j = 0; j < NJ; ++j) __hip_atomic_fetch_add(hist + (uk[j] >> 24), 1u, __ATOMIC_RELAXED, __HIP_MEMORY_SCOPE_WORKGROUP);
    unsigned binc = radix_scan(hist, lane, dg, rank); T = dg << 24;
#pragma unroll
    for (int lv = 1; lv < 4; ++lv) {
        const int sh = 24 - 8 * lv;
        if (binc == rank) break;
        *(u32x4*)(hist + 4 * lane) = (u32x4){0u, 0u, 0u, 0u};
        const unsigned pre = T >> (sh + 8);
#pragma unroll
        for (int j = 0; j < NJ; ++j) { unsigned* dst = ((uk[j] >> (sh + 8)) == pre) ? hist + ((uk[j] >> sh) & 255u) : dummy;
            __hip_atomic_fetch_add(dst, 1u, __ATOMIC_RELAXED, __HIP_MEMORY_SCOPE_WORKGROUP); }
        binc = radix_scan(hist, lane, dg, rank); T |= dg << sh;
    }
    unsigned word = 0u;
    if (binc == rank) {
#pragma unroll
        for (int j = 0; j < NJ; ++j) {
            const unsigned long long sel = __ballot(uk[j] >= T);
            asm volatile("s_nop 3\n\tv_writelane_b32 %0, %1, %3\n\tv_writelane_b32 %0, %2, %4" : "+v"(word) : "s"((unsigned)sel), "s"((unsigned)(sel >> 32)), "n"(2 * j), "n"(2 * j + 1));
        }
    } else {
        int need = (int)rank;
#pragma unroll
        for (int j = 0; j < NJ; ++j) {
            unsigned long long sel = __ballot(uk[j] > T);
            unsigned long long em = __ballot(uk[j] == T);
            if (need > 0 && em != 0ull) {
                const int pc = __popcll(em);
                if (pc <= need) { sel |= em; need -= pc; }
                else { unsigned long long keep = 0ull; for (int i = 0; i < need; ++i) { const unsigned long long lowb = em & (0ull - em); keep |= lowb; em ^= lowb; } sel |= keep; need = 0; }
            }
            asm volatile("s_nop 3\n\tv_writelane_b32 %0, %1, %3\n\tv_writelane_b32 %0, %2, %4" : "+v"(word) : "s"((unsigned)sel), "s"((unsigned)(sel >> 32)), "n"(2 * j), "n"(2 * j + 1));
        }
    }
    return word;
}
__device__ __forceinline__ void indexer_phase(unsigned char* lds, const f16* PROJ, unsigned* MASK, int G, int wg, bool do_topk) {
    const int tid = ltid(), lane = tid & 63, wv = tid >> 6, l16 = lane & 15, lq = lane >> 4;
    float* SCR = (float*)lds;
    unsigned* hist = (unsigned*)(lds + 136192) + wv * 256;
    unsigned* hdum = (unsigned*)(lds + 136192 + 8192) + wv * 64;
    f16x8 qa[8][2]; f16x8 w8r[4]; f16x8 ka[4][2];
#define IDX_LOAD_UNIT(U) do { const int _b = 2 * ((U) & 7) + (((U) >> 3) & 1), _q0 = (127 - ((U) >> 4)) * 16; const size_t _rb = (size_t)_b * SEQ; \
        const f16* _qp = PROJ + (_rb + _q0 + l16) * NPJ + C_IQ + lq * 8; \
        _Pragma("unroll") for (int hd = 0; hd < 8; ++hd) _Pragma("unroll") for (int s_ = 0; s_ < 2; ++s_) qa[hd][s_] = *(const f16x8*)(_qp + hd * 64 + 32 * s_); \
        _Pragma("unroll") for (int r = 0; r < 4; ++r) w8r[r] = *(const f16x8*)(PROJ + (_rb + _q0 + 4 * lq + r) * NPJ + C_IW); \
        const int _c0 = (((64 * ((_q0 >> 6) + 1)) >> 4) + 7) >> 3; const f16* _kb = PROJ + (_rb + wv * 16 + l16) * NPJ + C_IK + lq * 8; \
        _Pragma("unroll") for (int j = 0; j < 4; ++j) { const int _it = (j < _c0 - 1) ? j : _c0 - 1; const f16* _kp = _kb + (size_t)_it * (128 * NPJ); ka[j][0] = *(const f16x8*)_kp; ka[j][1] = *(const f16x8*)(_kp + 32); } } while (0)
    if (wg < MT / 16) IDX_LOAD_UNIT(wg);
    for (int u = wg; u < MT / 16; u += G) {
        const int b = 2 * (u & 7) + ((u >> 3) & 1), qg = 127 - (u >> 4);
        const int q0 = qg * 16; const size_t rowbase = (size_t)b * SEQ;
        const int nadm = 64 * ((q0 >> 6) + 1);
        float wq[4][8];
#pragma unroll
        for (int r = 0; r < 4; ++r)
#pragma unroll
            for (int hd = 0; hd < 8; ++hd) wq[r][hd] = (float)w8r[r][hd] * (0.35355339059327373f * 0.125f);
        const int ntile = nadm >> 4;
        const int c0 = (ntile + 7) >> 3, cnt = (c0 + 3) & ~3;
        const f16* kbase = PROJ + (rowbase + wv * 16 + l16) * NPJ + C_IK + lq * 8;
        for (int i = 0; i < cnt; i += 4) {
#pragma unroll
            for (int j = 0; j < 4; ++j) {
                const int it = (i + j < c0 - 1) ? i + j : c0 - 1;
                f32x4 sc = {0.f, 0.f, 0.f, 0.f};
                f32x4 a[8];
#pragma unroll
                for (int hd = 0; hd < 8; ++hd) { a[hd] = (f32x4){0.f, 0.f, 0.f, 0.f}; a[hd] = __builtin_amdgcn_mfma_f32_16x16x32_f16(qa[hd][0], ka[j][0], a[hd], 0, 0, 0); }
#pragma unroll
                for (int hd = 0; hd < 8; ++hd) a[hd] = __builtin_amdgcn_mfma_f32_16x16x32_f16(qa[hd][1], ka[j][1], a[hd], 0, 0, 0);
                __builtin_amdgcn_sched_barrier(0);
#pragma unroll
                for (int hd = 0; hd < 8; ++hd)
#pragma unroll
                    for (int r = 0; r < 4; ++r) { const int bi = __float_as_int(a[hd][r]); sc[r] += wq[r][hd] * __int_as_float(bi > 0 ? bi : 0); }
                { const int itn = (i + j + 4 < c0 - 1) ? i + j + 4 : c0 - 1; const f16* kp = kbase + (size_t)itn * (128 * NPJ); ka[j][0] = *(const f16x8*)kp; ka[j][1] = *(const f16x8*)(kp + 32); }
#pragma unroll
                for (int r = 0; r < 4; ++r) SCR[(4 * lq + r) * IDX_PITCH + (wv + 8 * it) * 16 + l16] = sc[r] + 0.0f;
            }
        }
        __syncthreads();
        if (u + G < MT / 16) IDX_LOAD_UNIT(u + G);
#ifndef TOPK_REP
#define TOPK_REP 1
#endif
        if (do_topk) for (int qs = 0; qs < 2 * TOPK_REP; ++qs) {
            const int qq = 2 * wv + (qs & 1);
            unsigned* mrow = MASK + (rowbase + q0 + qq) * 64;
            unsigned word = 0u;
            if (nadm <= 256) {
                word = (lane * 32 < nadm) ? 0xFFFFFFFFu : 0u;
            } else {
                const float* row = SCR + qq * IDX_PITCH;
                if (nadm <= 512) word = topk_words<8>(row, nadm, lane, hist, hdum);
                else if (nadm <= 1024) word = topk_words<16>(row, nadm, lane, hist, hdum);
                else if (nadm <= 1536) word = topk_words<24>(row, nadm, lane, hist, hdum);
                else word = topk_words<32>(row, nadm, lane, hist, hdum);
            }
            mrow[lane] = word;
        }
        __syncthreads();
    }
}
__device__ __forceinline__ void dsa_attn_phase(unsigned char* lds, const f16* PROJ, const f16* KV, const f16* KVT, const unsigned* MASK, const float* BIAS2, const f16* WUVT, f16* OBUF, int G, int wg) {
    const int tid = ltid(), lane = tid & 63, wv = tid >> 6, l32 = lane & 31, hh = lane >> 5;
    f16* KlB = (f16*)lds;
    f16* VlB = (f16*)(lds + 2 * 17408);
    const int hd = wv;
    const float c1 = 0.08838834764831845f * LOG2E;
    const int skey = tid >> 3, skc = (tid & 7) * 16, sdim = tid >> 2, sdc = (tid & 3) * 16;
    f16x8 qraw[8], k0, k1, t0, t1;
#define DSA_UNIT_BQ(U, B_, QI_) do { if (G == 256) { const int _j = wg >> 4, _i = (U) >> 8; B_ = 2 * (wg & 7) + ((wg >> 3) & 1);     QI_ = (_i == 0) ? 63 - _j : (_i == 1) ? 32 + _j : (_i == 2) ? 31 - _j : _j; } \
        else { B_ = (U) & 15; QI_ = 63 - ((U) >> 4); } } while (0)
#define DSA_LOAD_UNIT(U) do { int _b, _qi; DSA_UNIT_BQ(U, _b, _qi); const size_t _rb = (size_t)_b * SEQ; \
        const f16* _qp = PROJ + (_rb + _qi * 32 + l32) * NPJ + C_DQ + hd * 128 + hh * 8; \
        _Pragma("unroll") for (int s_ = 0; s_ < 8; ++s_) qraw[s_] = *(const f16x8*)(_qp + 16 * s_); \
        const f16* _kv = KV + (_rb + skey) * 128 + skc; const f16* _kt = KVT + ((size_t)_b * 128 + sdim) * SEQ + sdc; \
        k0 = *(const f16x8*)_kv; k1 = *(const f16x8*)(_kv + 8); t0 = *(const f16x8*)_kt; t1 = *(const f16x8*)(_kt + 8); } while (0)
    float* BL = (float*)(lds + 77824) + wv * 256;
    { const float* bsrc = BIAS2 + hd * 2112 + 2047 - 192;
#pragma unroll
      for (int i = 0; i < 4; ++i) BL[lane + 64 * i] = bsrc[lane + 64 * i]; }
    float* RED = (float*)(lds + 73728 + 2048);
    int par = 0;
    for (int u = wg; u < 1024; u += G, par ^= 1) {
        int b, qi; DSA_UNIT_BQ(u, b, qi);
        DSA_LOAD_UNIT(u);
        const int q0 = qi * 32; const size_t rowbase = (size_t)b * SEQ;
        const int ntile = (q0 >> 6) + 1;
        f16x8 qf[8];
#pragma unroll
        for (int s = 0; s < 8; ++s)
#pragma unroll
            for (int e = 0; e < 8; ++e) qf[s][e] = (f16)((float)qraw[s][e] * c1);
        const unsigned* mrow = MASK + (rowbase + q0 + l32) * 64;
        const int q = q0 + l32;
        f32x16 accO[4];
#pragma unroll
        for (int d = 0; d < 4; ++d)
#pragma unroll
            for (int r = 0; r < 16; ++r) accO[d][r] = 0.f;
        float mrun = 0.f, lsum = 0.f;
        const f16* kvp = KV + (rowbase + skey) * 128 + skc;
        const f16* ktp = KVT + ((size_t)b * 128 + sdim) * SEQ + sdc;
        __syncthreads();
        { f16* Kw = KlB + skey * 136 + skc; f16* Vw = VlB + sdim * 72 + sdc;
          *(f16x8*)Kw = k0; *(f16x8*)(Kw + 8) = k1; *(f16x8*)Vw = t0; *(f16x8*)(Vw + 8) = t1; }
        __syncthreads();
        for (int kt = 0; kt < ntile; ++kt) {
            const f16* Kl = KlB + (kt & 1) * (64 * 136); const f16* Vl = VlB + (kt & 1) * (128 * 72);
            if (kt + 1 < ntile) { const f16* a = kvp + (size_t)(kt + 1) * 64 * 128; const f16* c = ktp + (kt + 1) * 64;
                k0 = *(const f16x8*)a; k1 = *(const f16x8*)(a + 8); t0 = *(const f16x8*)c; t1 = *(const f16x8*)(c + 8); }
            const u32x2 mw = *(const u32x2*)(mrow + 2 * kt);
            const bool near = (kt * 64 + 63 + 96 > q0);
            const float* bp = BL + 192 - q + kt * 64 + 4 * hh;
            f32x16 S0, S1;
            { const float ninit = -mrun;
#pragma unroll
              for (int r = 0; r < 16; ++r) { S0[r] = ninit; S1[r] = ninit; } }
#define DSA_QK(SX, T_) do { _Pragma("unroll") for (int s4 = 0; s4 < 8; s4 += 4) { f16x8 kf[4]; \
                _Pragma("unroll") for (int s = 0; s < 4; ++s) kf[s] = *(const f16x8*)(Kl + (32 * (T_) + l32) * 136 + 16 * (s4 + s) + 8 * hh); \
                __builtin_amdgcn_sched_barrier(0); __builtin_amdgcn_s_setprio(1); \
                _Pragma("unroll") for (int s = 0; s < 4; ++s) SX = __builtin_amdgcn_mfma_f32_32x32x16_f16(kf[s], qf[s4 + s], SX, 0, 0, 0); __builtin_amdgcn_s_setprio(0); } } while (0)
#define DSA_SOFTMAX(SX, SOTHER, T_, PF) do { \
                if (near) { _Pragma("unroll") for (int g = 0; g < 4; ++g) _Pragma("unroll") for (int e = 0; e < 4; ++e) SX[4 * g + e] += bp[32 * (T_) + 8 * g + e]; } \
                float tmax = SX[0]; _Pragma("unroll") for (int r = 1; r < 16; ++r) tmax = fmaxf(tmax, SX[r]); \
                const bool first = (kt == 0 && (T_) == 0); \
                if (first || __ballot(tmax > 8.0f) != 0ull) { \
                    const float tm2 = fmaxf(tmax, __shfl_xor(tmax, 32)); \
                    const float delta = (first || tm2 > 8.0f) ? tm2 : 0.f; \
                    const float alpha = __builtin_amdgcn_exp2f(-delta); \
                    mrun += delta; lsum *= alpha; \
                    _Pragma("unroll") for (int r = 0; r < 16; ++r) { SX[r] -= delta; if ((T_) == 0) SOTHER[r] -= delta; }     \
                    _Pragma("unroll") for (int d = 0; d < 4; ++d) _Pragma("unroll") for (int r = 0; r < 16; ++r) accO[d][r] *= alpha; } \
                const unsigned wsh = ((T_) == 0 ? mw[0] : mw[1]) >> (4 * hh); \
                float ps = 0.f; \
                _Pragma("unroll") for (int r = 0; r < 16; ++r) { \
                    const float p = __builtin_amdgcn_exp2f(SX[r]); float pm; \
                    asm("v_bfe_i32 %0, %1, %2, 1\n\tv_and_b32 %0, %0, %3" : "=&v"(pm) : "v"(wsh), "n"(8 * (r >> 2) + (r & 3)), "v"(p)); \
                    SX[r] = pm; ps += pm; } \
                lsum += ps; \
                _Pragma("unroll") for (int s = 0; s < 2; ++s) _Pragma("unroll") for (int e = 0; e < 8; ++e) PF[s][e] = (f16)SX[8 * s + e]; } while (0)
#define DSA_PV(PF, T_) do { _Pragma("unroll") for (int d2 = 0; d2 < 4; d2 += 2) { f16x8 vf[2][2]; \
                _Pragma("unroll") for (int d = 0; d < 2; ++d) _Pragma("unroll") for (int s = 0; s < 2; ++s) vf[d][s] = *(const f16x8*)(Vl + (32 * (d2 + d) + l32) * 72 + 32 * (T_) + 16 * s + 8 * hh); \
                __builtin_amdgcn_sched_barrier(0); __builtin_amdgcn_s_setprio(1); \
                _Pragma("unroll") for (int d = 0; d < 2; ++d) _Pragma("unroll") for (int s = 0; s < 2; ++s) accO[d2 + d] = __builtin_amdgcn_mfma_f32_32x32x16_f16(vf[d][s], PF[s], accO[d2 + d], 0, 0, 0); __builtin_amdgcn_s_setprio(0); } } while (0)
            DSA_QK(S0, 0); DSA_QK(S1, 1);
            { f16x8 pf0[2]; DSA_SOFTMAX(S0, S1, 0, pf0); DSA_PV(pf0, 0); }
            { f16x8 pf1[2]; DSA_SOFTMAX(S1, S0, 1, pf1); DSA_PV(pf1, 1); }
#undef DSA_QK
#undef DSA_SOFTMAX
#undef DSA_PV
            if (kt + 1 < ntile) { f16* Kw = KlB + ((kt + 1) & 1) * (64 * 136) + skey * 136 + skc; f16* Vw = VlB + ((kt + 1) & 1) * (128 * 72) + sdim * 72 + sdc;
                *(f16x8*)Kw = k0; *(f16x8*)(Kw + 8) = k1; *(f16x8*)Vw = t0; *(f16x8*)(Vw + 8) = t1; }
            __syncthreads();
        }
        const float ltot = lsum + __shfl_xor(lsum, 32);
        const float inv = 1.0f / ltot;
        f32x16 Z[2];
#pragma unroll
        for (int n = 0; n < 2; ++n)
#pragma unroll
            for (int r = 0; r < 16; ++r) Z[n][r] = 0.f;
#pragma unroll
        for (int dh = 0; dh < 2; ++dh) {
            f16x4 wlo[2][2][2], whi[2][2][2];
#pragma unroll
            for (int d = 0; d < 2; ++d)
#pragma unroll
                for (int s = 0; s < 2; ++s)
#pragma unroll
                    for (int n = 0; n < 2; ++n) {
                        const f16* wp = WUVT + ((size_t)hd * 64 + 32 * n + l32) * 128 + 32 * (2 * dh + d) + 16 * s + 4 * hh;
                        wlo[d][s][n] = *(const f16x4*)wp; whi[d][s][n] = *(const f16x4*)(wp + 8);
                    }
#pragma unroll
            for (int d = 0; d < 2; ++d)
#pragma unroll
                for (int s = 0; s < 2; ++s) {
                    f16x8 ob;
#pragma unroll
                    for (int e = 0; e < 8; ++e) ob[e] = (f16)(accO[2 * dh + d][8 * s + e] * inv);
#pragma unroll
                    for (int n = 0; n < 2; ++n) {
                        const f16x4 lo = wlo[d][s][n], hi = whi[d][s][n];
                        f16x8 wa; wa[0] = lo[0]; wa[1] = lo[1]; wa[2] = lo[2]; wa[3] = lo[3]; wa[4] = hi[0]; wa[5] = hi[1]; wa[6] = hi[2]; wa[7] = hi[3];
                        Z[n] = __builtin_amdgcn_mfma_f32_32x32x16_f16(wa, ob, Z[n], 0, 0, 0);
                    }
                }
        }
        float ssq = 0.f;
#pragma unroll
        for (int n = 0; n < 2; ++n)
#pragma unroll
            for (int r = 0; r < 16; ++r) ssq += Z[n][r] * Z[n][r];
        ssq += __shfl_xor(ssq, 32);
        if (hh == 0) RED[(par * 8 + wv) * 32 + l32] = ssq;
        __syncthreads();
        float tot = 0.f;
#pragma unroll
        for (int w8 = 0; w8 < 8; ++w8) tot += RED[(par * 8 + w8) * 32 + l32];
        const float rstd = rsqrtf(tot * (1.0f / 512.f) + EPS);
        { f16* op = OBUF + (rowbase + q) * DM + 512 + hd * 64 + 4 * hh;
#pragma unroll
          for (int n = 0; n < 2; ++n)
#pragma unroll
            for (int g = 0; g < 4; ++g) { f16x4 o; o[0] = (f16)(Z[n][4 * g] * rstd); o[1] = (f16)(Z[n][4 * g + 1] * rstd); o[2] = (f16)(Z[n][4 * g + 2] * rstd); o[3] = (f16)(Z[n][4 * g + 3] * rstd);
                *(f16x4*)(op + 32 * n + 8 * g) = o; } }
    }
}
constexpr int N_PHASES = 15;
struct Args { Ptrs p; int ph_lo, ph_hi; };

__global__ void __launch_bounds__(NTHR, 2) trunk_fwd(Args args) {
    extern __shared__ __attribute__((aligned(16))) unsigned char lds[];
    const Ptrs& P = args.p;
    unsigned char* ws = P.ws;
    const int G = gridDim.x, wg = blockIdx.x, tid = threadIdx.x;
    const int lo = args.ph_lo, hi = args.ph_hi;
    const bool multi = (hi - lo) > 1;
    XcdBarrier bar; bar.bar = (unsigned*)(ws + WS_CTL); bar.x = 0; bar.st = nullptr;
    if (multi) {
        if (tid < 4) ((LAS unsigned*)(lds + LDS_MISC))[tid] = 0u;
        __syncthreads();
        bar = xcd_barrier_post((unsigned*)(ws + WS_CTL), (volatile LAS unsigned*)(lds + LDS_MISC));
    }
#ifndef REP_IDX
#define REP_IDX 1
#endif
#ifndef REP_IDX_SCORE_ONLY
#define REP_IDX_SCORE_ONLY 0
#endif
#ifndef REP_SB
#define REP_SB 1
#endif
#ifndef REP_DSA
#define REP_DSA 1
#endif
#ifndef REP_GIN
#define REP_GIN 1
#endif
#ifndef REP_GUP
#define REP_GUP 1
#endif
#ifndef PHMASK
#define PHMASK 0xFFFFF
#endif
#define IN(k) (lo <= (k) && (k) < hi)
#define PM(j) ((PHMASK >> (j)) & 1)
#define SEAM(k) do { if (IN(k) && IN((k) + 1)) xcd_barrier(bar); } while (0)
    float* MOD = (float*)(ws + WS_MOD);
    f16* H = (f16*)(ws + WS_H); f16* PROJ = (f16*)(ws + WS_PROJ); f16* OBUF = (f16*)(ws + WS_OBUF); f16* HID = (f16*)(ws + WS_HID);
    f16* KV = (f16*)(ws + WS_KV); f16* KVT = (f16*)(ws + WS_KVT); f16* VTA = (f16*)(ws + WS_VTA); unsigned* MASK = (unsigned*)(ws + WS_MASK);
    float* X = P.out;

    float* SSQ = (float*)(ws + WS_SSQ); float* BW = (float*)(ws + WS_BW);
    if (PM(0) && IN(0)) { prologue_phase(lds, P, G, wg); SEAM(0); }
    if (PM(1) && IN(1)) {
        bw_phase(lds, P, MOD, BW, G, wg);
        prenorm0_phase(P.x, P.g_attn, MOD + 1 * DM, H, SSQ, G, wg);
        SEAM(1);
    }

    for (int l = 0; l < NLAYER; ++l) {
        const int pb = 2 + 6 * l;
        const float* modl = MOD + (size_t)l * 16 * 6144;
        const float* xin = (l == 0) ? P.x : X;
        const float* ssq1 = SSQ + (size_t)(l == 0 ? 0 : 2) * MT;
        float* ssq2 = SSQ + (size_t)(l == 0 ? 1 : 3) * MT;
        if (PM(2) && IN(pb + 0)) {
            pg8::Gemm g{H, (const f16*)(ws + WS_WIN) + (size_t)l * NPJ * DM, MT, NPJ, DM}; pg8::StaticOrder S; S.init(MT, NPJ, G, wg);
            pg8::EpiF16N<0> E{PROJ, NPJ, ssq1, BW + (size_t)(l * 2 + 0) * 16 * 4096};
            for (int rep = 0; rep < REP_GIN; ++rep) pg8::gemm_phase<pg8::EpiF16N<0>, pg8::StaticOrder>((LAS unsigned char*)lds, g, S, E);
            SEAM(pb + 0);
        }
        if (PM(3) && IN(pb + 1)) {
#if ENABLE_DSA
            kvnorm_phase(lds, PROJ, P.kv_norm_g + l * 128, KV, KVT, G, wg);
            __syncthreads();
#endif
#if ENABLE_SB
            vtrans_phase(lds, PROJ, VTA, G, wg);
            __syncthreads();
#endif
#if ENABLE_DSA
            for (int rep = 0; rep < REP_IDX; ++rep) { indexer_phase(lds, PROJ, MASK, G, wg, rep == 0 || !REP_IDX_SCORE_ONLY); __syncthreads(); }
#endif
            SEAM(pb + 1);
        }
        if (PM(4) && IN(pb + 2)) {
            for (int rep = 0; rep < REP_SB; ++rep) { sb_attn_phase(lds, PROJ, VTA, OBUF, G, wg); }
            for (int rep = 0; rep < REP_DSA; ++rep) { __syncthreads(); dsa_attn_phase(lds, PROJ, KV, KVT, MASK, (const float*)(ws + WS_BIAS), (const f16*)(ws + WS_WUV) + (size_t)l * 8 * 64 * 128, OBUF, G, wg); }
            SEAM(pb + 2);
        }
        if (PM(6) && IN(pb + 3)) {
            pg8::Gemm g{OBUF, (const f16*)(ws + WS_WOUT) + (size_t)l * DM * DM, MT, DM, DM}; pg8::StaticOrder S; S.init(MT, DM, G, wg);
            pg8::EpiResidN E{xin, X, modl + 2 * DM, P.g_mlp + l * DM, modl + 4 * DM, H, ssq2};
            pg8::gemm_phase<pg8::EpiResidN, pg8::StaticOrder>((LAS unsigned char*)lds, g, S, E);
            SEAM(pb + 3);
        }
        if (PM(8) && IN(pb + 4)) {
            pg8::Gemm g{H, (const f16*)(ws + WS_WUP) + (size_t)l * FF * DM, MT, FF, DM}; pg8::StaticOrder S; S.init(MT, FF, G, wg);
            pg8::EpiF16N<1> E{HID, FF, ssq2, BW + (size_t)(l * 2 + 1) * 16 * 4096};
            for (int rep = 0; rep < REP_GUP; ++rep) pg8::gemm_phase<pg8::EpiF16N<1>, pg8::StaticOrder>((LAS unsigned char*)lds, g, S, E);
            SEAM(pb + 4);
        }
        if (PM(9) && IN(pb + 5)) {
            pg8::Gemm g{HID, (const f16*)(ws + WS_WDN) + (size_t)l * DM * FF, MT, DM, FF}; pg8::StaticOrder S; S.init(MT, DM, G, wg);
            if (l == 0) {
                pg8::EpiResidN E{X, X, modl + 5 * DM, P.g_attn + DM, MOD + (size_t)16 * 6144 + 1 * DM, H, SSQ + (size_t)2 * MT};
                pg8::gemm_phase<pg8::EpiResidN, pg8::StaticOrder>((LAS unsigned char*)lds, g, S, E);
            } else {
                pg8::EpiResid E{X, X, modl + 5 * DM};
                pg8::gemm_phase<pg8::EpiResid, pg8::StaticOrder>((LAS unsigned char*)lds, g, S, E);
            }
            SEAM(pb + 5);
        }
    }
    if (PM(10) && IN(14)) { final_norm_phase(X, P.g_final, P.out, G, wg); }
#undef IN
#undef SEAM
}

extern "C" void kernel_launch(void* const* d_in, const int* in_sizes, int n_in, void* d_out, int out_size, void* d_ws, size_t ws_size, hipStream_t stream) {
    static int grid = 0;
    if (grid == 0) {
        if (n_in != 16 || in_sizes[0] != MT * DM || out_size != MT * DM || ws_size < WS_END) {
            fprintf(stderr, "kernel_launch: unexpected shapes: n_in %d in0 %d out %d ws %zu (need %zu)\n", n_in, n_in > 0 ? in_sizes[0] : -1, out_size, ws_size, (size_t)WS_END); grid = -1; return; }
        int dev = 0, cus = 0, per_cu = 0;
        if (hipGetDevice(&dev) != hipSuccess || hipDeviceGetAttribute(&cus, hipDeviceAttributeMultiprocessorCount, dev) != hipSuccess) { grid = -1; return; }
        if (hipFuncSetAttribute((const void*)trunk_fwd, hipFuncAttributeMaxDynamicSharedMemorySize, LDS_BYTES) != hipSuccess) { fprintf(stderr, "kernel_launch: hipFuncSetAttribute failed\n"); grid = -1; return; }
        if (hipOccupancyMaxActiveBlocksPerMultiprocessor(&per_cu, (const void*)trunk_fwd, NTHR, LDS_BYTES) != hipSuccess || per_cu < 1) fprintf(stderr, "kernel_launch: occupancy query says %d\n", per_cu);
        (void)hipGetLastError();
        grid = cus;
    }
    if (grid < 0) return;
    (void)hipMemsetAsync((char*)d_ws + WS_CTL, 0, CTL_BYTES, stream);
    Args a{};
    a.p.x = (const float*)d_in[0]; a.p.c = (const float*)d_in[1]; a.p.w_mod = (const float*)d_in[2]; a.p.b_mod = (const float*)d_in[3]; a.p.g_attn = (const float*)d_in[4];
    a.p.w_in = (const float*)d_in[5]; a.p.kv_norm_g = (const float*)d_in[6]; a.p.w_uv = (const float*)d_in[7]; a.p.g_out_a = (const float*)d_in[8]; a.p.g_out_b = (const float*)d_in[9];
    a.p.w_out = (const float*)d_in[10]; a.p.g_mlp = (const float*)d_in[11]; a.p.w_up = (const float*)d_in[12]; a.p.w_down = (const float*)d_in[13]; a.p.rel_bias = (const float*)d_in[14];
    a.p.g_final = (const float*)d_in[15]; a.p.out = (float*)d_out; a.p.ws = (unsigned char*)d_ws;
#if N_LAUNCH_MODE == 1
    a.ph_lo = 0; a.ph_hi = N_PHASES;
    hipLaunchKernelGGL(trunk_fwd, dim3(grid), dim3(NTHR), LDS_BYTES, stream, a);
#else
    for (int ph = 0; ph < N_PHASES; ++ph) { a.ph_lo = ph; a.ph_hi = ph + 1; hipLaunchKernelGGL(trunk_fwd, dim3(grid), dim3(NTHR), LDS_BYTES, stream, a); }
#endif
}
```

```cpp
#include <hip/hip_runtime.h>
#include <cstdio>
#include <cstdint>

#define LAS __attribute__((address_space(3)))
typedef _Float16 f16;
typedef _Float16 f16x8 __attribute__((ext_vector_type(8)));
typedef _Float16 f16x4 __attribute__((ext_vector_type(4)));
typedef __bf16 bf16x8 __attribute__((ext_vector_type(8)));
typedef float f32x2 __attribute__((ext_vector_type(2)));
typedef float f32x4 __attribute__((ext_vector_type(4)));
typedef float f32x16 __attribute__((ext_vector_type(16)));
typedef unsigned u32x2 __attribute__((ext_vector_type(2)));
typedef unsigned u32x4 __attribute__((ext_vector_type(4)));

#ifndef N_LAUNCH_MODE
#define N_LAUNCH_MODE 1
#endif
#ifndef ENABLE_SB
#define ENABLE_SB 1
#endif
#ifndef ENABLE_DSA
#define ENABLE_DSA 1
#endif

constexpr int NB = 16, SEQ = 2048, DM = 1024, MT = NB * SEQ, NPJ = 3328, NPJ_VALID = 3272, FF = 4096, NLAYER = 2;
constexpr int C_SBQ = 0, C_SBK = 512, C_SBV = 1024, C_DQ = 1536, C_DKV = 2560, C_IQ = 2688, C_IK = 3200, C_IW = 3264;
constexpr int NWAVES = 8, NTHR = 512;
constexpr float EPS = 1e-6f;
constexpr float LOG2E = 1.4426950408889634f;

constexpr size_t al256(size_t x) { return (x + 255) & ~(size_t)255; }
constexpr size_t WS_CTL = 0;
constexpr size_t CTL_BYTES = 65536;
constexpr size_t WS_MOD = WS_CTL + CTL_BYTES;
constexpr size_t WS_BIAS = WS_MOD + al256((size_t)2 * 16 * 6144 * 4);
constexpr size_t WS_SSQ = WS_BIAS + al256((size_t)8 * 2112 * 4);
constexpr size_t WS_BW = WS_SSQ + (size_t)4 * MT * 4;
constexpr size_t WS_WIN = WS_BW + (size_t)2 * 2 * 16 * 4096 * 4;
constexpr size_t WS_WOUT = WS_WIN + (size_t)2 * NPJ * DM * 2;
constexpr size_t WS_WUP = WS_WOUT + (size_t)2 * DM * DM * 2;
constexpr size_t WS_WDN = WS_WUP + (size_t)2 * FF * DM * 2;
constexpr size_t WS_WUV = WS_WDN + (size_t)2 * FF * DM * 2;
constexpr size_t WS_H = WS_WUV + (size_t)2 * 8 * 64 * 128 * 2;
constexpr size_t WS_KV = WS_H + (size_t)MT * DM * 2;
constexpr size_t WS_KVT = WS_KV + (size_t)MT * 128 * 2;
constexpr size_t WS_VTA = WS_KVT + (size_t)MT * 128 * 2;
constexpr size_t WS_MASK = WS_VTA + (size_t)MT * 512 * 2;
constexpr size_t WS_PROJ = WS_MASK + (size_t)MT * 64 * 4;
constexpr size_t WS_OBUF = WS_PROJ + (size_t)MT * NPJ * 2;
constexpr size_t WS_HID = WS_PROJ;
constexpr size_t WS_END = WS_OBUF + (size_t)MT * DM * 2;
static_assert((size_t)MT * FF * 2 <= WS_END - WS_PROJ, "HID overlay must fit");

constexpr int LDS_BYTES = 147456;
constexpr int LDS_MISC = 135168;

__device__ __forceinline__ float wave_sum(float v) {
    v += __shfl_xor(v, 32); v += __shfl_xor(v, 16); v += __shfl_xor(v, 8); v += __shfl_xor(v, 4); v += __shfl_xor(v, 2); v += __shfl_xor(v, 1); return v;
}
__device__ __forceinline__ float half_sum(float v) {
    v += __shfl_xor(v, 16); v += __shfl_xor(v, 8); v += __shfl_xor(v, 4); v += __shfl_xor(v, 2); v += __shfl_xor(v, 1); return v;
}

__device__ __forceinline__ int ltid() { int t = threadIdx.x; asm volatile("" : "+v"(t)); return t; }

__device__ __forceinline__ int wave_sum_i(int v) {
    v += __builtin_amdgcn_update_dpp(0, v, 0xB1, 0xf, 0xf, true);
    v += __builtin_amdgcn_update_dpp(0, v, 0x4E, 0xf, 0xf, true);
    v += __builtin_amdgcn_update_dpp(0, v, 0x141, 0xf, 0xf, true);
    v += __builtin_amdgcn_update_dpp(0, v, 0x140, 0xf, 0xf, true);
    return __builtin_amdgcn_readlane(v, 0) + __builtin_amdgcn_readlane(v, 16) + __builtin_amdgcn_readlane(v, 32) + __builtin_amdgcn_readlane(v, 48);
}

__device__ __forceinline__ int kperm16(int k) { return (k & ~12) | ((k & 8) >> 1) | ((k & 4) << 1); }

#ifndef MLP_BF16
#define MLP_BF16 1
#endif
#ifndef ALL_BF16
#define ALL_BF16 0
#endif
template <bool BF> __device__ __forceinline__ f16 cvt16(float x) { if constexpr (BF) { const __bf16 b = (__bf16)x; return __builtin_bit_cast(f16, b); } else return (f16)x; }
#define XB_TMO      128
#define XB_XCNT(j)  (256  + 64 * (j))
#define XB_XSUB(j)  (1280 + 64 * (j))
#define XB_XGEN(j)  (2304 + 64 * (j))
#define XB_TOP      3328
#define XB_TOPGEN   3392
#define XCD_BAR_WORDS 3456
#define XB_SPIN_CAP (1u << 18)

__device__ __forceinline__ unsigned xb_ld(unsigned* p)              { return __hip_atomic_load(p, __ATOMIC_RELAXED, __HIP_MEMORY_SCOPE_AGENT); }
__device__ __forceinline__ unsigned xb_add(unsigned* p, unsigned v) { return __hip_atomic_fetch_add(p, v, __ATOMIC_RELAXED, __HIP_MEMORY_SCOPE_AGENT); }
__device__ __forceinline__ unsigned xb_xcc_id() { return (unsigned)__builtin_amdgcn_s_getreg((3 << 11) | 20) & 0xFu; }
#define XB_SPIN(cond, bar) do { unsigned _sp = 0; while (cond) { __builtin_amdgcn_s_sleep(1); \
    if ((++_sp & 255u) == 0u) { if (xb_ld(&(bar)[XB_TMO])) break; if (_sp > XB_SPIN_CAP) { atomicAdd(&(bar)[XB_TMO], 1u); break; } } } } while (0)

struct XcdBarrier {
    unsigned* bar; unsigned x;
    volatile LAS unsigned* st;
};

__device__ __forceinline__ XcdBarrier xcd_barrier_post(unsigned* bar, volatile LAS unsigned* st) {
    XcdBarrier b; b.bar = bar; b.x = xb_xcc_id(); b.st = st;
    if (threadIdx.x == 0) (void)xb_add(&bar[XB_XCNT(b.x)], 1u);
    return b;
}
__device__ __forceinline__ void xcd_barrier_complete(unsigned* bar, unsigned x, unsigned& nloc, unsigned& nx) {
    const unsigned G = gridDim.x * gridDim.y * gridDim.z;
    unsigned sum, cnt, mine, sp = 0u;
    for (;;) {
        sum = 0u; cnt = 0u; mine = 0u;
#pragma unroll
        for (unsigned j = 0; j < 16; ++j) { const unsigned c = xb_ld(&bar[XB_XCNT(j)]); sum += c; cnt += (c > 0u) ? 1u : 0u; mine = (j == x) ? c : mine; }
        if (sum == G) break;
        __builtin_amdgcn_s_sleep(1);
        if ((++sp & 255u) == 0u) { if (xb_ld(&bar[XB_TMO])) break; if (sp > XB_SPIN_CAP) { atomicAdd(&bar[XB_TMO], 1u); break; } }
    }
    nloc = mine > 0u ? mine : 1u; nx = cnt > 0u ? cnt : 1u;
}

__device__ __forceinline__ void xcd_barrier(const XcdBarrier& b) {
    asm volatile("s_waitcnt vmcnt(0)" ::: "memory");
    __syncthreads();
    if (threadIdx.x == 0) {
        unsigned* bar = b.bar;
        __builtin_amdgcn_s_waitcnt(0);
        unsigned nloc = b.st[0], nx = b.st[1];
        if (nloc == 0u) { xcd_barrier_complete(bar, b.x, nloc, nx); b.st[0] = nloc; b.st[1] = nx; }
        const unsigned old = xb_add(&bar[XB_XSUB(b.x)], 1u);
        const unsigned gen = old / nloc;
        if (old + 1u == (gen + 1u) * nloc) {
            __builtin_amdgcn_fence(__ATOMIC_RELEASE, "agent");
            asm volatile("s_waitcnt vmcnt(0)" ::: "memory");
            const unsigned og = xb_add(&bar[XB_TOP], 1u);
            const unsigned tg = og / nx;
            if (og + 1u == (tg + 1u) * nx) xb_add(&bar[XB_TOPGEN], 1u);
            else XB_SPIN(xb_ld(&bar[XB_TOPGEN]) == tg, bar);
            __builtin_amdgcn_fence(__ATOMIC_ACQUIRE, "agent");
            xb_add(&bar[XB_XGEN(b.x)], 1u);
            asm volatile("s_waitcnt vmcnt(0)" ::: "memory");
        } else {
            XB_SPIN(xb_ld(&bar[XB_XGEN(b.x)]) == gen, bar);
            __builtin_amdgcn_fence(__ATOMIC_ACQUIRE, "agent");
            asm volatile("s_waitcnt vmcnt(0)" ::: "memory");
        }
    }
    __syncthreads();
}

namespace pg8 {
constexpr int BM = 256, BK = 64, HALF = 128, HTB = HALF * BK * 2  , STAGE_BYTES = 8 * HTB, NXCD = 8, WGM = 4;

__host__ __device__ __forceinline__ int lds_byte(int r, int c) { const int st = (r >> 4) * 2 + (c >> 5), rr = r & 15, cc = c & 31, ob = rr * 64 + cc * 2; return st * 1024 + (ob ^ (((ob >> 9) & 1) << 5)); }
__host__ __device__ __forceinline__ void stage_rc(int b, int& R, int& C) { const int st = b / 1024, sb = b % 1024, swz = sb ^ (((sb >> 9) & 1) << 5); R = (st >> 1) * 16 + swz / 64; C = (st & 1) * 32 + (swz % 64) / 2; }
__host__ __device__ __forceinline__ int perm32(int rho) { const int n = rho >> 4, i = rho & 15; return 8 * (i >> 2) + 4 * n + (i & 3); }

struct Unit { int pm, pn; };
struct Gemm { const f16* A; const f16* Bt; int M, N, K; };

struct StaticOrder {
    int nM, nN, nwg, G, c;
    __host__ __device__ void init(int M, int N, int G_, int c_) { nM = M / BM; nN = N / BM; nwg = nM * nN; G = G_; c = c_; }
    __host__ __device__ bool next(int i, Unit& u) const {
        const long L = (long)i * G + c; if (L >= nwg) return false;
        int wgid = (int)L;
#ifndef NO_XCD_REMAP
        { const int q = nwg / NXCD, r = nwg % NXCD, xcd = wgid % NXCD, off = wgid / NXCD; wgid = (xcd < r ? xcd * (q + 1) : r * (q + 1) + (xcd - r) * q) + off; }
#endif
        const int nig = WGM * nN, gid = wgid / nig, fm = gid * WGM, gsz = (nM - fm) < WGM ? (nM - fm) : WGM;
        u.pm = fm + ((wgid % nig) % gsz); u.pn = (wgid % nig) / gsz; return true;
    }
    __device__ __forceinline__ void a_ready(const Unit&) const {}
    __device__ __forceinline__ void done(const Unit&) const {}
};

struct EpiResid {
    static constexpr bool PERM = true, AFTER_DRAIN = false, PREFETCH = false;
    const float* base; float* out; const float* gate;
    __device__ __forceinline__ void operator()(const f32x4 (&acc)[2][2][4][2], const Unit& u, int wr, int wc, int fr, int fq) const {
        const int row0 = u.pm * BM + wr * 64 + fr; const int col0 = u.pn * BM + wc * 32 + 8 * fq;
        const float* gp = gate + (size_t)((u.pm * BM) >> 11) * 6144 + col0;
        f32x4 gv[2][2];
#pragma unroll
        for (int bj = 0; bj < 2; ++bj)
#pragma unroll
            for (int n = 0; n < 2; ++n) gv[bj][n] = *(const f32x4*)(gp + bj * HALF + 4 * n);
#pragma unroll
        for (int ai = 0; ai < 2; ++ai)
#pragma unroll
            for (int m = 0; m < 4; ++m) { const size_t ro = (size_t)(row0 + ai * HALF + m * 16) * DM + col0;
#pragma unroll
                for (int bj = 0; bj < 2; ++bj)
#pragma unroll
                    for (int n = 0; n < 2; ++n) { const f32x4 x = *(const f32x4*)(base + ro + bj * HALF + 4 * n);
                        *(f32x4*)(out + ro + bj * HALF + 4 * n) = x + gv[bj][n] * acc[ai][bj][m][n]; } }
    }
};
template <int ACT  , bool BF = false> struct EpiF16N {
    static constexpr bool PERM = true, AFTER_DRAIN = false, PREFETCH = true;
    f16* O; int ldc; const float* ssq; const float* bw;
    __device__ __forceinline__ void prefetch(LAS unsigned char* aux, const Unit& u, int tid, int wid) const {
        const float* src = (tid < 256) ? ssq + u.pm * BM + tid : bw + (size_t)((u.pm * BM) >> 11) * 4096 + u.pn * BM + (tid - 256);
        __builtin_amdgcn_global_load_lds((const unsigned*)src, (LAS unsigned*)(aux + wid * 256), 4, 0, 0);
    }
    __device__ __forceinline__ void with_lds(const f32x4 (&acc)[2][2][4][2], const Unit& u, int wr, int wc, int fr, int fq, LAS unsigned char* aux) const {
        const int row0 = u.pm * BM + wr * 64 + fr; const int col0 = u.pn * BM + wc * 32 + 8 * fq;
        const LAS float* sq = (const LAS float*)aux; const LAS float* bl = (const LAS float*)(aux + 1024) + wc * 32 + 8 * fq;
        f32x4 bv[2][2];
#pragma unroll
        for (int bj = 0; bj < 2; ++bj)
#pragma unroll
            for (int n = 0; n < 2; ++n) bv[bj][n] = *(const LAS f32x4*)(bl + bj * HALF + 4 * n);
        float rs[2][4];
#pragma unroll
        for (int ai = 0; ai < 2; ++ai)
#pragma unroll
            for (int m = 0; m < 4; ++m) rs[ai][m] = rsqrtf(sq[wr * 64 + fr + ai * HALF + m * 16] * (1.0f / DM) + EPS);
#pragma unroll
        for (int ai = 0; ai < 2; ++ai)
#pragma unroll
            for (int m = 0; m < 4; ++m) { f16* rowp = O + (size_t)(row0 + ai * HALF + m * 16) * ldc + col0;
#pragma unroll
                for (int bj = 0; bj < 2; ++bj) { f32x4 v0 = acc[ai][bj][m][0] * rs[ai][m] + bv[bj][0], v1 = acc[ai][bj][m][1] * rs[ai][m] + bv[bj][1];
                    if (ACT == 1) {
#pragma unroll
                        for (int e = 0; e < 4; ++e) { const float a = fmaxf(v0[e], 0.f), b = fmaxf(v1[e], 0.f); v0[e] = a * a; v1[e] = b * b; } }
                    f16x8 w; w[0] = cvt16<BF>(v0[0]); w[1] = cvt16<BF>(v0[1]); w[2] = cvt16<BF>(v0[2]); w[3] = cvt16<BF>(v0[3]); w[4] = cvt16<BF>(v1[0]); w[5] = cvt16<BF>(v1[1]); w[6] = cvt16<BF>(v1[2]); w[7] = cvt16<BF>(v1[3]);
                    *(f16x8*)(rowp + bj * HALF) = w; } }
    }
    __device__ __forceinline__ void operator()(const f32x4 (&)[2][2][4][2], const Unit&, int, int, int, int) const {}
};
template <bool BF = false> struct EpiResidN {
    static constexpr bool PERM = true, AFTER_DRAIN = false, PREFETCH = false;
    const float* base; float* out; const float* gate; const float* gain; const float* scale; f16* An; float* ssq;
    __device__ __forceinline__ void operator()(const f32x4 (&acc)[2][2][4][2], const Unit& u, int wr, int wc, int fr, int fq) const {
        const int row0 = u.pm * BM + wr * 64 + fr; const int col0 = u.pn * BM + wc * 32 + 8 * fq;
        const size_t bo = (size_t)((u.pm * BM) >> 11) * 6144 + col0;
        f32x4 gv[2][2], al[2][2];
#pragma unroll
        for (int bj = 0; bj < 2; ++bj)
#pragma unroll
            for (int n = 0; n < 2; ++n) { gv[bj][n] = *(const f32x4*)(gate + bo + bj * HALF + 4 * n);
                const f32x4 g4 = *(const f32x4*)(gain + col0 + bj * HALF + 4 * n), s4 = *(const f32x4*)(scale + bo + bj * HALF + 4 * n); al[bj][n] = g4 * (1.0f + s4); }
#pragma unroll
        for (int ai = 0; ai < 2; ++ai)
#pragma unroll
            for (int m = 0; m < 4; ++m) { const int row = row0 + ai * HALF + m * 16; const size_t ro = (size_t)row * DM + col0; float sq = 0.f;
#pragma unroll
                for (int bj = 0; bj < 2; ++bj) {
                    const f32x4 x0 = *(const f32x4*)(base + ro + bj * HALF), x1 = *(const f32x4*)(base + ro + bj * HALF + 4);
                    const f32x4 y0 = x0 + gv[bj][0] * acc[ai][bj][m][0], y1 = x1 + gv[bj][1] * acc[ai][bj][m][1];
                    *(f32x4*)(out + ro + bj * HALF) = y0; *(f32x4*)(out + ro + bj * HALF + 4) = y1;
                    sq += ((y0[0] * y0[0] + y0[1] * y0[1]) + (y0[2] * y0[2] + y0[3] * y0[3])) + ((y1[0] * y1[0] + y1[1] * y1[1]) + (y1[2] * y1[2] + y1[3] * y1[3]));
                    const f32x4 z0 = y0 * al[bj][0], z1 = y1 * al[bj][1]; f16x8 zz;
                    zz[0] = cvt16<BF>(z0[0]); zz[1] = cvt16<BF>(z0[1]); zz[2] = cvt16<BF>(z0[2]); zz[3] = cvt16<BF>(z0[3]); zz[4] = cvt16<BF>(z1[0]); zz[5] = cvt16<BF>(z1[1]); zz[6] = cvt16<BF>(z1[2]); zz[7] = cvt16<BF>(z1[3]);
                    *(f16x8*)(An + ro + bj * HALF) = zz; }
                sq += __shfl_xor(sq, 16); sq += __shfl_xor(sq, 32);
                if (fq == 0) __hip_atomic_fetch_add(ssq + row, sq, __ATOMIC_RELAXED, __HIP_MEMORY_SCOPE_AGENT); }
    }
};

template <class Epi, class Sched, bool BF = false>
__device__ __forceinline__ void gemm_phase(LAS unsigned char* lds, const Gemm g, const Sched& S, const Epi& E) {
    const int tid = ltid(), wid = __builtin_amdgcn_readfirstlane(tid >> 6), lane = tid & 63, wr = wid >> 2, wc = wid & 3, fr = lane & 15, fq = lane >> 4;
    const int K = g.K, nt = K / BK;
    unsigned voffA[2], voffB[2];
#pragma unroll
    for (int i = 0; i < 2; ++i) { int R, C; stage_rc(tid * 16 + i * 8192, R, C); const int Rb = Epi::PERM ? ((R & ~31) + perm32(R & 31)) : R;
        voffA[i] = (unsigned)(R * K + C) * 2u; voffB[i] = (unsigned)(Rb * K + C) * 2u; }
    const size_t kstep = (size_t)(BK * 2);
    const size_t hstep = (size_t)HALF * K * 2;
    const size_t tstep = 2 * hstep;
    const unsigned ldsw = (unsigned)wid * 1024u;
    const int aoff = lds_byte(wr * 64 + fr, fq * 8), boff = lds_byte(wc * 32 + fr, fq * 8);
#define PG8_SA(b, h) (((b) * 2 + (h)) * HTB)
#define PG8_SB(b, h) ((4 + (b) * 2 + (h)) * HTB)
#define PG8_STAGE(bufoff, gbase, voff) do { _Pragma("unroll") for (int _i = 0; _i < 2; ++_i) \
        __builtin_amdgcn_global_load_lds((const unsigned*)((const char*)(gbase) + (voff)[_i]), (LAS unsigned*)(lds + (bufoff) + ldsw + _i * 8192), 16, 0, 0); } while (0)
#define PG8_LDA(dst, b, h) do { _Pragma("unroll") for (int m = 0; m < 4; ++m) _Pragma("unroll") for (int k = 0; k < 2; ++k) dst[m][k] = *(const LAS f16x8*)(lds + PG8_SA(b, h) + aoff + m * 2048 + k * 1024); } while (0)
#define PG8_LDB(dst, b, h) do { _Pragma("unroll") for (int n = 0; n < 2; ++n) _Pragma("unroll") for (int k = 0; k < 2; ++k) dst[n][k] = *(const LAS f16x8*)(lds + PG8_SB(b, h) + boff + n * 2048 + k * 1024); } while (0)
#define PG8_MMA(ai, bj, At, Bt) do { __builtin_amdgcn_s_setprio(1); _Pragma("unroll") for (int m = 0; m < 4; ++m) _Pragma("unroll") for (int n = 0; n < 2; ++n) _Pragma("unroll") for (int k = 0; k < 2; ++k) \
        { if constexpr (BF) acc[ai][bj][m][n] = __builtin_amdgcn_mfma_f32_16x16x32_bf16(__builtin_bit_cast(bf16x8, Bt[n][k]), __builtin_bit_cast(bf16x8, At[m][k]), acc[ai][bj][m][n], 0, 0, 0); \
          else acc[ai][bj][m][n] = __builtin_amdgcn_mfma_f32_16x16x32_f16(Bt[n][k], At[m][k], acc[ai][bj][m][n], 0, 0, 0); } __builtin_amdgcn_s_setprio(0); } while (0)
#define PG8_WAIT_V(n) asm volatile("s_waitcnt vmcnt(" #n ")" ::: "memory")
#define PG8_WAIT_L(n) asm volatile("s_waitcnt lgkmcnt(" #n ")" ::: "memory")
#define PG8_BAR __builtin_amdgcn_s_barrier()
#define PG8_SCHED __builtin_amdgcn_sched_barrier(0)
    Unit cur, nxt; int ui = 0;
    if (!S.next(0, cur)) return;
    f32x4 acc[2][2][4][2];
#pragma unroll
    for (int a = 0; a < 2; ++a)
#pragma unroll
        for (int b = 0; b < 2; ++b)
#pragma unroll
            for (int m = 0; m < 4; ++m)
#pragma unroll
                for (int n = 0; n < 2; ++n) acc[a][b][m][n] = (f32x4){0.f, 0.f, 0.f, 0.f};
    f16x8 At[4][2], B0[2][2], B1[2][2];
    const char* cA = (const char*)g.A + (size_t)cur.pm * tstep; const char* cB = (const char*)g.Bt + (size_t)cur.pn * tstep;
    S.a_ready(cur);
    if constexpr (Epi::PREFETCH) E.prefetch(lds + STAGE_BYTES, cur, tid, wid);
    PG8_STAGE(PG8_SB(0, 0), cB, voffB); PG8_STAGE(PG8_SB(0, 1), cB + hstep, voffB); PG8_STAGE(PG8_SA(0, 0), cA, voffA); PG8_STAGE(PG8_SA(0, 1), cA + hstep, voffA);
    if (wr == 1) PG8_BAR;
    PG8_WAIT_V(2); PG8_BAR;
    PG8_STAGE(PG8_SB(1, 0), cB + kstep, voffB); PG8_STAGE(PG8_SA(1, 0), cA + kstep, voffA); PG8_STAGE(PG8_SB(1, 1), cB + hstep + kstep, voffB);
    PG8_WAIT_V(6); PG8_BAR;
    for (;;) {
        const bool has_next = S.next(ui + 1, nxt);
        const char* nA = has_next ? (const char*)g.A + (size_t)nxt.pm * tstep : cA; const char* nB = has_next ? (const char*)g.Bt + (size_t)nxt.pn * tstep : cB;
        for (int t = 0; t < nt; t += 2) {
            const bool last = (t == nt - 2);
            const char* a1 = cA + (size_t)(t + 1) * kstep;
            const char* a2 = last ? nA : cA + (size_t)(t + 2) * kstep; const char* b2 = last ? nB : cB + (size_t)(t + 2) * kstep;
            const char* a3 = a2 + kstep; const char* b3 = b2 + kstep;
            if (last && has_next) S.a_ready(nxt);
            PG8_LDB(B0, 0, 0); PG8_LDB(B1, 0, 1); PG8_SCHED; PG8_LDA(At, 0, 0); PG8_STAGE(PG8_SA(1, 1), a1 + hstep, voffA);
            PG8_WAIT_V(8); PG8_WAIT_L(0); PG8_BAR; PG8_MMA(0, 0, At, B0); PG8_MMA(0, 1, At, B1); PG8_BAR; PG8_SCHED;
            PG8_LDA(At, 0, 1); PG8_STAGE(PG8_SB(0, 0), b2, voffB); PG8_STAGE(PG8_SB(0, 1), b2 + hstep, voffB); PG8_STAGE(PG8_SA(0, 0), a2, voffA);
            PG8_WAIT_V(8); PG8_WAIT_L(0); PG8_BAR; PG8_MMA(1, 0, At, B0); PG8_MMA(1, 1, At, B1); PG8_BAR; PG8_SCHED;
            PG8_LDB(B0, 1, 0); PG8_LDB(B1, 1, 1); PG8_SCHED; PG8_LDA(At, 1, 0); PG8_STAGE(PG8_SA(0, 1), a2 + hstep, voffA);
            PG8_WAIT_V(8); PG8_WAIT_L(0); PG8_BAR; PG8_MMA(0, 0, At, B0); PG8_MMA(0, 1, At, B1); PG8_BAR; PG8_SCHED;
            PG8_LDA(At, 1, 1); PG8_STAGE(PG8_SB(1, 0), b3, voffB); PG8_STAGE(PG8_SB(1, 1), b3 + hstep, voffB); PG8_STAGE(PG8_SA(1, 0), a3, voffA);
            PG8_WAIT_V(8); PG8_WAIT_L(0); PG8_BAR; PG8_MMA(1, 0, At, B0); PG8_MMA(1, 1, At, B1); PG8_BAR; PG8_SCHED;
        }
#ifndef PG8_NOALIGN
        if (wr == 0) PG8_BAR;
#endif
        if constexpr (Epi::PREFETCH) E.with_lds(acc, cur, wr, wc, fr, fq, lds + STAGE_BYTES + (ui & 1) * 2048); else E(acc, cur, wr, wc, fr, fq);
        S.done(cur);
        if (!has_next) break;
#pragma unroll
        for (int a = 0; a < 2; ++a)
#pragma unroll
            for (int b = 0; b < 2; ++b)
#pragma unroll
                for (int m = 0; m < 4; ++m)
#pragma unroll
                    for (int n = 0; n < 2; ++n) acc[a][b][m][n] = (f32x4){0.f, 0.f, 0.f, 0.f};
        cur = nxt; cA = nA; cB = nB; ++ui;
        if constexpr (Epi::PREFETCH) E.prefetch(lds + STAGE_BYTES + (ui & 1) * 2048, cur, tid, wid);
#ifndef PG8_NOALIGN
        if (wr == 1) PG8_BAR;
#endif
    }
    PG8_WAIT_V(0);
#ifdef PG8_NOALIGN
    if (wr == 0) PG8_BAR;
#endif
    PG8_BAR;
#undef PG8_SA
#undef PG8_SB
#undef PG8_STAGE
#undef PG8_LDA
#undef PG8_LDB
#undef PG8_MMA
#undef PG8_WAIT_V
#undef PG8_WAIT_L
#undef PG8_BAR
#undef PG8_SCHED
}
}
struct Ptrs {
    const float *x, *c, *w_mod, *b_mod, *g_attn, *w_in, *kv_norm_g, *w_uv, *g_out_a, *g_out_b, *w_out, *g_mlp, *w_up, *w_down, *rel_bias, *g_final;
    float* out; unsigned char* ws;
};

struct ConvDesc { const float* src; f16* dst; const float* ks0; const float* ks1; int N, K, Nvalid, tn, tk, bf; };
__device__ __forceinline__ void conv_load(const ConvDesc& d, int tid, float (&v)[8]) {
#pragma unroll
    for (int i = 0; i < 8; ++i) {
        const int kk = (tid >> 6) + 8 * i, k = d.tk * 64 + kk, n = d.tn * 64 + (tid & 63);
        float x = (n < d.Nvalid) ? d.src[(size_t)k * d.N + n] : 0.f;
        if (d.ks0) x *= (k < 512 ? d.ks0[k] : d.ks1[k - 512]);
        v[i] = x;
    }
}
__device__ __forceinline__ void conv_store(const ConvDesc& d, int tid, const float (&v)[8], float* T  ) {
#pragma unroll
    for (int i = 0; i < 8; ++i) T[((tid >> 6) + 8 * i) * 65 + (tid & 63)] = v[i];
    __syncthreads();
    { const int nn = tid >> 3, kc = (tid & 7) * 8; f16x8 o;
#pragma unroll
      for (int e = 0; e < 8; ++e) { const float x = T[(kc + e) * 65 + nn]; o[e] = d.bf ? cvt16<true>(x) : cvt16<false>(x); }
      *(f16x8*)(d.dst + (size_t)(d.tn * 64 + nn) * d.K + d.tk * 64 + kc) = o; }
    __syncthreads();
}
__device__ __forceinline__ int t5_bucket_dev(int rel) {
    const int n = rel < 0 ? -rel : rel; int bk;
    if (n < 8) bk = n; else if (n < 12) bk = 8; else if (n < 16) bk = 9; else if (n < 23) bk = 10; else if (n < 32) bk = 11; else if (n < 46) bk = 12; else if (n < 64) bk = 13; else if (n < 91) bk = 14; else bk = 15;
    return (rel > 0 ? 16 : 0) + bk;
}

__device__ __forceinline__ void prologue_phase(unsigned char* lds, const Ptrs& P, int G, int wg) {
    const int tid = ltid(), lane = tid & 63, wv = tid >> 6;
    unsigned char* ws = P.ws;
    float* T = (float*)lds;
    constexpr int T_IN = 52 * 16, T_OUT = 16 * 16, T_UP = 64 * 16, T_DN = 16 * 64, T_UV = 16, T_L = T_IN + T_OUT + T_UP + T_DN + T_UV;
    auto decode = [&](int u) -> ConvDesc {
        const int l = u / T_L; int r = u % T_L;
        if (r < T_IN) return ConvDesc{P.w_in + (size_t)l * DM * NPJ_VALID, (f16*)(ws + WS_WIN) + (size_t)l * NPJ * DM, nullptr, nullptr, NPJ_VALID, DM, NPJ_VALID, r / 16, r % 16, ALL_BF16};
        r -= T_IN;
        if (r < T_OUT) return ConvDesc{P.w_out + (size_t)l * DM * DM, (f16*)(ws + WS_WOUT) + (size_t)l * DM * DM, P.g_out_a + l * 512, P.g_out_b + l * 512, DM, DM, DM, r / 16, r % 16, ALL_BF16};
        r -= T_OUT;
        if (r < T_UP) return ConvDesc{P.w_up + (size_t)l * DM * FF, (f16*)(ws + WS_WUP) + (size_t)l * FF * DM, nullptr, nullptr, FF, DM, FF, r / 16, r % 16, MLP_BF16};
        r -= T_UP;
        if (r < T_DN) return ConvDesc{P.w_down + (size_t)l * FF * DM, (f16*)(ws + WS_WDN) + (size_t)l * DM * FF, nullptr, nullptr, DM, FF, DM, r / 64, r % 64, MLP_BF16};
        r -= T_DN;
        const int h = r >> 1;
        return ConvDesc{P.w_uv + ((size_t)l * 8 + h) * 128 * 64, (f16*)(ws + WS_WUV) + ((size_t)l * 8 + h) * 64 * 128, nullptr, nullptr, 64, 128, 64, 0, r & 1, 0};
    };
    {
        int u = wg; ConvDesc dc{}; float va[8], vb[8];
        if (u < 2 * T_L) { dc = decode(u); conv_load(dc, tid, va); }
        for (; u < 2 * T_L; u += G) {
            ConvDesc dn{}; const bool more = (u + G < 2 * T_L);
            if (more) { dn = decode(u + G); conv_load(dn, tid, vb); }
            conv_store(dc, tid, va, T);
            dc = dn;
#pragma unroll
            for (int i = 0; i < 8; ++i) va[i] = vb[i];
        }
    }
    { float* sq = (float*)(ws + WS_SSQ) + MT; for (size_t i = (size_t)wg * NTHR + tid; i < (size_t)3 * MT / 4; i += (size_t)G * NTHR) ((f32x4*)sq)[i] = (f32x4){0.f, 0.f, 0.f, 0.f}; }
    if (wg == G - 1) {
        float* BT = (float*)(ws + WS_BIAS);
        for (int i = tid; i < 8 * 2112; i += NTHR) { const int h = i / 2112, idx = i % 2112; const int bk = t5_bucket_dev(idx - 2047);
            BT[i] = (P.rel_bias[bk * 8 + h] - P.rel_bias[15 * 8 + h]) * LOG2E; }
    }
    __syncthreads();
    if (wg < 192) {
        float* SC = (float*)lds;
        float* RED = (float*)(lds + 65536);
        for (int i = tid; i < 16 * 1024; i += NTHR) { const int b = i >> 10, k = i & 1023; const float cv = P.c[i]; SC[k * 16 + b] = cv / (1.f + __expf(-cv)); }
        __syncthreads();
        for (int u = wg; u < 192; u += G) {
            const int l = u / 96, cb = u % 96, col = cb * 64 + lane;
            const float* wp = P.w_mod + (size_t)l * DM * 6144 + col;
            float acc[16];
#pragma unroll
            for (int b = 0; b < 16; ++b) acc[b] = 0.f;
            for (int k0 = wv * 128; k0 < wv * 128 + 128; k0 += 16) {
                float w16[16];
#pragma unroll
                for (int j = 0; j < 16; ++j) w16[j] = wp[(size_t)(k0 + j) * 6144];
#pragma unroll
                for (int j = 0; j < 16; ++j) { const int k = k0 + j; const float w = w16[j];
                    const f32x4 s0 = *(const f32x4*)(SC + k * 16), s1 = *(const f32x4*)(SC + k * 16 + 4), s2 = *(const f32x4*)(SC + k * 16 + 8), s3 = *(const f32x4*)(SC + k * 16 + 12);
#pragma unroll
                    for (int e = 0; e < 4; ++e) { acc[e] += s0[e] * w; acc[4 + e] += s1[e] * w; acc[8 + e] += s2[e] * w; acc[12 + e] += s3[e] * w; } }
            }
#pragma unroll
            for (int b = 0; b < 16; ++b) RED[(wv * 16 + b) * 64 + lane] = acc[b];
            __syncthreads();
            for (int i = tid; i < 1024; i += NTHR) { const int b = i >> 6, cc = i & 63; float s = P.b_mod[l * 6144 + cb * 64 + cc];
#pragma unroll
                for (int w8 = 0; w8 < 8; ++w8) s += RED[(w8 * 16 + b) * 64 + cc];
                ((float*)(ws + WS_MOD))[((size_t)l * 16 + b) * 6144 + cb * 64 + cc] = s; }
            __syncthreads();
        }
    }
}

__device__ __forceinline__ void final_norm_phase(const float* x, const float* gain, float* out, int G, int wg) {
    const int tid_ = ltid(); const int lane = tid_ & 63, wv = tid_ >> 6;
    const int step = G * NWAVES;
    int row = wg * NWAVES + wv;
    f32x4 g4[4];
#pragma unroll
    for (int i = 0; i < 4; ++i) g4[i] = *(const f32x4*)(gain + i * 256 + lane * 4);
    f32x4 nx[4];
    if (row < MT) {
#pragma unroll
        for (int i = 0; i < 4; ++i) nx[i] = *(const f32x4*)(x + (size_t)row * DM + lane * 4 + i * 256); }
    for (; row < MT; row += step) {
        f32x4 v[4];
#pragma unroll
        for (int i = 0; i < 4; ++i) v[i] = nx[i];
        if (row + step < MT) {
#pragma unroll
            for (int i = 0; i < 4; ++i) nx[i] = *(const f32x4*)(x + (size_t)(row + step) * DM + lane * 4 + i * 256); }
        float ss = 0.f;
#pragma unroll
        for (int i = 0; i < 4; ++i) ss += v[i][0] * v[i][0] + v[i][1] * v[i][1] + v[i][2] * v[i][2] + v[i][3] * v[i][3];
        ss = wave_sum(ss);
        const float rstd = rsqrtf(ss * (1.0f / DM) + EPS);
#pragma unroll
        for (int i = 0; i < 4; ++i) *(f32x4*)(out + (size_t)row * DM + i * 256 + lane * 4) = v[i] * rstd * g4[i];
    }
}

__device__ __forceinline__ void kvnorm_phase(unsigned char* lds, const f16* PROJ, const float* g, f16* KV, f16* KVT, int G, int wg) {
    const int tid = ltid();
    f16* T = (f16*)lds;
    for (int blk = wg; blk < MT / 64; blk += G) {
        const int tok = tid >> 3, ch = tid & 7; const size_t row = (size_t)blk * 64 + tok;
        const f16* p = PROJ + row * NPJ + C_DKV + ch * 16;
        const f16x8 a = *(const f16x8*)p, b = *(const f16x8*)(p + 8);
        float va[8], vb[8]; float ss = 0.f;
#pragma unroll
        for (int e = 0; e < 8; ++e) { va[e] = (float)a[e]; vb[e] = (float)b[e]; ss += va[e] * va[e] + vb[e] * vb[e]; }
        ss += __shfl_xor(ss, 4); ss += __shfl_xor(ss, 2); ss += __shfl_xor(ss, 1);
        const float rstd = rsqrtf(ss * (1.0f / 128.f) + EPS);
        f16x8 oa, ob;
#pragma unroll
        for (int e = 0; e < 8; ++e) { oa[e] = (f16)(va[e] * rstd * g[ch * 16 + e]); ob[e] = (f16)(vb[e] * rstd * g[ch * 16 + 8 + e]); }
        *(f16x8*)(KV + row * 128 + ch * 16) = oa; *(f16x8*)(KV + row * 128 + ch * 16 + 8) = ob;
        { const int tp = (tok & ~15) | kperm16(tok & 15);
#pragma unroll
        for (int e = 0; e < 8; ++e) { T[(ch * 16 + e) * 72 + tp] = oa[e]; T[(ch * 16 + 8 + e) * 72 + tp] = ob[e]; } }
        __syncthreads();
        { const int dim = tid >> 2, tc = (tid & 3) * 16; const int bb = (blk * 64) >> 11, t0 = (blk * 64) & 2047;
          const f16x8 x0 = *(const f16x8*)(T + dim * 72 + tc), x1 = *(const f16x8*)(T + dim * 72 + tc + 8);
          f16* q = KVT + ((size_t)bb * 128 + dim) * SEQ + t0 + tc;
          *(f16x8*)q = x0; *(f16x8*)(q + 8) = x1; }
        __syncthreads();
    }
}

__device__ __forceinline__ void prenorm0_phase(const float* x, const float* gain, const float* sc, f16* An, float* ssq, int G, int wg) {
    const int tid_ = ltid(); const int lane = tid_ & 63, wv = tid_ >> 6;
    const int step = G * NWAVES;
    int row = wg * NWAVES + wv;
    f32x4 g4[4];
#pragma unroll
    for (int i = 0; i < 4; ++i) g4[i] = *(const f32x4*)(gain + i * 256 + lane * 4);
    f32x4 nx[4];
    if (row < MT) {
#pragma unroll
        for (int i = 0; i < 4; ++i) nx[i] = *(const f32x4*)(x + (size_t)row * DM + lane * 4 + i * 256); }
    for (; row < MT; row += step) {
        const int b = row >> 11;
        f32x4 v[4], s4[4];
#pragma unroll
        for (int i = 0; i < 4; ++i) { v[i] = nx[i]; s4[i] = *(const f32x4*)(sc + (size_t)b * 6144 + i * 256 + lane * 4); }
        if (row + step < MT) {
#pragma unroll
            for (int i = 0; i < 4; ++i) nx[i] = *(const f32x4*)(x + (size_t)(row + step) * DM + lane * 4 + i * 256); }
        float ss = 0.f;
#pragma unroll
        for (int i = 0; i < 4; ++i) ss += v[i][0] * v[i][0] + v[i][1] * v[i][1] + v[i][2] * v[i][2] + v[i][3] * v[i][3];
        ss = wave_sum(ss);
        if (lane == 0) ssq[row] = ss;
#pragma unroll
        for (int i = 0; i < 4; ++i) { f16x4 o;
#pragma unroll
            for (int e = 0; e < 4; ++e) o[e] = cvt16<ALL_BF16 != 0>(v[i][e] * (g4[i][e] * (1.f + s4[i][e])));
            *(f16x4*)(An + (size_t)row * DM + i * 256 + lane * 4) = o; }
    }
}

__device__ __forceinline__ void bw_phase(unsigned char* lds, const Ptrs& P, const float* MOD, float* BW, int G, int wg) {
    const int tid = ltid(), lane = tid & 63, wv = tid >> 6;
    float* SH = (float*)lds;
    float* RED = (float*)(lds + 65536);
    for (int u = wg; u < 2 * 116; u += G) {
        const int l = u / 116, r = u % 116, site = (r < 52) ? 0 : 1, cb = (site == 0) ? r : r - 52;
        const int N = (site == 0) ? NPJ_VALID : FF;
        const float* W = (site == 0) ? P.w_in + (size_t)l * DM * NPJ_VALID : P.w_up + (size_t)l * DM * FF;
        const float* shp = MOD + (size_t)l * 16 * 6144 + (site == 0 ? 0 : 3) * DM;
        __syncthreads();
        for (int i = tid; i < 16 * 1024; i += NTHR) { const int b = i >> 10, k = i & 1023; SH[k * 16 + b] = shp[(size_t)b * 6144 + k]; }
        __syncthreads();
        const int col = cb * 64 + lane; const bool ok = col < N;
        const float* wp = W + (ok ? col : 0);
        float acc[16];
#pragma unroll
        for (int b = 0; b < 16; ++b) acc[b] = 0.f;
        for (int k0 = wv * 128; k0 < wv * 128 + 128; k0 += 16) {
            float w16[16];
#pragma unroll
            for (int j = 0; j < 16; ++j) w16[j] = ok ? wp[(size_t)(k0 + j) * N] : 0.f;
#pragma unroll
            for (int j = 0; j < 16; ++j) { const int k = k0 + j; const float w = w16[j];
                const f32x4 s0 = *(const f32x4*)(SH + k * 16), s1 = *(const f32x4*)(SH + k * 16 + 4), s2 = *(const f32x4*)(SH + k * 16 + 8), s3 = *(const f32x4*)(SH + k * 16 + 12);
#pragma unroll
                for (int e = 0; e < 4; ++e) { acc[e] += s0[e] * w; acc[4 + e] += s1[e] * w; acc[8 + e] += s2[e] * w; acc[12 + e] += s3[e] * w; } }
        }
#pragma unroll
        for (int b = 0; b < 16; ++b) RED[(wv * 16 + b) * 64 + lane] = acc[b];
        __syncthreads();
        for (int i = tid; i < 1024; i += NTHR) { const int b = i >> 6, cc = i & 63; float s = 0.f;
#pragma unroll
            for (int w8 = 0; w8 < 8; ++w8) s += RED[(w8 * 16 + b) * 64 + cc];
            BW[(((size_t)l * 2 + site) * 16 + b) * 4096 + cb * 64 + cc] = s; }
    }
    __syncthreads();
}

__device__ __forceinline__ void vtrans_phase(unsigned char* lds, const f16* PROJ, f16* VTA, int G, int wg) {
    const int tid = ltid();
    f16* T = (f16*)lds;
    const int tok = tid >> 3, ch = tid & 7;
    const int tp = (tok & ~15) | kperm16(tok & 15);
    auto src = [&](int blk) { const int bh = blk >> 5, tb = blk & 31, b = bh >> 3, h = bh & 7; return PROJ + ((size_t)b * SEQ + tb * 64 + tok) * NPJ + C_SBV + h * 64 + ch * 8; };
    int blk = wg;
    f16x8 vn = {0, 0, 0, 0, 0, 0, 0, 0};
    if (blk < 16 * 8 * 32) vn = *(const f16x8*)src(blk);
    for (; blk < 16 * 8 * 32; blk += G) {
        const int bh = blk >> 5, tb = blk & 31;
        const f16x8 v = vn;
        if (blk + G < 16 * 8 * 32) vn = *(const f16x8*)src(blk + G);
#pragma unroll
        for (int e = 0; e < 8; ++e) T[(ch * 8 + e) * 72 + tp] = v[e];
        __syncthreads();
        { const int dim = tid >> 3, kc = (tid & 7) * 8;
          *(f16x8*)(VTA + ((size_t)bh * 64 + dim) * SEQ + tb * 64 + kc) = *(const f16x8*)(T + dim * 72 + kc); }
        __syncthreads();
    }
}

#define SB_LOAD(KF, VF, HT) do { const int _ht = (HT) < 0 ? 0 : (HT); \
    _Pragma("unroll") for (int s = 0; s < 4; ++s) KF[s] = *(const f16x8*)(kp + (size_t)_ht * 32 * NPJ + 16 * s); \
    _Pragma("unroll") for (int d = 0; d < 2; ++d) _Pragma("unroll") for (int s = 0; s < 2; ++s) VF[d][s] = *(const f16x8*)(vp + (size_t)d * 32 * SEQ + _ht * 32 + 16 * s); } while (0)

#define SB_COMPUTE(KF, VF, HT) do { \
    f32x16 S; _Pragma("unroll") for (int r = 0; r < 16; ++r) S[r] = 0.f; \
    _Pragma("unroll") for (int s = 0; s < 4; ++s) S = __builtin_amdgcn_mfma_f32_32x32x16_f16(KF[s], qf[s], S, 0, 0, 0); \
    f32x16 om; \
    _Pragma("unroll") for (int r = 0; r < 16; ++r) { \
        const float zc = __builtin_amdgcn_fmed3f(S[r], -640.f, 640.f);                    \
        const float e1 = __builtin_amdgcn_exp2f(zc * (-0.125f * LOG2E));                  \
        const float be = __builtin_amdgcn_rcpf(1.0f + e1);                                \
        S[r] = be; om[r] = e1 * be; }                                                      \
    if ((HT) == rb) {                                                                      \
        const int kb = (HT) * 32 + 4 * hh; \
        _Pragma("unroll") for (int r = 0; r < 16; ++r) { const int key = kb + 8 * (r >> 2) + (r & 3); if (key >= q) { S[r] = 0.f; om[r] = 1.0f; } } } \
    float R = C; \
    _Pragma("unroll") for (int g = 3; g >= 0; --g) { \
        const float o0 = om[4 * g], o1 = om[4 * g + 1], o2 = om[4 * g + 2], o3 = om[4 * g + 3]; \
        const float gown = (o0 * o1) * (o2 * o3); \
        const float gp = __shfl_xor(gown, 32); \
        const float pre = hh ? R : R * gp; \
        const float p3 = pre, p2 = p3 * o3, p1 = p2 * o2, p0 = p1 * o1; \
        S[4 * g + 3] *= p3; S[4 * g + 2] *= p2; S[4 * g + 1] *= p1; S[4 * g] *= p0; \
        R = R * gown * gp; } \
    C = R; \
    f16x8 pf[2]; \
    _Pragma("unroll") for (int s = 0; s < 2; ++s) _Pragma("unroll") for (int e = 0; e < 8; ++e) pf[s][e] = (f16)S[8 * s + e]; \
    _Pragma("unroll") for (int d = 0; d < 2; ++d) _Pragma("unroll") for (int s = 0; s < 2; ++s) accO[d] = __builtin_amdgcn_mfma_f32_32x32x16_f16(VF[d][s], pf[s], accO[d], 0, 0, 0); \
    } while (0)

__device__ __forceinline__ void sb_attn_phase(unsigned char* lds, const f16* PROJ, const f16* VTA, f16* OBUF, int G, int wg) {
    const int tid = ltid(), lane = tid & 63, wv = tid >> 6, l32 = lane & 31, hh = lane >> 5;
    float* RED = (float*)(lds + 73728);
    int par = 0;
    f16x8 qn[4], kA[4], vA[2][2], kB[4], vB[2][2];
#define SB_UNIT_LOAD(U) do { const int _b = 2 * ((U) & 7) + (((U) >> 3) & 1), _rb = 63 - ((U) >> 4), _bh = _b * 8 + wv; const size_t _rw = (size_t)_b * SEQ; \
        const f16* _qp = PROJ + (_rw + _rb * 32 + l32) * NPJ + C_SBQ + wv * 64 + hh * 8; \
        _Pragma("unroll") for (int s = 0; s < 4; ++s) qn[s] = *(const f16x8*)(_qp + 16 * s); \
        const f16* kp = PROJ + (_rw + l32) * NPJ + C_SBK + wv * 64 + hh * 8; const f16* vp = VTA + ((size_t)_bh * 64 + l32) * SEQ + 8 * hh; \
        SB_LOAD(kA, vA, _rb); } while (0)
    if (wg < 1024) SB_UNIT_LOAD(wg);
    for (int u = wg; u < 1024; u += G, par ^= 1) {
        const int b = 2 * (u & 7) + ((u >> 3) & 1), rb = 63 - (u >> 4), h = wv, bh = b * 8 + h;
        const size_t rowbase = (size_t)b * SEQ;
        const int r0 = rb * 32, q = r0 + l32;
        f16x8 qf[4];
#pragma unroll
        for (int s = 0; s < 4; ++s) qf[s] = qn[s];
        const f16* kp = PROJ + (rowbase + l32) * NPJ + C_SBK + h * 64 + hh * 8;
        const f16* vp = VTA + ((size_t)bh * 64 + l32) * SEQ + 8 * hh;
        f32x16 accO[2];
#pragma unroll
        for (int d = 0; d < 2; ++d)
#pragma unroll
            for (int r = 0; r < 16; ++r) accO[d][r] = 0.f;
        float C = 1.0f;
        int ht = rb;
        for (;;) {
            SB_LOAD(kB, vB, ht - 1);
            SB_COMPUTE(kA, vA, ht);
            if (ht == 0 || __ballot(C >= 2.9e-8f) == 0ull) break;
            --ht;
            SB_LOAD(kA, vA, ht - 1);
            SB_COMPUTE(kB, vB, ht);
            if (ht == 0 || __ballot(C >= 2.9e-8f) == 0ull) break;
            --ht;
        }
        if (u + G < 1024) SB_UNIT_LOAD(u + G);
        float ssq = 0.f;
#pragma unroll
        for (int d = 0; d < 2; ++d)
#pragma unroll
            for (int r = 0; r < 16; ++r) ssq += accO[d][r] * accO[d][r];
        ssq += __shfl_xor(ssq, 32);
        if (hh == 0) RED[(par * 8 + wv) * 32 + l32] = ssq;
        __syncthreads();
        float tot = 0.f;
#pragma unroll
        for (int w8 = 0; w8 < 8; ++w8) tot += RED[(par * 8 + w8) * 32 + l32];
        const float rstd = rsqrtf(tot * (1.0f / 512.f) + EPS);
        { f16* op = OBUF + (rowbase + q) * DM + h * 64 + 4 * hh;
#pragma unroll
          for (int d = 0; d < 2; ++d)
#pragma unroll
            for (int g = 0; g < 4; ++g) { f16x4 o; o[0] = cvt16<ALL_BF16 != 0>(accO[d][4 * g] * rstd); o[1] = cvt16<ALL_BF16 != 0>(accO[d][4 * g + 1] * rstd); o[2] = cvt16<ALL_BF16 != 0>(accO[d][4 * g + 2] * rstd); o[3] = cvt16<ALL_BF16 != 0>(accO[d][4 * g + 3] * rstd);
                *(f16x4*)(op + 32 * d + 8 * g) = o; } }
    }
}
constexpr int IDX_PITCH = 2052;
__device__ __forceinline__ unsigned radix_scan(const unsigned* hist, int lane, unsigned& digit, unsigned& rank) {
    const u32x4 b = *(const u32x4*)(hist + 4 * lane);
    const unsigned s = b[0] + b[1] + b[2] + b[3];
    unsigned p = s;
    p += (unsigned)__builtin_amdgcn_update_dpp(0, (int)p, 0x101, 0xf, 0xf, true);
    p += (unsigned)__builtin_amdgcn_update_dpp(0, (int)p, 0x102, 0xf, 0xf, true);
    p += (unsigned)__builtin_amdgcn_update_dpp(0, (int)p, 0x104, 0xf, 0xf, true);
    p += (unsigned)__builtin_amdgcn_update_dpp(0, (int)p, 0x108, 0xf, 0xf, true);
    { const unsigned t1 = __builtin_amdgcn_readlane(p, 16), t2 = __builtin_amdgcn_readlane(p, 32), t3 = __builtin_amdgcn_readlane(p, 48);
      p += (lane < 16) ? (t1 + t2 + t3) : (lane < 32) ? (t2 + t3) : (lane < 48) ? t3 : 0u; }
    const unsigned long long ge = __ballot(p >= rank);
    const int L = __popcll(ge) - 1;
    const unsigned pL = __builtin_amdgcn_readlane(p, L), sL = __builtin_amdgcn_readlane(s, L);
    unsigned r = rank - (pL - sL);
    const unsigned b3 = __builtin_amdgcn_readlane(b[3], L), b2 = __builtin_amdgcn_readlane(b[2], L), b1 = __builtin_amdgcn_readlane(b[1], L);
    unsigned k = 3, bc = b3;
    if (r > b3) { r -= b3; k = 2; bc = b2; if (r > b2) { r -= b2; k = 1; bc = b1; if (r > b1) { r -= b1; k = 0; bc = __builtin_amdgcn_readlane(b[0], L); } } }
    digit = 4u * (unsigned)L + k; rank = r; return bc;
}
template <int NJ> __device__ __forceinline__ unsigned topk_words_exact(const float* row, int nadm, int lane, unsigned* hist, unsigned* hist_dummy) {
    unsigned uk[NJ];
#pragma unroll
    for (int j = 0; j < NJ; ++j) {
        const int key = 64 * j + lane;
        unsigned bits = 0u;
        if (key < nadm) { bits = __float_as_uint(row[key]); bits ^= (unsigned)(((int)bits >> 31) | 0x80000000); }
        uk[j] = bits;
    }
    unsigned rank = 256u, T = 0u, dg;
    unsigned* dummy = hist_dummy + lane;
    *(u32x4*)(hist + 4 * lane) = (u32x4){0u, 0u, 0u, 0u};
#pragma unroll
    for (int j = 0; j < NJ; ++j) __hip_atomic_fetch_add(hist + (uk[j] >> 24), 1u, __ATOMIC_RELAXED, __HIP_MEMORY_SCOPE_WORKGROUP);
    unsigned binc = radix_scan(hist, lane, dg, rank); T = dg << 24;
#pragma unroll
    for (int lv = 1; lv < 4; ++lv) {
        const int sh = 24 - 8 * lv;
        if (binc == rank) break;
        *(u32x4*)(hist + 4 * lane) = (u32x4){0u, 0u, 0u, 0u};
        const unsigned pre = T >> (sh + 8);
#pragma unroll
        for (int j = 0; j < NJ; ++j) { unsigned* dst = ((uk[j] >> (sh + 8)) == pre) ? hist + ((uk[j] >> sh) & 255u) : dummy;
            __hip_atomic_fetch_add(dst, 1u, __ATOMIC_RELAXED, __HIP_MEMORY_SCOPE_WORKGROUP); }
        binc = radix_scan(hist, lane, dg, rank); T |= dg << sh;
    }
    unsigned word = 0u;
    if (binc == rank) {
#pragma unroll
        for (int j = 0; j < NJ; ++j) {
            const unsigned long long sel = __ballot(uk[j] >= T);
            asm volatile("s_nop 3\n\tv_writelane_b32 %0, %1, %3\n\tv_writelane_b32 %0, %2, %4" : "+v"(word) : "s"((unsigned)sel), "s"((unsigned)(sel >> 32)), "n"(2 * j), "n"(2 * j + 1));
        }
    } else {
        int need = (int)rank;
#pragma unroll
        for (int j = 0; j < NJ; ++j) {
            unsigned long long sel = __ballot(uk[j] > T);
            unsigned long long em = __ballot(uk[j] == T);
            if (need > 0 && em != 0ull) {
                const int pc = __popcll(em);
                if (pc <= need) { sel |= em; need -= pc; }
                else { unsigned long long keep = 0ull; for (int i = 0; i < need; ++i) { const unsigned long long lowb = em & (0ull - em); keep |= lowb; em ^= lowb; } sel |= keep; need = 0; }
            }
            asm volatile("s_nop 3\n\tv_writelane_b32 %0, %1, %3\n\tv_writelane_b32 %0, %2, %4" : "+v"(word) : "s"((unsigned)sel), "s"((unsigned)(sel >> 32)), "n"(2 * j), "n"(2 * j + 1));
        }
    }
    return word;
}
__device__ __forceinline__ unsigned radix_scan_up(const unsigned* hist, int lane, unsigned& digit, unsigned& rank) {
    const u32x4 b = *(const u32x4*)(hist + 4 * lane);
    const unsigned s = b[0] + b[1] + b[2] + b[3];
    unsigned p = s;
    p += (unsigned)__builtin_amdgcn_update_dpp(0, (int)p, 0x111, 0xf, 0xf, true);
    p += (unsigned)__builtin_amdgcn_update_dpp(0, (int)p, 0x112, 0xf, 0xf, true);
    p += (unsigned)__builtin_amdgcn_update_dpp(0, (int)p, 0x114, 0xf, 0xf, true);
    p += (unsigned)__builtin_amdgcn_update_dpp(0, (int)p, 0x118, 0xf, 0xf, true);
    p += (unsigned)__builtin_amdgcn_update_dpp(0, (int)p, 0x142, 0xa, 0xf, false);
    p += (unsigned)__builtin_amdgcn_update_dpp(0, (int)p, 0x143, 0xc, 0xf, false);
    const unsigned long long ge = __ballot(p >= rank) | (1ull << 63);
    const int L = __builtin_ctzll(ge);
    const unsigned pL = __builtin_amdgcn_readlane(p, L), sL = __builtin_amdgcn_readlane(s, L);
    unsigned r = rank - (pL - sL);
    const unsigned b0 = __builtin_amdgcn_readlane(b[0], L), b1 = __builtin_amdgcn_readlane(b[1], L), b2 = __builtin_amdgcn_readlane(b[2], L);
    unsigned k = 0, bc = b0;
    if (r > b0) { r -= b0; k = 1; bc = b1; if (r > b1) { r -= b1; k = 2; bc = b2; if (r > b2) { r -= b2; k = 3; bc = __builtin_amdgcn_readlane(b[3], L); } } }
    digit = 4u * (unsigned)L + k; rank = r; return bc;
}
__device__ __forceinline__ void wave_max_min(float& a, float& b) {
    asm("s_nop 1\n\t"
        "v_max_f32_dpp %0, %0, %0 quad_perm:[1,0,3,2] row_mask:0xf bank_mask:0xf\n\tv_min_f32_dpp %1, %1, %1 quad_perm:[1,0,3,2] row_mask:0xf bank_mask:0xf\n\ts_nop 0\n\t"
        "v_max_f32_dpp %0, %0, %0 quad_perm:[2,3,0,1] row_mask:0xf bank_mask:0xf\n\tv_min_f32_dpp %1, %1, %1 quad_perm:[2,3,0,1] row_mask:0xf bank_mask:0xf\n\ts_nop 0\n\t"
        "v_max_f32_dpp %0, %0, %0 row_half_mirror row_mask:0xf bank_mask:0xf\n\tv_min_f32_dpp %1, %1, %1 row_half_mirror row_mask:0xf bank_mask:0xf\n\ts_nop 0\n\t"
        "v_max_f32_dpp %0, %0, %0 row_mirror row_mask:0xf bank_mask:0xf\n\tv_min_f32_dpp %1, %1, %1 row_mirror row_mask:0xf bank_mask:0xf\n\ts_nop 0\n\t"
        "v_max_f32_dpp %0, %0, %0 row_bcast:15 row_mask:0xa bank_mask:0xf\n\tv_min_f32_dpp %1, %1, %1 row_bcast:15 row_mask:0xa bank_mask:0xf\n\ts_nop 0\n\t"
        "v_max_f32_dpp %0, %0, %0 row_bcast:31 row_mask:0xc bank_mask:0xf\n\tv_min_f32_dpp %1, %1, %1 row_bcast:31 row_mask:0xc bank_mask:0xf\n\ts_nop 1"
        : "+v"(a), "+v"(b));
    a = __int_as_float(__builtin_amdgcn_readlane(__float_as_int(a), 63));
    b = __int_as_float(__builtin_amdgcn_readlane(__float_as_int(b), 63));
}
template <int NJ> __device__ __forceinline__ unsigned topk_words(const float* row, int nadm, int lane, unsigned* hist, bool& ok) {
    const int nja = nadm >> 6;
    unsigned v[NJ];
    {
        float x[NJ];
#pragma unroll
        for (int j = 0; j < NJ; ++j) x[j] = row[64 * j + lane];
        float mx = x[0], mn = x[0];
#pragma unroll
        for (int j = 1; j < NJ; ++j) { const float xx = (j < NJ - 8 || j < nja) ? x[j] : x[0]; mx = __builtin_fmaxf(mx, xx); mn = __builtin_fminf(mn, xx); }
        wave_max_min(mx, mn);
        const float R = mx - mn;
        const float sc = (R > 1e-30f && __builtin_fabsf(mx) <= 8.0f * R) ? 16777000.0f * __builtin_amdgcn_rcpf(R) : 0.f;
        const float cc = __builtin_fmaf(mx, sc, 16.0f);
        const f32x2 ns2 = {-sc, -sc}, cc2 = {cc, cc};
#pragma unroll
        for (int j = 0; j < NJ; j += 2) {
            const f32x2 xp = {x[j], x[j + 1]};
            const f32x2 t = __builtin_elementwise_fma(xp, ns2, cc2);
            v[j] = (j < NJ - 8 || j < nja) ? (unsigned)t[0] : 0xFFFFFFFFu;
            v[j + 1] = (j + 1 < NJ - 8 || j + 1 < nja) ? (unsigned)t[1] : 0xFFFFFFFFu;
        }
    }
    unsigned rank = 256u, base = 0u, U = 0u, dg, binc = 0u;
    const unsigned dcap = 256u + (unsigned)lane;
#pragma unroll
    for (int lv = 0; lv < 3; ++lv) {
        const int sh = 16 - 8 * lv;
        if (lv > 0 && binc == rank) break;
        *(u32x4*)(hist + 4 * lane) = (u32x4){0u, 0u, 0u, 0u};
#pragma unroll
        for (int j = 0; j < NJ; ++j) if (j < NJ - 8 || j < nja) {
            const unsigned d = (lv == 0) ? ((v[j] >> 16) & 255u) : min((v[j] - base) >> sh, dcap);
            __hip_atomic_fetch_add(hist + d, 1u, __ATOMIC_RELAXED, __HIP_MEMORY_SCOPE_WORKGROUP); }
        binc = radix_scan_up(hist, lane, dg, rank); base |= dg << sh; U = base + (1u << sh);
    }
    ok = (binc == rank);
    unsigned word = 0u;
#pragma unroll
    for (int j = 0; j < NJ; j += 4) {
        const unsigned long long s0 = __ballot(v[j] < U), s1 = __ballot(v[j + 1] < U), s2 = __ballot(v[j + 2] < U), s3 = __ballot(v[j + 3] < U);
        asm volatile("s_nop 3\n\tv_writelane_b32 %0, %1, %9\n\tv_writelane_b32 %0, %2, %10\n\tv_writelane_b32 %0, %3, %11\n\tv_writelane_b32 %0, %4, %12\n\t"
                     "v_writelane_b32 %0, %5, %13\n\tv_writelane_b32 %0, %6, %14\n\tv_writelane_b32 %0, %7, %15\n\tv_writelane_b32 %0, %8, %16"
                     : "+v"(word) : "s"((unsigned)s0), "s"((unsigned)(s0 >> 32)), "s"((unsigned)s1), "s"((unsigned)(s1 >> 32)), "s"((unsigned)s2), "s"((unsigned)(s2 >> 32)),
                       "s"((unsigned)s3), "s"((unsigned)(s3 >> 32)), "n"(2 * j), "n"(2 * j + 1), "n"(2 * j + 2), "n"(2 * j + 3), "n"(2 * j + 4), "n"(2 * j + 5), "n"(2 * j + 6), "n"(2 * j + 7));
    }
    return word;
}
__device__ __forceinline__ int idx_unit_qg(int u, int G) {
    if (G == 256) { const int j = (u & 255) >> 4, i = u >> 8; return (i & 1) ? 16 * (i - 1) + j : 127 - j - 16 * i; }
    return 127 - (u >> 4);
}
__device__ __forceinline__ void indexer_phase(unsigned char* lds, const f16* PROJ, unsigned* MASK, int G, int wg, bool do_topk) {
    const int tid = ltid(), lane = tid & 63, wv = tid >> 6, l16 = lane & 15, lq = lane >> 4;
    float* SCR = (float*)lds;
    unsigned* hist = (unsigned*)(lds + 136192) + wv * 320;
    unsigned* hdum = hist + 256;
    f16x8 qa[8][2]; f16x8 w8r[4]; f16x8 ka[4][2];
#define IDX_LOAD_UNIT(U) do { const int _b = 2 * ((U) & 7) + (((U) >> 3) & 1), _q0 = idx_unit_qg((U), G) * 16; const size_t _rb = (size_t)_b * SEQ; \
        const f16* _qp = PROJ + (_rb + _q0 + l16) * NPJ + C_IQ + lq * 8; \
        _Pragma("unroll") for (int hd = 0; hd < 8; ++hd) _Pragma("unroll") for (int s_ = 0; s_ < 2; ++s_) qa[hd][s_] = *(const f16x8*)(_qp + hd * 64 + 32 * s_); \
        _Pragma("unroll") for (int r = 0; r < 4; ++r) w8r[r] = *(const f16x8*)(PROJ + (_rb + _q0 + 4 * lq + r) * NPJ + C_IW); \
        const int _c0 = (((64 * ((_q0 >> 6) + 1)) >> 4) + 7) >> 3; const f16* _kb = PROJ + (_rb + wv * 16 + l16) * NPJ + C_IK + lq * 8; \
        _Pragma("unroll") for (int j = 0; j < 4; ++j) { const int _it = (j < _c0 - 1) ? j : _c0 - 1; const f16* _kp = _kb + (size_t)_it * (128 * NPJ); ka[j][0] = *(const f16x8*)_kp; ka[j][1] = *(const f16x8*)(_kp + 32); } } while (0)
    if (wg < MT / 16) IDX_LOAD_UNIT(wg);
    for (int u = wg; u < MT / 16; u += G) {
        const int b = 2 * (u & 7) + ((u >> 3) & 1), qg = idx_unit_qg(u, G);
        const int q0 = qg * 16; const size_t rowbase = (size_t)b * SEQ;
        const int nadm = 64 * ((q0 >> 6) + 1);
        float wq[4][8];
#pragma unroll
        for (int r = 0; r < 4; ++r)
#pragma unroll
            for (int hd = 0; hd < 8; ++hd) wq[r][hd] = (float)w8r[r][hd] * (0.35355339059327373f * 0.125f);
        const int ntile = nadm >> 4;
        const int c0 = (ntile + 7) >> 3, cnt = (c0 + 3) & ~3;
        const f16* kbase = PROJ + (rowbase + wv * 16 + l16) * NPJ + C_IK + lq * 8;
        for (int i = 0; i < cnt; i += 4) {
#pragma unroll
            for (int j = 0; j < 4; ++j) {
                const int it = (i + j < c0 - 1) ? i + j : c0 - 1;
                f32x4 sc = {0.f, 0.f, 0.f, 0.f};
                f32x4 a[8];
#pragma unroll
                for (int hd = 0; hd < 8; ++hd) { a[hd] = (f32x4){0.f, 0.f, 0.f, 0.f}; a[hd] = __builtin_amdgcn_mfma_f32_16x16x32_f16(qa[hd][0], ka[j][0], a[hd], 0, 0, 0); }
#pragma unroll
                for (int hd = 0; hd < 8; ++hd) a[hd] = __builtin_amdgcn_mfma_f32_16x16x32_f16(qa[hd][1], ka[j][1], a[hd], 0, 0, 0);
                __builtin_amdgcn_sched_barrier(0);
#pragma unroll
                for (int hd = 0; hd < 8; ++hd)
#pragma unroll
                    for (int r = 0; r < 4; ++r) { const int bi = __float_as_int(a[hd][r]); sc[r] += wq[r][hd] * __int_as_float(bi > 0 ? bi : 0); }
                { const int itn = (i + j + 4 < c0 - 1) ? i + j + 4 : c0 - 1; const f16* kp = kbase + (size_t)itn * (128 * NPJ); ka[j][0] = *(const f16x8*)kp; ka[j][1] = *(const f16x8*)(kp + 32); }
#pragma unroll
                for (int r = 0; r < 4; ++r) SCR[(4 * lq + r) * IDX_PITCH + (wv + 8 * it) * 16 + l16] = sc[r] + 0.0f;
            }
        }
        __syncthreads();
        if (u + G < MT / 16) IDX_LOAD_UNIT(u + G);
#ifndef TOPK_REP
#define TOPK_REP 1
#endif
        if (do_topk) for (int qs = 0; qs < 2 * TOPK_REP; ++qs) {
            const int qq = 2 * wv + (qs & 1);
            unsigned* mrow = MASK + (rowbase + q0 + qq) * 64;
            unsigned word = 0u;
            if (nadm <= 256) {
                word = (lane * 32 < nadm) ? 0xFFFFFFFFu : 0u;
            } else {
                int lk = lane; asm volatile("" : "+v"(lk));
                unsigned* hk = hist + (lk - lane);
                const float* row = SCR + qq * IDX_PITCH;
                bool ok;
                if (nadm <= 512) word = topk_words<8>(row, nadm, lk, hk, ok);
                else if (nadm <= 1024) word = topk_words<16>(row, nadm, lk, hk, ok);
                else if (nadm <= 1536) word = topk_words<24>(row, nadm, lk, hk, ok);
                else word = topk_words<32>(row, nadm, lk, hk, ok);
                if (!ok) { int l2 = lane; asm volatile("" : "+v"(l2)); word = topk_words_exact<32>(row + (l2 - lane), nadm, l2, hk + (l2 - lane), hk + 256 + (l2 - lane)); }
            }
            mrow[lane] = word;
        }
        __syncthreads();
    }
}
__device__ __forceinline__ void dsa_attn_phase(unsigned char* lds, const f16* PROJ, const f16* KV, const f16* KVT, const unsigned* MASK, const float* BIAS2, const f16* WUVT, f16* OBUF, int G, int wg) {
    const int tid = ltid(), lane = tid & 63, wv = tid >> 6, l32 = lane & 31, hh = lane >> 5;
    f16* KlB = (f16*)lds;
    f16* VlB = (f16*)(lds + 2 * 17408);
    const int hd = wv;
    const float c1 = 0.08838834764831845f * LOG2E;
    const int skey = tid >> 3, skc = (tid & 7) * 16, sdim = tid >> 2, sdc = (tid & 3) * 16;
    f16x8 qraw[8], k0, k1, t0, t1;
#define DSA_UNIT_BQ(U, B_, QI_) do { if (G == 256) { const int _j = wg >> 4, _i = (U) >> 8; B_ = 2 * (wg & 7) + ((wg >> 3) & 1);     QI_ = (_i == 0) ? 63 - _j : (_i == 1) ? 32 + _j : (_i == 2) ? 31 - _j : _j; } \
        else { B_ = (U) & 15; QI_ = 63 - ((U) >> 4); } } while (0)
#define DSA_LOAD_Q(B_, QI_) do { const f16* _qp = PROJ + ((size_t)(B_) * SEQ + (QI_) * 32 + l32) * NPJ + C_DQ + hd * 128 + hh * 8; \
        _Pragma("unroll") for (int s_ = 0; s_ < 8; ++s_) qraw[s_] = *(const f16x8*)(_qp + 16 * s_); } while (0)
#define DSA_LOAD_TILE0(U) do { int _b, _qi; DSA_UNIT_BQ(U, _b, _qi); const f16* _kv = KV + ((size_t)_b * SEQ + skey) * 128 + skc; const f16* _kt = KVT + ((size_t)_b * 128 + sdim) * SEQ + sdc; \
        k0 = *(const f16x8*)_kv; k1 = *(const f16x8*)(_kv + 8); t0 = *(const f16x8*)_kt; t1 = *(const f16x8*)(_kt + 8); } while (0)
    float* BL = (float*)(lds + 77824) + wv * 256;
    { const float* bsrc = BIAS2 + hd * 2112 + 2047 - 192;
#pragma unroll
      for (int i = 0; i < 4; ++i) BL[lane + 64 * i] = bsrc[lane + 64 * i]; }
    float* RED = (float*)(lds + 73728 + 2048);
    int par = 0;
    if (wg < 1024) DSA_LOAD_TILE0(wg);
    for (int u = wg; u < 1024; u += G, par ^= 1) {
        int b, qi; DSA_UNIT_BQ(u, b, qi);
        DSA_LOAD_Q(b, qi);
        const int q0 = qi * 32; const size_t rowbase = (size_t)b * SEQ;
        const int ntile = (q0 >> 6) + 1;
        f16x8 qf[8];
#pragma unroll
        for (int s = 0; s < 8; ++s)
#pragma unroll
            for (int e = 0; e < 8; ++e) qf[s][e] = (f16)((float)qraw[s][e] * c1);
        const unsigned* mrow = MASK + (rowbase + q0 + l32) * 64;
        u32x2 mwn = *(const u32x2*)mrow;
        const int q = q0 + l32;
        f32x16 accO[4];
#pragma unroll
        for (int d = 0; d < 4; ++d)
#pragma unroll
            for (int r = 0; r < 16; ++r) accO[d][r] = 0.f;
        float mrun = 0.f, lsum = 0.f;
        const f16* kvp = KV + (rowbase + skey) * 128 + skc;
        const f16* ktp = KVT + ((size_t)b * 128 + sdim) * SEQ + sdc;
        __syncthreads();
        { f16* Kw = KlB + skey * 136 + skc; f16* Vw = VlB + sdim * 72 + sdc;
          *(f16x8*)Kw = k0; *(f16x8*)(Kw + 8) = k1; *(f16x8*)Vw = t0; *(f16x8*)(Vw + 8) = t1; }
        __syncthreads();
        for (int kt = 0; kt < ntile; ++kt) {
            const f16* Kl = KlB + (kt & 1) * (64 * 136); const f16* Vl = VlB + (kt & 1) * (128 * 72);
            if (kt + 1 < ntile) { const f16* a = kvp + (size_t)(kt + 1) * 64 * 128; const f16* c = ktp + (kt + 1) * 64;
                k0 = *(const f16x8*)a; k1 = *(const f16x8*)(a + 8); t0 = *(const f16x8*)c; t1 = *(const f16x8*)(c + 8); }
            const u32x2 mw = mwn;
            if (kt + 1 < ntile) mwn = *(const u32x2*)(mrow + 2 * (kt + 1));
            const bool near = (kt * 64 + 63 + 96 > q0);
            const float* bp = BL + 192 - q + kt * 64 + 4 * hh;
            f32x16 S0, S1;
            { const float ninit = -mrun;
#pragma unroll
              for (int r = 0; r < 16; ++r) { S0[r] = ninit; S1[r] = ninit; } }
#define DSA_QK(SX, T_) do { _Pragma("unroll") for (int s4 = 0; s4 < 8; s4 += 4) { f16x8 kf[4]; \
                _Pragma("unroll") for (int s = 0; s < 4; ++s) kf[s] = *(const f16x8*)(Kl + (32 * (T_) + l32) * 136 + 16 * (s4 + s) + 8 * hh); \
                __builtin_amdgcn_sched_barrier(0); __builtin_amdgcn_s_setprio(1); \
                _Pragma("unroll") for (int s = 0; s < 4; ++s) SX = __builtin_amdgcn_mfma_f32_32x32x16_f16(kf[s], qf[s4 + s], SX, 0, 0, 0); __builtin_amdgcn_s_setprio(0); } } while (0)
#define DSA_SOFTMAX(SX, SOTHER, T_, PF) do { \
                if (near) { _Pragma("unroll") for (int g = 0; g < 4; ++g) _Pragma("unroll") for (int e = 0; e < 4; ++e) SX[4 * g + e] += bp[32 * (T_) + 8 * g + e]; } \
                float tmax = SX[0]; _Pragma("unroll") for (int r = 1; r < 16; ++r) tmax = fmaxf(tmax, SX[r]); \
                const bool first = (kt == 0 && (T_) == 0); \
                if (first || __ballot(tmax > 8.0f) != 0ull) { \
                    const float tm2 = fmaxf(tmax, __shfl_xor(tmax, 32)); \
                    const float delta = (first || tm2 > 8.0f) ? tm2 : 0.f; \
                    const float alpha = __builtin_amdgcn_exp2f(-delta); \
                    mrun += delta; lsum *= alpha; \
                    _Pragma("unroll") for (int r = 0; r < 16; ++r) { SX[r] -= delta; if ((T_) == 0) SOTHER[r] -= delta; }     \
                    _Pragma("unroll") for (int d = 0; d < 4; ++d) _Pragma("unroll") for (int r = 0; r < 16; ++r) accO[d][r] *= alpha; } \
                const unsigned wsh = ((T_) == 0 ? mw[0] : mw[1]) >> (4 * hh); \
                float ps = 0.f; \
                _Pragma("unroll") for (int r = 0; r < 16; ++r) { \
                    const float p = __builtin_amdgcn_exp2f(SX[r]); float pm; \
                    asm("v_bfe_i32 %0, %1, %2, 1\n\tv_and_b32 %0, %0, %3" : "=&v"(pm) : "v"(wsh), "n"(8 * (r >> 2) + (r & 3)), "v"(p)); \
                    SX[r] = pm; ps += pm; } \
                lsum += ps; \
                _Pragma("unroll") for (int s = 0; s < 2; ++s) _Pragma("unroll") for (int e = 0; e < 8; ++e) PF[s][e] = (f16)SX[8 * s + e]; } while (0)
#define DSA_PV(PF, T_) do { _Pragma("unroll") for (int d2 = 0; d2 < 4; d2 += 2) { f16x8 vf[2][2]; \
                _Pragma("unroll") for (int d = 0; d < 2; ++d) _Pragma("unroll") for (int s = 0; s < 2; ++s) vf[d][s] = *(const f16x8*)(Vl + (32 * (d2 + d) + l32) * 72 + 32 * (T_) + 16 * s + 8 * hh); \
                __builtin_amdgcn_sched_barrier(0); __builtin_amdgcn_s_setprio(1); \
                _Pragma("unroll") for (int d = 0; d < 2; ++d) _Pragma("unroll") for (int s = 0; s < 2; ++s) accO[d2 + d] = __builtin_amdgcn_mfma_f32_32x32x16_f16(vf[d][s], PF[s], accO[d2 + d], 0, 0, 0); __builtin_amdgcn_s_setprio(0); } } while (0)
            DSA_QK(S0, 0); DSA_QK(S1, 1);
            { f16x8 pf0[2]; DSA_SOFTMAX(S0, S1, 0, pf0); DSA_PV(pf0, 0); }
            { f16x8 pf1[2]; DSA_SOFTMAX(S1, S0, 1, pf1); DSA_PV(pf1, 1); }
#undef DSA_QK
#undef DSA_SOFTMAX
#undef DSA_PV
            if (kt + 1 < ntile) { f16* Kw = KlB + ((kt + 1) & 1) * (64 * 136) + skey * 136 + skc; f16* Vw = VlB + ((kt + 1) & 1) * (128 * 72) + sdim * 72 + sdc;
                *(f16x8*)Kw = k0; *(f16x8*)(Kw + 8) = k1; *(f16x8*)Vw = t0; *(f16x8*)(Vw + 8) = t1; }
            __syncthreads();
        }
        if (u + G < 1024) DSA_LOAD_TILE0(u + G);
        int l32e = l32, hhe = hh; asm volatile("" : "+v"(l32e), "+v"(hhe));
        const float ltot = lsum + __shfl_xor(lsum, 32);
        const float inv = 1.0f / ltot;
        f32x16 Z[2];
#pragma unroll
        for (int n = 0; n < 2; ++n)
#pragma unroll
            for (int r = 0; r < 16; ++r) Z[n][r] = 0.f;
#pragma unroll
        for (int dh = 0; dh < 2; ++dh) {
            f16x4 wlo[2][2][2], whi[2][2][2];
#pragma unroll
            for (int d = 0; d < 2; ++d)
#pragma unroll
                for (int s = 0; s < 2; ++s)
#pragma unroll
                    for (int n = 0; n < 2; ++n) {
                        const f16* wp = WUVT + ((size_t)hd * 64 + 32 * n + l32e) * 128 + 32 * (2 * dh + d) + 16 * s + 4 * hhe;
                        wlo[d][s][n] = *(const f16x4*)wp; whi[d][s][n] = *(const f16x4*)(wp + 8);
                    }
#pragma unroll
            for (int d = 0; d < 2; ++d)
#pragma unroll
                for (int s = 0; s < 2; ++s) {
                    f16x8 ob;
#pragma unroll
                    for (int e = 0; e < 8; ++e) ob[e] = (f16)(accO[2 * dh + d][8 * s + e] * inv);
#pragma unroll
                    for (int n = 0; n < 2; ++n) {
                        const f16x4 lo = wlo[d][s][n], hi = whi[d][s][n];
                        f16x8 wa; wa[0] = lo[0]; wa[1] = lo[1]; wa[2] = lo[2]; wa[3] = lo[3]; wa[4] = hi[0]; wa[5] = hi[1]; wa[6] = hi[2]; wa[7] = hi[3];
                        Z[n] = __builtin_amdgcn_mfma_f32_32x32x16_f16(wa, ob, Z[n], 0, 0, 0);
                    }
                }
        }
        float ssq = 0.f;
#pragma unroll
        for (int n = 0; n < 2; ++n)
#pragma unroll
            for (int r = 0; r < 16; ++r) ssq += Z[n][r] * Z[n][r];
        ssq += __shfl_xor(ssq, 32);
        if (hh == 0) RED[(par * 8 + wv) * 32 + l32] = ssq;
        __syncthreads();
        float tot = 0.f;
#pragma unroll
        for (int w8 = 0; w8 < 8; ++w8) tot += RED[(par * 8 + w8) * 32 + l32];
        const float rstd = rsqrtf(tot * (1.0f / 512.f) + EPS);
        { f16* op = OBUF + (rowbase + q0 + l32e) * DM + 512 + hd * 64 + 4 * hhe;
#pragma unroll
          for (int n = 0; n < 2; ++n)
#pragma unroll
            for (int g = 0; g < 4; ++g) { f16x4 o; o[0] = cvt16<ALL_BF16 != 0>(Z[n][4 * g] * rstd); o[1] = cvt16<ALL_BF16 != 0>(Z[n][4 * g + 1] * rstd); o[2] = cvt16<ALL_BF16 != 0>(Z[n][4 * g + 2] * rstd); o[3] = cvt16<ALL_BF16 != 0>(Z[n][4 * g + 3] * rstd);
                *(f16x4*)(op + 32 * n + 8 * g) = o; } }
    }
}
constexpr int N_PHASES = 15;
struct Args { Ptrs p; int ph_lo, ph_hi; };

__global__ void __launch_bounds__(NTHR, 2) trunk_fwd(Args args) {
    extern __shared__ __attribute__((aligned(16))) unsigned char lds[];
    const Ptrs& P = args.p;
    unsigned char* ws = P.ws;
    const int G = gridDim.x, wg = blockIdx.x, tid = threadIdx.x;
    const int lo = args.ph_lo, hi = args.ph_hi;
    const bool multi = (hi - lo) > 1;
    XcdBarrier bar; bar.bar = (unsigned*)(ws + WS_CTL); bar.x = 0; bar.st = nullptr;
    if (multi) {
        if (tid < 4) ((LAS unsigned*)(lds + LDS_MISC))[tid] = 0u;
        __syncthreads();
        bar = xcd_barrier_post((unsigned*)(ws + WS_CTL), (volatile LAS unsigned*)(lds + LDS_MISC));
    }
#ifndef REP_IDX
#define REP_IDX 1
#endif
#ifndef REP_IDX_SCORE_ONLY
#define REP_IDX_SCORE_ONLY 0
#endif
#ifndef REP_SB
#define REP_SB 1
#endif
#ifndef REP_DSA
#define REP_DSA 1
#endif
#ifndef REP_GIN
#define REP_GIN 1
#endif
#ifndef REP_GUP
#define REP_GUP 1
#endif
#ifndef PHMASK
#define PHMASK 0xFFFFF
#endif
#ifndef PHASE_AMP
#define PHASE_AMP (-1)
#endif
#define IN(k) (lo <= (k) && (k) < hi)
#define AMPB(k) long long _ta = 0; if (PHASE_AMP == (k)) _ta = (long long)__builtin_amdgcn_s_memtime();
#define AMPE(k) if (PHASE_AMP == (k)) { const long long _tb = (long long)__builtin_amdgcn_s_memtime(); while ((long long)__builtin_amdgcn_s_memtime() - _tb < (_tb - _ta)) __builtin_amdgcn_s_sleep(8); }
#define PM(j) ((PHMASK >> (j)) & 1)
#define SEAM(k) do { if (IN(k) && IN((k) + 1)) xcd_barrier(bar); } while (0)
    float* MOD = (float*)(ws + WS_MOD);
    f16* H = (f16*)(ws + WS_H); f16* PROJ = (f16*)(ws + WS_PROJ); f16* OBUF = (f16*)(ws + WS_OBUF); f16* HID = (f16*)(ws + WS_HID);
    f16* KV = (f16*)(ws + WS_KV); f16* KVT = (f16*)(ws + WS_KVT); f16* VTA = (f16*)(ws + WS_VTA); unsigned* MASK = (unsigned*)(ws + WS_MASK);
    float* X = P.out;

    float* SSQ = (float*)(ws + WS_SSQ); float* BW = (float*)(ws + WS_BW);
    if (PM(0) && IN(0)) { AMPB(0) prologue_phase(lds, P, G, wg); AMPE(0) SEAM(0); }
    if (PM(1) && IN(1)) { AMPB(1)
        bw_phase(lds, P, MOD, BW, G, wg);
        prenorm0_phase(P.x, P.g_attn, MOD + 1 * DM, H, SSQ, G, wg);
        AMPE(1) SEAM(1);
    }

    for (int l = 0; l < NLAYER; ++l) {
        const int pb = 2 + 6 * l;
        const float* modl = MOD + (size_t)l * 16 * 6144;
        const float* xin = (l == 0) ? P.x : X;
        const float* ssq1 = SSQ + (size_t)(l == 0 ? 0 : 2) * MT;
        float* ssq2 = SSQ + (size_t)(l == 0 ? 1 : 3) * MT;
        if (PM(2) && IN(pb + 0)) { AMPB(pb + 0)
            pg8::Gemm g{H, (const f16*)(ws + WS_WIN) + (size_t)l * NPJ * DM, MT, NPJ, DM}; pg8::StaticOrder S; S.init(MT, NPJ, G, wg);
            pg8::EpiF16N<0> E{PROJ, NPJ, ssq1, BW + (size_t)(l * 2 + 0) * 16 * 4096};
            for (int rep = 0; rep < REP_GIN; ++rep) pg8::gemm_phase<pg8::EpiF16N<0>, pg8::StaticOrder, ALL_BF16 != 0>((LAS unsigned char*)lds, g, S, E);
            AMPE(pb + 0) SEAM(pb + 0);
        }
        if (PM(3) && IN(pb + 1)) { AMPB(pb + 1)
#if ENABLE_DSA
            kvnorm_phase(lds, PROJ, P.kv_norm_g + l * 128, KV, KVT, G, wg);
            __syncthreads();
#endif
#if ENABLE_SB
            vtrans_phase(lds, PROJ, VTA, G, wg);
            __syncthreads();
#endif
#if ENABLE_DSA
            for (int rep = 0; rep < REP_IDX; ++rep) { indexer_phase(lds, PROJ, MASK, G, wg, rep == 0 || !REP_IDX_SCORE_ONLY); __syncthreads(); }
#endif
            AMPE(pb + 1) SEAM(pb + 1);
        }
        if (PM(4) && IN(pb + 2)) { AMPB(pb + 2)
            for (int rep = 0; rep < REP_SB; ++rep) { sb_attn_phase(lds, PROJ, VTA, OBUF, G, wg); }
            for (int rep = 0; rep < REP_DSA; ++rep) { __syncthreads(); dsa_attn_phase(lds, PROJ, KV, KVT, MASK, (const float*)(ws + WS_BIAS), (const f16*)(ws + WS_WUV) + (size_t)l * 8 * 64 * 128, OBUF, G, wg); }
            AMPE(pb + 2) SEAM(pb + 2);
        }
        if (PM(6) && IN(pb + 3)) { AMPB(pb + 3)
            pg8::Gemm g{OBUF, (const f16*)(ws + WS_WOUT) + (size_t)l * DM * DM, MT, DM, DM}; pg8::StaticOrder S; S.init(MT, DM, G, wg);
            pg8::EpiResidN<MLP_BF16 != 0> E{xin, X, modl + 2 * DM, P.g_mlp + l * DM, modl + 4 * DM, H, ssq2};
            pg8::gemm_phase<pg8::EpiResidN<MLP_BF16 != 0>, pg8::StaticOrder, ALL_BF16 != 0>((LAS unsigned char*)lds, g, S, E);
            AMPE(pb + 3) SEAM(pb + 3);
        }
        if (PM(8) && IN(pb + 4)) { AMPB(pb + 4)
            pg8::Gemm g{H, (const f16*)(ws + WS_WUP) + (size_t)l * FF * DM, MT, FF, DM}; pg8::StaticOrder S; S.init(MT, FF, G, wg);
            pg8::EpiF16N<1, MLP_BF16 != 0> E{HID, FF, ssq2, BW + (size_t)(l * 2 + 1) * 16 * 4096};
            for (int rep = 0; rep < REP_GUP; ++rep) pg8::gemm_phase<pg8::EpiF16N<1, MLP_BF16 != 0>, pg8::StaticOrder, MLP_BF16 != 0>((LAS unsigned char*)lds, g, S, E);
            AMPE(pb + 4) SEAM(pb + 4);
        }
        if (PM(9) && IN(pb + 5)) { AMPB(pb + 5)
            pg8::Gemm g{HID, (const f16*)(ws + WS_WDN) + (size_t)l * DM * FF, MT, DM, FF}; pg8::StaticOrder S; S.init(MT, DM, G, wg);
            if (l == 0) {
                pg8::EpiResidN<ALL_BF16 != 0> E{X, X, modl + 5 * DM, P.g_attn + DM, MOD + (size_t)16 * 6144 + 1 * DM, H, SSQ + (size_t)2 * MT};
                pg8::gemm_phase<pg8::EpiResidN<ALL_BF16 != 0>, pg8::StaticOrder, MLP_BF16 != 0>((LAS unsigned char*)lds, g, S, E);
            } else {
                pg8::EpiResid E{X, X, modl + 5 * DM};
                pg8::gemm_phase<pg8::EpiResid, pg8::StaticOrder, MLP_BF16 != 0>((LAS unsigned char*)lds, g, S, E);
            }
            AMPE(pb + 5) SEAM(pb + 5);
        }
    }
    if (PM(10) && IN(14)) { final_norm_phase(X, P.g_final, P.out, G, wg); }
#undef IN
#undef SEAM
}

extern "C" void kernel_launch(void* const* d_in, const int* in_sizes, int n_in, void* d_out, int out_size, void* d_ws, size_t ws_size, hipStream_t stream) {
    static int grid = 0;
    if (grid == 0) {
        if (n_in != 16 || in_sizes[0] != MT * DM || out_size != MT * DM || ws_size < WS_END) {
            fprintf(stderr, "kernel_launch: unexpected shapes: n_in %d in0 %d out %d ws %zu (need %zu)\n", n_in, n_in > 0 ? in_sizes[0] : -1, out_size, ws_size, (size_t)WS_END); grid = -1; return; }
        int dev = 0, cus = 0, per_cu = 0;
        if (hipGetDevice(&dev) != hipSuccess || hipDeviceGetAttribute(&cus, hipDeviceAttributeMultiprocessorCount, dev) != hipSuccess) { grid = -1; return; }
        if (hipFuncSetAttribute((const void*)trunk_fwd, hipFuncAttributeMaxDynamicSharedMemorySize, LDS_BYTES) != hipSuccess) { fprintf(stderr, "kernel_launch: hipFuncSetAttribute failed\n"); grid = -1; return; }
        if (hipOccupancyMaxActiveBlocksPerMultiprocessor(&per_cu, (const void*)trunk_fwd, NTHR, LDS_BYTES) != hipSuccess || per_cu < 1) fprintf(stderr, "kernel_launch: occupancy query says %d\n", per_cu);
        (void)hipGetLastError();
        grid = cus;
    }
    if (grid < 0) return;
    (void)hipMemsetAsync((char*)d_ws + WS_CTL, 0, CTL_BYTES, stream);
    Args a{};
    a.p.x = (const float*)d_in[0]; a.p.c = (const float*)d_in[1]; a.p.w_mod = (const float*)d_in[2]; a.p.b_mod = (const float*)d_in[3]; a.p.g_attn = (const float*)d_in[4];
    a.p.w_in = (const float*)d_in[5]; a.p.kv_norm_g = (const float*)d_in[6]; a.p.w_uv = (const float*)d_in[7]; a.p.g_out_a = (const float*)d_in[8]; a.p.g_out_b = (const float*)d_in[9];
    a.p.w_out = (const float*)d_in[10]; a.p.g_mlp = (const float*)d_in[11]; a.p.w_up = (const float*)d_in[12]; a.p.w_down = (const float*)d_in[13]; a.p.rel_bias = (const float*)d_in[14];
    a.p.g_final = (const float*)d_in[15]; a.p.out = (float*)d_out; a.p.ws = (unsigned char*)d_ws;
#if N_LAUNCH_MODE == 1
    a.ph_lo = 0; a.ph_hi = N_PHASES;
    hipLaunchKernelGGL(trunk_fwd, dim3(grid), dim3(NTHR), LDS_BYTES, stream, a);
#else
    for (int ph = 0; ph < N_PHASES; ++ph) { a.ph_lo = ph; a.ph_hi = ph + 1; hipLaunchKernelGGL(trunk_fwd, dim3(grid), dim3(NTHR), LDS_BYTES, stream, a); }
#endif
}
```

```cpp
#include <hip/hip_runtime.h>
#include <cstdio>
#include <cstdint>

#define LAS __attribute__((address_space(3)))
typedef _Float16 f16;
typedef _Float16 f16x8 __attribute__((ext_vector_type(8)));
typedef _Float16 f16x4 __attribute__((ext_vector_type(4)));
typedef __bf16 bf16x8 __attribute__((ext_vector_type(8)));
typedef float f32x2 __attribute__((ext_vector_type(2)));
typedef float f32x4 __attribute__((ext_vector_type(4)));
typedef float f32x16 __attribute__((ext_vector_type(16)));
typedef unsigned u32x2 __attribute__((ext_vector_type(2)));
typedef unsigned u32x4 __attribute__((ext_vector_type(4)));

#ifndef N_LAUNCH_MODE
#define N_LAUNCH_MODE 1
#endif
#ifndef ENABLE_SB
#define ENABLE_SB 1
#endif
#ifndef ENABLE_DSA
#define ENABLE_DSA 1
#endif

constexpr int NB = 16, SEQ = 2048, DM = 1024, MT = NB * SEQ, NPJ = 3328, NPJ_VALID = 3272, FF = 4096, NLAYER = 2;
constexpr int C_SBQ = 0, C_SBK = 512, C_SBV = 1024, C_DQ = 1536, C_DKV = 2560, C_IQ = 2688, C_IK = 3200, C_IW = 3264;
constexpr int NWAVES = 8, NTHR = 512;
constexpr float EPS = 1e-6f;
constexpr float LOG2E = 1.4426950408889634f;

constexpr size_t al256(size_t x) { return (x + 255) & ~(size_t)255; }
constexpr size_t WS_CTL = 0;
constexpr size_t CTL_BYTES = 65536;
constexpr size_t WS_MOD = WS_CTL + CTL_BYTES;
constexpr size_t WS_BIAS = WS_MOD + al256((size_t)2 * 16 * 6144 * 4);
constexpr size_t WS_SSQ = WS_BIAS + al256((size_t)8 * 2112 * 4);
constexpr size_t WS_BW = WS_SSQ + (size_t)5 * MT * 4;
constexpr size_t WS_WIN = WS_BW + (size_t)2 * 2 * 16 * 4096 * 4;
constexpr size_t WS_WOUT = WS_WIN + (size_t)2 * NPJ * DM * 2;
constexpr size_t WS_WUP = WS_WOUT + (size_t)2 * DM * DM * 2;
constexpr size_t WS_WDN = WS_WUP + (size_t)2 * FF * DM * 2;
constexpr size_t WS_WUV = WS_WDN + (size_t)2 * FF * DM * 2;
constexpr size_t WS_H = WS_WUV + (size_t)2 * 8 * 64 * 128 * 2;
constexpr size_t WS_KV = WS_H + (size_t)MT * DM * 2;
constexpr size_t WS_KVT = WS_KV + (size_t)MT * 128 * 2;
constexpr size_t WS_VTA = WS_KVT + (size_t)MT * 128 * 2;
constexpr size_t WS_MASK = WS_VTA + (size_t)MT * 512 * 2;
constexpr size_t WS_PROJ = WS_MASK + (size_t)MT * 64 * 4;
constexpr size_t WS_OBUF = WS_PROJ + (size_t)MT * NPJ * 2;
constexpr size_t WS_HID = WS_PROJ;
constexpr size_t WS_X16 = WS_OBUF + (size_t)MT * DM * 2;
constexpr size_t WS_END = WS_X16 + (size_t)MT * DM * 2;
static_assert((size_t)MT * FF * 2 <= WS_END - WS_PROJ, "HID overlay must fit");

constexpr int LDS_BYTES = 147456;
constexpr int LDS_MISC = 135168;

__device__ __forceinline__ float wave_sum(float v) {
    v += __shfl_xor(v, 32); v += __shfl_xor(v, 16); v += __shfl_xor(v, 8); v += __shfl_xor(v, 4); v += __shfl_xor(v, 2); v += __shfl_xor(v, 1); return v;
}
__device__ __forceinline__ float half_sum(float v) {
    v += __shfl_xor(v, 16); v += __shfl_xor(v, 8); v += __shfl_xor(v, 4); v += __shfl_xor(v, 2); v += __shfl_xor(v, 1); return v;
}

__device__ __forceinline__ int ltid() { int t = threadIdx.x; asm volatile("" : "+v"(t)); return t; }

__device__ __forceinline__ int wave_sum_i(int v) {
    v += __builtin_amdgcn_update_dpp(0, v, 0xB1, 0xf, 0xf, true);
    v += __builtin_amdgcn_update_dpp(0, v, 0x4E, 0xf, 0xf, true);
    v += __builtin_amdgcn_update_dpp(0, v, 0x141, 0xf, 0xf, true);
    v += __builtin_amdgcn_update_dpp(0, v, 0x140, 0xf, 0xf, true);
    return __builtin_amdgcn_readlane(v, 0) + __builtin_amdgcn_readlane(v, 16) + __builtin_amdgcn_readlane(v, 32) + __builtin_amdgcn_readlane(v, 48);
}

__device__ __forceinline__ int kperm16(int k) { return (k & ~12) | ((k & 8) >> 1) | ((k & 4) << 1); }

#ifndef MLP_BF16
#define MLP_BF16 1
#endif
#ifndef ALL_BF16
#define ALL_BF16 0
#endif
typedef __fp16 lds_h4 __attribute__((__vector_size__(4 * sizeof(__fp16))));
typedef _Float16 f16x4_t __attribute__((ext_vector_type(4)));
#define LDS_TR16(P_) __builtin_bit_cast(f16x4_t, __builtin_amdgcn_ds_read_tr16_b64_v4f16((LAS lds_h4*)(P_)))
template <bool BF> __device__ __forceinline__ f16 cvt16(float x) { if constexpr (BF) { const __bf16 b = (__bf16)x; return __builtin_bit_cast(f16, b); } else return (f16)x; }
#define XB_TMO      128
#define XB_XCNT(j)  (256  + 64 * (j))
#define XB_XSUB(j)  (1280 + 64 * (j))
#define XB_XGEN(j)  (2304 + 64 * (j))
#define XB_TOP      3328
#define XB_TOPGEN   3392
#define XCD_BAR_WORDS 3456
#define XB_SPIN_CAP (1u << 18)

__device__ __forceinline__ unsigned xb_ld(unsigned* p)              { return __hip_atomic_load(p, __ATOMIC_RELAXED, __HIP_MEMORY_SCOPE_AGENT); }
__device__ __forceinline__ unsigned xb_add(unsigned* p, unsigned v) { return __hip_atomic_fetch_add(p, v, __ATOMIC_RELAXED, __HIP_MEMORY_SCOPE_AGENT); }
__device__ __forceinline__ unsigned xb_xcc_id() { return (unsigned)__builtin_amdgcn_s_getreg((3 << 11) | 20) & 0xFu; }
#define XB_SPIN(cond, bar) do { unsigned _sp = 0; while (cond) { __builtin_amdgcn_s_sleep(1); \
    if ((++_sp & 255u) == 0u) { if (xb_ld(&(bar)[XB_TMO])) break; if (_sp > XB_SPIN_CAP) { atomicAdd(&(bar)[XB_TMO], 1u); break; } } } } while (0)

struct XcdBarrier {
    unsigned* bar; unsigned x;
    volatile LAS unsigned* st;
};

__device__ __forceinline__ XcdBarrier xcd_barrier_post(unsigned* bar, volatile LAS unsigned* st) {
    XcdBarrier b; b.bar = bar; b.x = xb_xcc_id(); b.st = st;
    if (threadIdx.x == 0) (void)xb_add(&bar[XB_XCNT(b.x)], 1u);
    return b;
}
__device__ __forceinline__ void xcd_barrier_complete(unsigned* bar, unsigned x, unsigned& nloc, unsigned& nx) {
    const unsigned G = gridDim.x * gridDim.y * gridDim.z;
    unsigned sum, cnt, mine, sp = 0u;
    for (;;) {
        sum = 0u; cnt = 0u; mine = 0u;
#pragma unroll
        for (unsigned j = 0; j < 16; ++j) { const unsigned c = xb_ld(&bar[XB_XCNT(j)]); sum += c; cnt += (c > 0u) ? 1u : 0u; mine = (j == x) ? c : mine; }
        if (sum == G) break;
        __builtin_amdgcn_s_sleep(1);
        if ((++sp & 255u) == 0u) { if (xb_ld(&bar[XB_TMO])) break; if (sp > XB_SPIN_CAP) { atomicAdd(&bar[XB_TMO], 1u); break; } }
    }
    nloc = mine > 0u ? mine : 1u; nx = cnt > 0u ? cnt : 1u;
}

__device__ __forceinline__ void xcd_barrier(const XcdBarrier& b) {
    asm volatile("s_waitcnt vmcnt(0)" ::: "memory");
    __syncthreads();
    if (threadIdx.x == 0) {
        unsigned* bar = b.bar;
        __builtin_amdgcn_s_waitcnt(0);
        unsigned nloc = b.st[0], nx = b.st[1];
        if (nloc == 0u) { xcd_barrier_complete(bar, b.x, nloc, nx); b.st[0] = nloc; b.st[1] = nx; }
        const unsigned old = xb_add(&bar[XB_XSUB(b.x)], 1u);
        const unsigned gen = old / nloc;
        if (old + 1u == (gen + 1u) * nloc) {
            __builtin_amdgcn_fence(__ATOMIC_RELEASE, "agent");
            asm volatile("s_waitcnt vmcnt(0)" ::: "memory");
            const unsigned og = xb_add(&bar[XB_TOP], 1u);
            const unsigned tg = og / nx;
            if (og + 1u == (tg + 1u) * nx) xb_add(&bar[XB_TOPGEN], 1u);
            else XB_SPIN(xb_ld(&bar[XB_TOPGEN]) == tg, bar);
            __builtin_amdgcn_fence(__ATOMIC_ACQUIRE, "agent");
            xb_add(&bar[XB_XGEN(b.x)], 1u);
            asm volatile("s_waitcnt vmcnt(0)" ::: "memory");
        } else {
            XB_SPIN(xb_ld(&bar[XB_XGEN(b.x)]) == gen, bar);
            __builtin_amdgcn_fence(__ATOMIC_ACQUIRE, "agent");
            asm volatile("s_waitcnt vmcnt(0)" ::: "memory");
        }
    }
    __syncthreads();
}

namespace pg8 {
constexpr int BM = 256, BK = 64, HALF = 128, HTB = HALF * BK * 2  , STAGE_BYTES = 8 * HTB, NXCD = 8, WGM = 4;

__host__ __device__ __forceinline__ int lds_byte(int r, int c) { const int st = (r >> 4) * 2 + (c >> 5), rr = r & 15, cc = c & 31, ob = rr * 64 + cc * 2; return st * 1024 + (ob ^ (((ob >> 9) & 1) << 5)); }
__host__ __device__ __forceinline__ void stage_rc(int b, int& R, int& C) { const int st = b / 1024, sb = b % 1024, swz = sb ^ (((sb >> 9) & 1) << 5); R = (st >> 1) * 16 + swz / 64; C = (st & 1) * 32 + (swz % 64) / 2; }
__host__ __device__ __forceinline__ int perm32(int rho) { const int n = rho >> 4, i = rho & 15; return 8 * (i >> 2) + 4 * n + (i & 3); }

struct Unit { int pm, pn; };
struct Gemm { const f16* A; const f16* Bt; int M, N, K; };

struct StaticOrder {
    int nM, nN, nwg, G, c;
    __host__ __device__ void init(int M, int N, int G_, int c_) { nM = M / BM; nN = N / BM; nwg = nM * nN; G = G_; c = c_; }
    __host__ __device__ bool next(int i, Unit& u) const {
        const long L = (long)i * G + c; if (L >= nwg) return false;
        int wgid = (int)L;
#ifndef NO_XCD_REMAP
        { const int q = nwg / NXCD, r = nwg % NXCD, xcd = wgid % NXCD, off = wgid / NXCD; wgid = (xcd < r ? xcd * (q + 1) : r * (q + 1) + (xcd - r) * q) + off; }
#endif
        const int nig = WGM * nN, gid = wgid / nig, fm = gid * WGM, gsz = (nM - fm) < WGM ? (nM - fm) : WGM;
        u.pm = fm + ((wgid % nig) % gsz); u.pn = (wgid % nig) / gsz; return true;
    }
    __device__ __forceinline__ void a_ready(const Unit&) const {}
    __device__ __forceinline__ void done(const Unit&) const {}
};

__device__ __forceinline__ f16x8 epi_to_rowmajor(f16x8 v, int lane) {
    const int src = (((lane & 3) << 4) | (lane >> 2)) << 2;
    u32x4 x = __builtin_bit_cast(u32x4, v), y;
#pragma unroll
    for (int d = 0; d < 4; ++d) y[d] = (unsigned)__builtin_amdgcn_ds_bpermute(src, (int)x[d]);
    return __builtin_bit_cast(f16x8, y);
}
__device__ __forceinline__ f16x8 epi_from_rowmajor(f16x8 v, int lane) {
    const int src = (((lane & 15) << 2) | (lane >> 4)) << 2;
    u32x4 x = __builtin_bit_cast(u32x4, v), y;
#pragma unroll
    for (int d = 0; d < 4; ++d) y[d] = (unsigned)__builtin_amdgcn_ds_bpermute(src, (int)x[d]);
    return __builtin_bit_cast(f16x8, y);
}
struct EpiResid {
    static constexpr bool PERM = true, AFTER_DRAIN = false, PREFETCH = false;
    const f16* base; f16* out; const float* gate;
    __device__ __forceinline__ void operator()(const f32x4 (&acc)[2][2][4][2], const Unit& u, int wr, int wc, int fr, int fq) const {
        const int col0 = u.pn * BM + wc * 32 + 8 * fq;
        const float* gp = gate + (size_t)((u.pm * BM) >> 11) * 6144 + col0;
        f32x4 gv[2][2];
#pragma unroll
        for (int bj = 0; bj < 2; ++bj)
#pragma unroll
            for (int n = 0; n < 2; ++n) gv[bj][n] = *(const f32x4*)(gp + bj * HALF + 4 * n);
        int lane = fq * 16 + fr; asm volatile("" : "+v"(lane));
        const size_t rp = (size_t)(u.pm * BM + wr * 64 + (lane >> 2)) * DM + u.pn * BM + wc * 32 + 8 * (lane & 3);
#pragma unroll
        for (int ai = 0; ai < 2; ++ai) {
            f16x8 xh[4][2];
#pragma unroll
            for (int m = 0; m < 4; ++m)
#pragma unroll
                for (int bj = 0; bj < 2; ++bj) xh[m][bj] = *(const f16x8*)(base + rp + (size_t)(ai * HALF + m * 16) * DM + bj * HALF);
#pragma unroll
            for (int m = 0; m < 4; ++m) { const size_t ro = rp + (size_t)(ai * HALF + m * 16) * DM;
#pragma unroll
                for (int bj = 0; bj < 2; ++bj) { const f16x8 xv = epi_from_rowmajor(xh[m][bj], lane); f16x8 o;
#pragma unroll
                    for (int e = 0; e < 8; ++e) o[e] = (f16)((float)xv[e] + gv[bj][e >> 2][e & 3] * acc[ai][bj][m][e >> 2][e & 3]);
                    *(f16x8*)(out + ro + bj * HALF) = epi_to_rowmajor(o, lane); } }
            __builtin_amdgcn_sched_barrier(0);
        }
    }
};
struct EpiFinal {
    static constexpr bool PERM = true, AFTER_DRAIN = false, PREFETCH = false;
    const f16* base; float* out; const float* gate; const float* gfin; float* ssq; unsigned* cnt; unsigned* tmo;
    __device__ __forceinline__ void operator()(f32x4 (&acc)[2][2][4][2], const Unit& u, int wr, int wc, int fr, int fq) const {
        const int row0 = u.pm * BM + wr * 64 + fr; const int col0 = u.pn * BM + wc * 32 + 8 * fq;
        { const float* gp = gate + (size_t)((u.pm * BM) >> 11) * 6144 + col0;
          f32x4 gv[2][2];
#pragma unroll
          for (int bj = 0; bj < 2; ++bj)
#pragma unroll
              for (int n = 0; n < 2; ++n) gv[bj][n] = *(const f32x4*)(gp + bj * HALF + 4 * n);
          int lane = fq * 16 + fr; asm volatile("" : "+v"(lane));
          const size_t rp = (size_t)(u.pm * BM + wr * 64 + (lane >> 2)) * DM + u.pn * BM + wc * 32 + 8 * (lane & 3);
#pragma unroll
          for (int ai = 0; ai < 2; ++ai) {
              f16x8 xh[4][2];
#pragma unroll
              for (int m = 0; m < 4; ++m)
#pragma unroll
                  for (int bj = 0; bj < 2; ++bj) xh[m][bj] = *(const f16x8*)(base + rp + (size_t)(ai * HALF + m * 16) * DM + bj * HALF);
#pragma unroll
              for (int m = 0; m < 4; ++m) { float sq = 0.f;
#pragma unroll
                  for (int bj = 0; bj < 2; ++bj) { const f16x8 xv = epi_from_rowmajor(xh[m][bj], lane);
#pragma unroll
                      for (int e = 0; e < 8; ++e) { const float y = (float)xv[e] + gv[bj][e >> 2][e & 3] * acc[ai][bj][m][e >> 2][e & 3]; acc[ai][bj][m][e >> 2][e & 3] = y; sq += y * y; } }
                  sq += __shfl_xor(sq, 16); sq += __shfl_xor(sq, 32);
                  if (fq == 0) __hip_atomic_fetch_add(ssq + row0 + ai * HALF + m * 16, sq, __ATOMIC_RELAXED, __HIP_MEMORY_SCOPE_AGENT); }
              __builtin_amdgcn_sched_barrier(0);
          } }
        asm volatile("s_waitcnt vmcnt(0)" ::: "memory");
        __builtin_amdgcn_s_barrier();
        if (threadIdx.x == 0) {
            (void)__hip_atomic_fetch_add(cnt + u.pm, 1u, __ATOMIC_RELAXED, __HIP_MEMORY_SCOPE_AGENT);
            unsigned sp = 0u;
            while (__hip_atomic_load(cnt + u.pm, __ATOMIC_RELAXED, __HIP_MEMORY_SCOPE_AGENT) < 4u) { __builtin_amdgcn_s_sleep(2);
                if ((++sp & 255u) == 0u) { if (__hip_atomic_load(tmo, __ATOMIC_RELAXED, __HIP_MEMORY_SCOPE_AGENT)) break; if (sp > (1u << 18)) { atomicAdd(tmo, 1u); break; } } }
        }
        __builtin_amdgcn_s_barrier();
        { int lane = fq * 16 + fr; asm volatile("" : "+v"(lane));
          const int src = (((lane & 3) << 4) | (lane >> 2)) << 2;
          float* op = out + (size_t)(u.pm * BM + wr * 64 + (lane >> 2)) * DM + u.pn * BM + wc * 32 + 8 * (lane & 3);
          f32x4 gf[2][2];
#pragma unroll
          for (int bj = 0; bj < 2; ++bj)
#pragma unroll
              for (int n = 0; n < 2; ++n) gf[bj][n] = *(const f32x4*)(gfin + col0 + bj * HALF + 4 * n);
          float tot8[2][4];
#pragma unroll
          for (int ai = 0; ai < 2; ++ai)
#pragma unroll
              for (int m = 0; m < 4; ++m) tot8[ai][m] = __hip_atomic_load(ssq + row0 + ai * HALF + m * 16, __ATOMIC_RELAXED, __HIP_MEMORY_SCOPE_AGENT);
#pragma unroll
          for (int ai = 0; ai < 2; ++ai)
#pragma unroll
              for (int m = 0; m < 4; ++m) { const float tot = tot8[ai][m];
                  const float rs = rsqrtf(tot * (1.0f / DM) + EPS);
#pragma unroll
                  for (int bj = 0; bj < 2; ++bj) { f32x4 o0, o1;
#pragma unroll
                      for (int d = 0; d < 4; ++d) {
                          o0[d] = __int_as_float(__builtin_amdgcn_ds_bpermute(src, __float_as_int(acc[ai][bj][m][0][d] * rs * gf[bj][0][d])));
                          o1[d] = __int_as_float(__builtin_amdgcn_ds_bpermute(src, __float_as_int(acc[ai][bj][m][1][d] * rs * gf[bj][1][d]))); }
                      float* q = op + (size_t)(ai * HALF + m * 16) * DM + bj * HALF;
                      *(f32x4*)q = o0; *(f32x4*)(q + 4) = o1; }
                  if (m & 1) __builtin_amdgcn_sched_barrier(0); } }
    }
};
template <int ACT  , bool BF = false> struct EpiF16N {
    static constexpr bool PERM = true, AFTER_DRAIN = false, PREFETCH = true;
    f16* O; int ldc; const float* ssq; const float* bw;
    __device__ __forceinline__ void prefetch(LAS unsigned char* aux, const Unit& u, int tid, int wid) const {
        const float* src = (tid < 256) ? ssq + u.pm * BM + tid : bw + (size_t)((u.pm * BM) >> 11) * 4096 + u.pn * BM + (tid - 256);
        __builtin_amdgcn_global_load_lds((const unsigned*)src, (LAS unsigned*)(aux + wid * 256), 4, 0, 0);
    }
    __device__ __forceinline__ void with_lds(const f32x4 (&acc)[2][2][4][2], const Unit& u, int wr, int wc, int fr, int fq, LAS unsigned char* aux) const {
        const int row0 = u.pm * BM + wr * 64 + fr; const int col0 = u.pn * BM + wc * 32 + 8 * fq;
        const LAS float* sq = (const LAS float*)aux; const LAS float* bl = (const LAS float*)(aux + 1024) + wc * 32 + 8 * fq;
        f32x4 bv[2][2];
#pragma unroll
        for (int bj = 0; bj < 2; ++bj)
#pragma unroll
            for (int n = 0; n < 2; ++n) bv[bj][n] = *(const LAS f32x4*)(bl + bj * HALF + 4 * n);
        float rs[2][4];
#pragma unroll
        for (int ai = 0; ai < 2; ++ai)
#pragma unroll
            for (int m = 0; m < 4; ++m) rs[ai][m] = rsqrtf(sq[wr * 64 + fr + ai * HALF + m * 16] * (1.0f / DM) + EPS);
        int lane = fq * 16 + fr; asm volatile("" : "+v"(lane));
        const int prow = lane >> 2, pcol = 8 * (lane & 3);
#pragma unroll
        for (int ai = 0; ai < 2; ++ai)
#pragma unroll
            for (int m = 0; m < 4; ++m) { f16* rowp = O + (size_t)(u.pm * BM + wr * 64 + prow + ai * HALF + m * 16) * ldc + u.pn * BM + wc * 32 + pcol;
#pragma unroll
                for (int bj = 0; bj < 2; ++bj) { f32x4 v0 = acc[ai][bj][m][0] * rs[ai][m] + bv[bj][0], v1 = acc[ai][bj][m][1] * rs[ai][m] + bv[bj][1];
                    if (ACT == 1) {
#pragma unroll
                        for (int e = 0; e < 4; ++e) { const float a = fmaxf(v0[e], 0.f), b = fmaxf(v1[e], 0.f); v0[e] = a * a; v1[e] = b * b; } }
                    f16x8 w; w[0] = cvt16<BF>(v0[0]); w[1] = cvt16<BF>(v0[1]); w[2] = cvt16<BF>(v0[2]); w[3] = cvt16<BF>(v0[3]); w[4] = cvt16<BF>(v1[0]); w[5] = cvt16<BF>(v1[1]); w[6] = cvt16<BF>(v1[2]); w[7] = cvt16<BF>(v1[3]);
                    *(f16x8*)(rowp + bj * HALF) = epi_to_rowmajor(w, lane); }
                if (m & 1) __builtin_amdgcn_sched_barrier(0); }
    }
    __device__ __forceinline__ void operator()(const f32x4 (&)[2][2][4][2], const Unit&, int, int, int, int) const {}
};
template <bool BF = false, bool BASE16 = true> struct EpiResidN {
    static constexpr bool PERM = true, AFTER_DRAIN = false, PREFETCH = false;
    const void* base; f16* out; const float* gate; const float* gain; const float* scale; f16* An; float* ssq;
    __device__ __forceinline__ void operator()(const f32x4 (&acc)[2][2][4][2], const Unit& u, int wr, int wc, int fr, int fq) const {
        const int row0 = u.pm * BM + wr * 64 + fr; const int col0 = u.pn * BM + wc * 32 + 8 * fq;
        const size_t bo = (size_t)((u.pm * BM) >> 11) * 6144 + col0;
        f32x4 gv[2][2], al[2][2], g4r[2][2], s4r[2][2];
#pragma unroll
        for (int bj = 0; bj < 2; ++bj)
#pragma unroll
            for (int n = 0; n < 2; ++n) { gv[bj][n] = *(const f32x4*)(gate + bo + bj * HALF + 4 * n);
                g4r[bj][n] = *(const f32x4*)(gain + col0 + bj * HALF + 4 * n); s4r[bj][n] = *(const f32x4*)(scale + bo + bj * HALF + 4 * n); }
        int lane = fq * 16 + fr; asm volatile("" : "+v"(lane));
        const size_t rp = (size_t)(u.pm * BM + wr * 64 + (lane >> 2)) * DM + u.pn * BM + wc * 32 + 8 * (lane & 3);
        f16x8 xh[4][2]; f32x4 xf[4][2][2];
#pragma unroll
        for (int m = 0; m < 2; ++m)
#pragma unroll
            for (int bj = 0; bj < 2; ++bj) { const size_t ro = rp + (size_t)(m * 16) * DM + bj * HALF;
                if constexpr (BASE16) xh[m][bj] = *(const f16x8*)((const f16*)base + ro);
                else { xf[m][bj][0] = *(const f32x4*)((const float*)base + ro); xf[m][bj][1] = *(const f32x4*)((const float*)base + ro + 4); } }
        __builtin_amdgcn_sched_barrier(0);
#pragma unroll
        for (int bj = 0; bj < 2; ++bj)
#pragma unroll
            for (int n = 0; n < 2; ++n) al[bj][n] = g4r[bj][n] * (1.0f + s4r[bj][n]);
#pragma unroll
        for (int am = 0; am < 4; ++am) { const int ai = am >> 1;
            if (am > 0) {
#pragma unroll
            for (int m = 2 * (am & 1); m < 2 * (am & 1) + 2; ++m)
#pragma unroll
                for (int bj = 0; bj < 2; ++bj) { const size_t ro = rp + (size_t)(ai * HALF + m * 16) * DM + bj * HALF;
                    if constexpr (BASE16) xh[m][bj] = *(const f16x8*)((const f16*)base + ro);
                    else { xf[m][bj][0] = *(const f32x4*)((const float*)base + ro); xf[m][bj][1] = *(const f32x4*)((const float*)base + ro + 4); } }
            }
#pragma unroll
            for (int m = 2 * (am & 1); m < 2 * (am & 1) + 2; ++m) { const int row = row0 + ai * HALF + m * 16; const size_t ro = rp + (size_t)(ai * HALF + m * 16) * DM; float sq = 0.f;
#pragma unroll
                for (int bj = 0; bj < 2; ++bj) {
                    f32x4 x0, x1;
                    if constexpr (BASE16) { const f16x8 xv = epi_from_rowmajor(xh[m][bj], lane);
                        x0 = (f32x4){(float)xv[0], (float)xv[1], (float)xv[2], (float)xv[3]}; x1 = (f32x4){(float)xv[4], (float)xv[5], (float)xv[6], (float)xv[7]}; }
                    else { const int src = (((lane & 15) << 2) | (lane >> 4)) << 2;
#pragma unroll
                        for (int d = 0; d < 4; ++d) { x0[d] = __int_as_float(__builtin_amdgcn_ds_bpermute(src, __float_as_int(xf[m][bj][0][d]))); x1[d] = __int_as_float(__builtin_amdgcn_ds_bpermute(src, __float_as_int(xf[m][bj][1][d]))); } }
                    const f32x4 y0 = x0 + gv[bj][0] * acc[ai][bj][m][0], y1 = x1 + gv[bj][1] * acc[ai][bj][m][1];
                    { f16x8 yo; yo[0] = (f16)y0[0]; yo[1] = (f16)y0[1]; yo[2] = (f16)y0[2]; yo[3] = (f16)y0[3]; yo[4] = (f16)y1[0]; yo[5] = (f16)y1[1]; yo[6] = (f16)y1[2]; yo[7] = (f16)y1[3];
                      *(f16x8*)(out + ro + bj * HALF) = epi_to_rowmajor(yo, lane); }
                    sq += ((y0[0] * y0[0] + y0[1] * y0[1]) + (y0[2] * y0[2] + y0[3] * y0[3])) + ((y1[0] * y1[0] + y1[1] * y1[1]) + (y1[2] * y1[2] + y1[3] * y1[3]));
                    const f32x4 z0 = y0 * al[bj][0], z1 = y1 * al[bj][1]; f16x8 zz;
                    zz[0] = cvt16<BF>(z0[0]); zz[1] = cvt16<BF>(z0[1]); zz[2] = cvt16<BF>(z0[2]); zz[3] = cvt16<BF>(z0[3]); zz[4] = cvt16<BF>(z1[0]); zz[5] = cvt16<BF>(z1[1]); zz[6] = cvt16<BF>(z1[2]); zz[7] = cvt16<BF>(z1[3]);
                    *(f16x8*)(An + ro + bj * HALF) = epi_to_rowmajor(zz, lane); }
                sq += __shfl_xor(sq, 16); sq += __shfl_xor(sq, 32);
                if (fq == 0) __hip_atomic_fetch_add(ssq + row, sq, __ATOMIC_RELAXED, __HIP_MEMORY_SCOPE_AGENT); }
            __builtin_amdgcn_sched_barrier(0);
        }
    }
};

#ifndef GEMM_AMP
#define GEMM_AMP 0
#endif
#define G_AMPB(k) long long _ga##k = 0; if (GEMM_AMP == (k)) _ga##k = (long long)__builtin_amdgcn_s_memtime();
#define G_AMPE(k) if (GEMM_AMP == (k)) { const long long _tb = (long long)__builtin_amdgcn_s_memtime(); while ((long long)__builtin_amdgcn_s_memtime() - _tb < (_tb - _ga##k)) __builtin_amdgcn_s_sleep(8); }
template <class Epi, class Sched, bool BF = false>
__device__ __forceinline__ void gemm_phase(LAS unsigned char* lds, const Gemm g, const Sched& S, const Epi& E) {
    const int tid = ltid(), wid = __builtin_amdgcn_readfirstlane(tid >> 6), lane = tid & 63, wr = wid >> 2, wc = wid & 3, fr = lane & 15, fq = lane >> 4;
    const int K = g.K, nt = K / BK;
    unsigned voffA[2], voffB[2];
#pragma unroll
    for (int i = 0; i < 2; ++i) { int R, C; stage_rc(tid * 16 + i * 8192, R, C); const int Rb = Epi::PERM ? ((R & ~31) + perm32(R & 31)) : R;
        voffA[i] = (unsigned)(R * K + C) * 2u; voffB[i] = (unsigned)(Rb * K + C) * 2u; }
    const size_t kstep = (size_t)(BK * 2);
    const size_t hstep = (size_t)HALF * K * 2;
    const size_t tstep = 2 * hstep;
    const unsigned ldsw = (unsigned)wid * 1024u;
    const int aoff = lds_byte(wr * 64 + fr, fq * 8), boff = lds_byte(wc * 32 + fr, fq * 8);
#define PG8_SA(b, h) (((b) * 2 + (h)) * HTB)
#define PG8_SB(b, h) ((4 + (b) * 2 + (h)) * HTB)
#define PG8_STAGE(bufoff, gbase, voff) do { _Pragma("unroll") for (int _i = 0; _i < 2; ++_i) \
        __builtin_amdgcn_global_load_lds((const unsigned*)((const char*)(gbase) + (voff)[_i]), (LAS unsigned*)(lds + (bufoff) + ldsw + _i * 8192), 16, 0, 0); } while (0)
#define PG8_LDA(dst, b, h) do { _Pragma("unroll") for (int m = 0; m < 4; ++m) _Pragma("unroll") for (int k = 0; k < 2; ++k) dst[m][k] = *(const LAS f16x8*)(lds + PG8_SA(b, h) + aoff + m * 2048 + k * 1024); } while (0)
#define PG8_LDB(dst, b, h) do { _Pragma("unroll") for (int n = 0; n < 2; ++n) _Pragma("unroll") for (int k = 0; k < 2; ++k) dst[n][k] = *(const LAS f16x8*)(lds + PG8_SB(b, h) + boff + n * 2048 + k * 1024); } while (0)
#define PG8_MMA(ai, bj, At, Bt) do { __builtin_amdgcn_s_setprio(1); _Pragma("unroll") for (int m = 0; m < 4; ++m) _Pragma("unroll") for (int n = 0; n < 2; ++n) _Pragma("unroll") for (int k = 0; k < 2; ++k) \
        { if constexpr (BF) acc[ai][bj][m][n] = __builtin_amdgcn_mfma_f32_16x16x32_bf16(__builtin_bit_cast(bf16x8, Bt[n][k]), __builtin_bit_cast(bf16x8, At[m][k]), acc[ai][bj][m][n], 0, 0, 0); \
          else acc[ai][bj][m][n] = __builtin_amdgcn_mfma_f32_16x16x32_f16(Bt[n][k], At[m][k], acc[ai][bj][m][n], 0, 0, 0); } __builtin_amdgcn_s_setprio(0); } while (0)
#define PG8_WAIT_V(n) asm volatile("s_waitcnt vmcnt(" #n ")" ::: "memory")
#define PG8_WAIT_L(n) asm volatile("s_waitcnt lgkmcnt(" #n ")" ::: "memory")
#define PG8_BAR __builtin_amdgcn_s_barrier()
#define PG8_SCHED __builtin_amdgcn_sched_barrier(0)
    Unit cur, nxt; int ui = 0;
    if (!S.next(0, cur)) return;
    f32x4 acc[2][2][4][2];
#pragma unroll
    for (int a = 0; a < 2; ++a)
#pragma unroll
        for (int b = 0; b < 2; ++b)
#pragma unroll
            for (int m = 0; m < 4; ++m)
#pragma unroll
                for (int n = 0; n < 2; ++n) acc[a][b][m][n] = (f32x4){0.f, 0.f, 0.f, 0.f};
    f16x8 At[4][2], B0[2][2], B1[2][2];
    const char* cA = (const char*)g.A + (size_t)cur.pm * tstep; const char* cB = (const char*)g.Bt + (size_t)cur.pn * tstep;
    S.a_ready(cur);
    if constexpr (Epi::PREFETCH) E.prefetch(lds + STAGE_BYTES, cur, tid, wid);
    PG8_STAGE(PG8_SB(0, 0), cB, voffB); PG8_STAGE(PG8_SB(0, 1), cB + hstep, voffB); PG8_STAGE(PG8_SA(0, 0), cA, voffA); PG8_STAGE(PG8_SA(0, 1), cA + hstep, voffA);
    if (wr == 1) PG8_BAR;
    PG8_WAIT_V(2); PG8_BAR;
    PG8_STAGE(PG8_SB(1, 0), cB + kstep, voffB); PG8_STAGE(PG8_SA(1, 0), cA + kstep, voffA); PG8_STAGE(PG8_SB(1, 1), cB + hstep + kstep, voffB);
    PG8_WAIT_V(6); PG8_BAR;
    for (;;) {
        const bool has_next = S.next(ui + 1, nxt);
        const char* nA = has_next ? (const char*)g.A + (size_t)nxt.pm * tstep : cA; const char* nB = has_next ? (const char*)g.Bt + (size_t)nxt.pn * tstep : cB;
        G_AMPB(1)
        for (int t = 0; t < nt; t += 2) {
            const bool last = (t == nt - 2);
            const char* a1 = cA + (size_t)(t + 1) * kstep;
            const char* a2 = last ? nA : cA + (size_t)(t + 2) * kstep; const char* b2 = last ? nB : cB + (size_t)(t + 2) * kstep;
            const char* a3 = a2 + kstep; const char* b3 = b2 + kstep;
            if (last && has_next) S.a_ready(nxt);
            PG8_LDB(B0, 0, 0); PG8_LDB(B1, 0, 1); PG8_SCHED; PG8_LDA(At, 0, 0); PG8_STAGE(PG8_SA(1, 1), a1 + hstep, voffA);
            PG8_WAIT_V(8); PG8_WAIT_L(0); PG8_BAR; PG8_MMA(0, 0, At, B0); PG8_MMA(0, 1, At, B1); PG8_BAR; PG8_SCHED;
            PG8_LDA(At, 0, 1); PG8_STAGE(PG8_SB(0, 0), b2, voffB); PG8_STAGE(PG8_SB(0, 1), b2 + hstep, voffB); PG8_STAGE(PG8_SA(0, 0), a2, voffA);
            PG8_WAIT_V(8); PG8_WAIT_L(0); PG8_BAR; PG8_MMA(1, 0, At, B0); PG8_MMA(1, 1, At, B1); PG8_BAR; PG8_SCHED;
            PG8_LDB(B0, 1, 0); PG8_LDB(B1, 1, 1); PG8_SCHED; PG8_LDA(At, 1, 0); PG8_STAGE(PG8_SA(0, 1), a2 + hstep, voffA);
            PG8_WAIT_V(8); PG8_WAIT_L(0); PG8_BAR; PG8_MMA(0, 0, At, B0); PG8_MMA(0, 1, At, B1); PG8_BAR; PG8_SCHED;
            PG8_LDA(At, 1, 1); PG8_STAGE(PG8_SB(1, 0), b3, voffB); PG8_STAGE(PG8_SB(1, 1), b3 + hstep, voffB); PG8_STAGE(PG8_SA(1, 0), a3, voffA);
            PG8_WAIT_V(8); PG8_WAIT_L(0); PG8_BAR; PG8_MMA(1, 0, At, B0); PG8_MMA(1, 1, At, B1); PG8_BAR; PG8_SCHED;
        }
        G_AMPE(1)
        G_AMPB(2)
#ifndef PG8_NOALIGN
        if (wr == 0) PG8_BAR;
#endif
        if constexpr (Epi::PREFETCH) E.with_lds(acc, cur, wr, wc, fr, fq, lds + STAGE_BYTES + (ui & 1) * 2048); else E(acc, cur, wr, wc, fr, fq);
        S.done(cur);
        G_AMPE(2)
        if (!has_next) break;
#pragma unroll
        for (int a = 0; a < 2; ++a)
#pragma unroll
            for (int b = 0; b < 2; ++b)
#pragma unroll
                for (int m = 0; m < 4; ++m)
#pragma unroll
                    for (int n = 0; n < 2; ++n) acc[a][b][m][n] = (f32x4){0.f, 0.f, 0.f, 0.f};
        cur = nxt; cA = nA; cB = nB; ++ui;
        if constexpr (Epi::PREFETCH) E.prefetch(lds + STAGE_BYTES + (ui & 1) * 2048, cur, tid, wid);
#ifndef PG8_NOALIGN
        if (wr == 1) PG8_BAR;
#endif
    }
    PG8_WAIT_V(0);
#ifdef PG8_NOALIGN
    if (wr == 0) PG8_BAR;
#endif
    PG8_BAR;
#undef PG8_SA
#undef PG8_SB
#undef PG8_STAGE
#undef PG8_LDA
#undef PG8_LDB
#undef PG8_MMA
#undef PG8_WAIT_V
#undef PG8_WAIT_L
#undef PG8_BAR
#undef PG8_SCHED
}
}
struct Ptrs {
    const float *x, *c, *w_mod, *b_mod, *g_attn, *w_in, *kv_norm_g, *w_uv, *g_out_a, *g_out_b, *w_out, *g_mlp, *w_up, *w_down, *rel_bias, *g_final;
    float* out; unsigned char* ws;
};

struct ConvDesc { const float* src; f16* dst; const float* ks0; const float* ks1; int N, K, Nvalid, tn, tk, bf; };
__device__ __forceinline__ void conv_load(const ConvDesc& d, int tid, float (&v)[8]) {
    const int n = d.tn * 64 + (tid & 63), nc = (n < d.Nvalid) ? n : d.Nvalid - 1;
    const float* p = d.src + (size_t)(d.tk * 64 + (tid >> 6)) * d.N + nc;
#pragma unroll
    for (int i = 0; i < 8; ++i) v[i] = p[(size_t)(8 * i) * d.N];
}
__device__ __forceinline__ void conv_store(const ConvDesc& d, int tid, const float (&v)[8], float* T  ) {
    const bool okn = (d.tn * 64 + (tid & 63)) < d.Nvalid;
#pragma unroll
    for (int i = 0; i < 8; ++i) T[((tid >> 6) + 8 * i) * 65 + (tid & 63)] = okn ? v[i] : 0.f;
    __syncthreads();
    { const int nn = tid >> 3, kc = (tid & 7) * 8; f16x8 o;
      f32x4 s0 = {1.f, 1.f, 1.f, 1.f}, s1 = s0;
      if (d.ks0) { const float* kp = (d.tk < 8) ? d.ks0 + d.tk * 64 + kc : d.ks1 + (d.tk - 8) * 64 + kc; s0 = *(const f32x4*)kp; s1 = *(const f32x4*)(kp + 4); }
#pragma unroll
      for (int e = 0; e < 8; ++e) { const float x = T[(kc + e) * 65 + nn] * (e < 4 ? s0[e] : s1[e - 4]); o[e] = d.bf ? cvt16<true>(x) : cvt16<false>(x); }
      *(f16x8*)(d.dst + (size_t)(d.tn * 64 + nn) * d.K + d.tk * 64 + kc) = o; }
    __syncthreads();
}
__device__ __forceinline__ int t5_bucket_dev(int rel) {
    const int n = rel < 0 ? -rel : rel; int bk;
    if (n < 8) bk = n; else if (n < 12) bk = 8; else if (n < 16) bk = 9; else if (n < 23) bk = 10; else if (n < 32) bk = 11; else if (n < 46) bk = 12; else if (n < 64) bk = 13; else if (n < 91) bk = 14; else bk = 15;
    return (rel > 0 ? 16 : 0) + bk;
}

constexpr int CONV_T_IN = 52 * 16, CONV_T_OUT = 16 * 16, CONV_T_UP = 64 * 16, CONV_T_DN = 16 * 64, CONV_T_L = CONV_T_IN + CONV_T_OUT + CONV_T_UP + CONV_T_DN;
__device__ __forceinline__ void conv_range(unsigned char* lds, const Ptrs& P, int u0, int u1, int Gc, int wgc) {
    const int tid = ltid();
    unsigned char* ws = P.ws;
    float* T = (float*)lds;
    constexpr int T_IN = CONV_T_IN, T_OUT = CONV_T_OUT, T_UP = CONV_T_UP, T_DN = CONV_T_DN, T_L = CONV_T_L;
    auto decode = [&](int u) -> ConvDesc {
        const int l = u / T_L; int r = u % T_L;
        if (r < T_IN) return ConvDesc{P.w_in + (size_t)l * DM * NPJ_VALID, (f16*)(ws + WS_WIN) + (size_t)l * NPJ * DM, nullptr, nullptr, NPJ_VALID, DM, NPJ_VALID, r / 16, r % 16, ALL_BF16};
        r -= T_IN;
        if (r < T_OUT) return ConvDesc{P.w_out + (size_t)l * DM * DM, (f16*)(ws + WS_WOUT) + (size_t)l * DM * DM, P.g_out_a + l * 512, P.g_out_b + l * 512, DM, DM, DM, r / 16, r % 16, ALL_BF16};
        r -= T_OUT;
        if (r < T_UP) return ConvDesc{P.w_up + (size_t)l * DM * FF, (f16*)(ws + WS_WUP) + (size_t)l * FF * DM, nullptr, nullptr, FF, DM, FF, r / 16, r % 16, MLP_BF16};
        r -= T_UP;
        return ConvDesc{P.w_down + (size_t)l * FF * DM, (f16*)(ws + WS_WDN) + (size_t)l * DM * FF, nullptr, nullptr, DM, FF, DM, r / 64, r % 64, MLP_BF16};
    };
    int u = u0 + wgc; ConvDesc d0{}, d1{}, d2{}; float va[8], vb[8], vc[8];
    if (u < u1) { d0 = decode(u); conv_load(d0, tid, va); }
    if (u + Gc < u1) { d1 = decode(u + Gc); conv_load(d1, tid, vb); }
#define CONV_STEP(VCUR, VNEW, DCUR, DNEW) { if (u >= u1) break; if (u + 2 * Gc < u1) { DNEW = decode(u + 2 * Gc); conv_load(DNEW, tid, VNEW); } conv_store(DCUR, tid, VCUR, T); u += Gc; }
    for (;;) {
        CONV_STEP(va, vc, d0, d2)
        CONV_STEP(vb, va, d1, d0)
        CONV_STEP(vc, vb, d2, d1)
    }
#undef CONV_STEP
}

#ifndef PRO_AMP
#define PRO_AMP 0
#endif
#define PRO_AMPB(k) long long _pa##k = 0; if (PRO_AMP == (k)) _pa##k = (long long)__builtin_amdgcn_s_memtime();
#define PRO_AMPE(k) if (PRO_AMP == (k)) { const long long _tb = (long long)__builtin_amdgcn_s_memtime(); while ((long long)__builtin_amdgcn_s_memtime() - _tb < (_tb - _pa##k)) __builtin_amdgcn_s_sleep(8); }
__device__ __forceinline__ void prologue_phase(unsigned char* lds, const Ptrs& P, int G, int wg) {
    const int tid = ltid(), lane = tid & 63, wv = tid >> 6;
    unsigned char* ws = P.ws;
    PRO_AMPB(1)
    conv_range(lds, P, 0, 2 * CONV_T_L, G, wg);
    PRO_AMPE(1)
    { const int wsel = (G == 256) ? wg - 192 : wg;
      const int gid = wsel * NTHR + tid;
      if (wsel >= 0 && gid < 2 * 8 * 16 * 64) {
          const int ln = gid & 63, blk = (gid >> 6) & 15, lh = gid >> 10;
          const int n = blk & 1, s_ = (blk >> 1) & 1, dq = blk >> 2, l32 = ln & 31, hh = ln >> 5;
          const float* src = P.w_uv + ((size_t)lh * 128 + 32 * dq + 16 * s_ + 4 * hh) * 64 + 32 * n + l32;
          f16x8 o;
#pragma unroll
          for (int e = 0; e < 8; ++e) o[e] = cvt16<ALL_BF16 != 0>(src[(size_t)((e & 3) + 8 * (e >> 2)) * 64]);
          *(f16x8*)((f16*)(ws + WS_WUV) + (size_t)gid * 8) = o; } }
    { float* sq = (float*)(ws + WS_SSQ) + MT; for (size_t i = (size_t)wg * NTHR + tid; i < (size_t)4 * MT / 4; i += (size_t)G * NTHR) ((f32x4*)sq)[i] = (f32x4){0.f, 0.f, 0.f, 0.f}; }
    if (wg == G - 1) {
        float* BT = (float*)(ws + WS_BIAS);
        float* RB = (float*)lds + 8192;
        __syncthreads();
        if (tid < 256) RB[tid] = P.rel_bias[tid];
        __syncthreads();
        for (int i = tid; i < 8 * 2112; i += NTHR) { const int h = i / 2112, idx = i % 2112; const int bk = t5_bucket_dev(idx - 2047);
            BT[i] = (RB[bk * 8 + h] - RB[15 * 8 + h]) * LOG2E; }
    }
    PRO_AMPB(2)
    __syncthreads();
    if (wg < 192) {
        float* SC = (float*)lds;
        float* RED = (float*)(lds + 65536);
#pragma unroll
        for (int h = 0; h < 2; ++h) { float cv[16];
#pragma unroll
            for (int j = 0; j < 16; ++j) cv[j] = P.c[tid + NTHR * (16 * h + j)];
#pragma unroll
            for (int j = 0; j < 16; ++j) { const int i = tid + NTHR * (16 * h + j), b = i >> 10, k = i & 1023; SC[k * 16 + b] = cv[j] / (1.f + __expf(-cv[j])); } }
        __syncthreads();
        for (int u = wg; u < 192; u += G) {
            const int l = u / 96, cb = u % 96, col = cb * 64 + lane;
            const float* wp = P.w_mod + (size_t)l * DM * 6144 + col;
            float acc[16];
#pragma unroll
            for (int b = 0; b < 16; ++b) acc[b] = 0.f;
            for (int k0 = wv * 128; k0 < wv * 128 + 128; k0 += 16) {
                float w16[16];
#pragma unroll
                for (int j = 0; j < 16; ++j) w16[j] = wp[(size_t)(k0 + j) * 6144];
#pragma unroll
                for (int j = 0; j < 16; ++j) { const int k = k0 + j; const float w = w16[j];
                    const f32x4 s0 = *(const f32x4*)(SC + k * 16), s1 = *(const f32x4*)(SC + k * 16 + 4), s2 = *(const f32x4*)(SC + k * 16 + 8), s3 = *(const f32x4*)(SC + k * 16 + 12);
#pragma unroll
                    for (int e = 0; e < 4; ++e) { acc[e] += s0[e] * w; acc[4 + e] += s1[e] * w; acc[8 + e] += s2[e] * w; acc[12 + e] += s3[e] * w; } }
            }
#pragma unroll
            for (int b = 0; b < 16; ++b) RED[(wv * 16 + b) * 64 + lane] = acc[b];
            __syncthreads();
            for (int i = tid; i < 1024; i += NTHR) { const int b = i >> 6, cc = i & 63; float s = P.b_mod[l * 6144 + cb * 64 + cc];
#pragma unroll
                for (int w8 = 0; w8 < 8; ++w8) s += RED[(w8 * 16 + b) * 64 + cc];
                ((float*)(ws + WS_MOD))[((size_t)l * 16 + b) * 6144 + cb * 64 + cc] = s; }
            __syncthreads();
        }
    }
    PRO_AMPE(2)
}

__device__ __forceinline__ void final_norm_phase(const f16* x, const float* gain, float* out, int G, int wg) {
    const int tid_ = ltid(); const int lane = tid_ & 63, wv = tid_ >> 6;
    const int step = G * NWAVES;
    int row = wg * NWAVES + wv;
    f32x4 g4[4];
#pragma unroll
    for (int i = 0; i < 4; ++i) g4[i] = *(const f32x4*)(gain + (i >> 1) * 512 + lane * 8 + (i & 1) * 4);
    f16x8 nx[2];
    if (row < MT) {
#pragma unroll
        for (int i = 0; i < 2; ++i) nx[i] = *(const f16x8*)(x + (size_t)row * DM + i * 512 + lane * 8); }
    for (; row < MT; row += step) {
        f32x4 v[4];
#pragma unroll
        for (int i = 0; i < 4; ++i)
#pragma unroll
            for (int e = 0; e < 4; ++e) v[i][e] = (float)nx[i >> 1][(i & 1) * 4 + e];
        if (row + step < MT) {
#pragma unroll
            for (int i = 0; i < 2; ++i) nx[i] = *(const f16x8*)(x + (size_t)(row + step) * DM + i * 512 + lane * 8); }
        float ss = 0.f;
#pragma unroll
        for (int i = 0; i < 4; ++i) ss += v[i][0] * v[i][0] + v[i][1] * v[i][1] + v[i][2] * v[i][2] + v[i][3] * v[i][3];
        ss = wave_sum(ss);
        const float rstd = rsqrtf(ss * (1.0f / DM) + EPS);
#pragma unroll
        for (int i = 0; i < 4; ++i) *(f32x4*)(out + (size_t)row * DM + (i >> 1) * 512 + lane * 8 + (i & 1) * 4) = v[i] * rstd * g4[i];
    }
}

__device__ __forceinline__ void kvnorm_phase(unsigned char* lds, const f16* PROJ, const float* g, f16* KV, f16* KVT, int G, int wg) {
    (void)lds; (void)KVT;
    const int tid = ltid();
    const int tok = tid >> 3, ch = tid & 7;
    float g0[8], g1[8];
#pragma unroll
    for (int e = 0; e < 8; ++e) { g0[e] = g[ch * 8 + e]; g1[e] = g[64 + ch * 8 + e]; }
    int blk = wg;
    f16x8 na = {0, 0, 0, 0, 0, 0, 0, 0}, nb = na;
    if (blk < MT / 64) { const f16* p = PROJ + ((size_t)blk * 64 + tok) * NPJ + C_DKV + ch * 8; na = *(const f16x8*)p; nb = *(const f16x8*)(p + 64); }
    for (; blk < MT / 64; blk += G) {
        const size_t row = (size_t)blk * 64 + tok;
        const f16x8 a = na, b = nb;
        if (blk + G < MT / 64) { const f16* p = PROJ + ((size_t)(blk + G) * 64 + tok) * NPJ + C_DKV + ch * 8; na = *(const f16x8*)p; nb = *(const f16x8*)(p + 64); }
        float va[8], vb[8]; float ss = 0.f;
#pragma unroll
        for (int e = 0; e < 8; ++e) { va[e] = (float)a[e]; vb[e] = (float)b[e]; ss += va[e] * va[e] + vb[e] * vb[e]; }
        ss += __shfl_xor(ss, 4); ss += __shfl_xor(ss, 2); ss += __shfl_xor(ss, 1);
        const float rstd = rsqrtf(ss * (1.0f / 128.f) + EPS);
        f16x8 oa, ob;
#pragma unroll
        for (int e = 0; e < 8; ++e) { oa[e] = (f16)(va[e] * rstd * g0[e]); ob[e] = (f16)(vb[e] * rstd * g1[e]); }
        *(f16x8*)(KV + row * 128 + ch * 8) = oa; *(f16x8*)(KV + row * 128 + 64 + ch * 8) = ob;
    }
}

__device__ __forceinline__ void prenorm0_phase(const float* x, const float* gain, const float* sc, f16* An, float* ssq, int G, int wg) {
    const int tid_ = ltid(); const int lane = tid_ & 63, wv = tid_ >> 6;
    const int step = G * NWAVES;
    int row = wg * NWAVES + wv;
    f32x4 g4[4];
#pragma unroll
    for (int i = 0; i < 4; ++i) g4[i] = *(const f32x4*)(gain + i * 256 + lane * 4);
    f32x4 nx[4];
    if (row < MT) {
#pragma unroll
        for (int i = 0; i < 4; ++i) nx[i] = *(const f32x4*)(x + (size_t)row * DM + lane * 4 + i * 256); }
    for (; row < MT; row += step) {
        const int b = row >> 11;
        f32x4 v[4], s4[4];
#pragma unroll
        for (int i = 0; i < 4; ++i) { v[i] = nx[i]; s4[i] = *(const f32x4*)(sc + (size_t)b * 6144 + i * 256 + lane * 4); }
        if (row + step < MT) {
#pragma unroll
            for (int i = 0; i < 4; ++i) nx[i] = *(const f32x4*)(x + (size_t)(row + step) * DM + lane * 4 + i * 256); }
        float ss = 0.f;
#pragma unroll
        for (int i = 0; i < 4; ++i) ss += v[i][0] * v[i][0] + v[i][1] * v[i][1] + v[i][2] * v[i][2] + v[i][3] * v[i][3];
        ss = wave_sum(ss);
        if (lane == 0) ssq[row] = ss;
#pragma unroll
        for (int i = 0; i < 4; ++i) { f16x4 o;
#pragma unroll
            for (int e = 0; e < 4; ++e) o[e] = cvt16<ALL_BF16 != 0>(v[i][e] * (g4[i][e] * (1.f + s4[i][e])));
            *(f16x4*)(An + (size_t)row * DM + i * 256 + lane * 4) = o; }
    }
}

__device__ __forceinline__ void bw_phase(unsigned char* lds, const Ptrs& P, const float* MOD, float* BW, int G, int wg) {
    const int tid = ltid(), lane = tid & 63, wv = tid >> 6;
    float* SH = (float*)lds;
    float* RED = (float*)(lds + 65536);
    for (int u = wg; u < 2 * 116; u += G) {
        const int l = u / 116, r = u % 116, site = (r < 52) ? 0 : 1, cb = (site == 0) ? r : r - 52;
        const int N = (site == 0) ? NPJ_VALID : FF;
        const float* W = (site == 0) ? P.w_in + (size_t)l * DM * NPJ_VALID : P.w_up + (size_t)l * DM * FF;
        const float* shp = MOD + (size_t)l * 16 * 6144 + (site == 0 ? 0 : 3) * DM;
        __syncthreads();
        { const float* sp = shp + tid;
#pragma unroll 1
          for (int b0 = 0; b0 < 16; b0 += 4) { float sv[8];
#pragma unroll
              for (int j = 0; j < 8; ++j) sv[j] = sp[(size_t)(b0 + (j >> 1)) * 6144 + 512 * (j & 1)];
#pragma unroll
              for (int j = 0; j < 8; ++j) SH[(tid + 512 * (j & 1)) * 16 + b0 + (j >> 1)] = sv[j]; } }
        __syncthreads();
        const int col = cb * 64 + lane; const bool ok = col < N;
        const float* wp = W + (ok ? col : 0);
        float acc[16];
#pragma unroll
        for (int b = 0; b < 16; ++b) acc[b] = 0.f;
        for (int k0 = wv * 128; k0 < wv * 128 + 128; k0 += 16) {
            float w16[16];
#pragma unroll
            for (int j = 0; j < 16; ++j) w16[j] = ok ? wp[(size_t)(k0 + j) * N] : 0.f;
#pragma unroll
            for (int j = 0; j < 16; ++j) { const int k = k0 + j; const float w = w16[j];
                const f32x4 s0 = *(const f32x4*)(SH + k * 16), s1 = *(const f32x4*)(SH + k * 16 + 4), s2 = *(const f32x4*)(SH + k * 16 + 8), s3 = *(const f32x4*)(SH + k * 16 + 12);
#pragma unroll
                for (int e = 0; e < 4; ++e) { acc[e] += s0[e] * w; acc[4 + e] += s1[e] * w; acc[8 + e] += s2[e] * w; acc[12 + e] += s3[e] * w; } }
        }
#pragma unroll
        for (int b = 0; b < 16; ++b) RED[(wv * 16 + b) * 64 + lane] = acc[b];
        __syncthreads();
        for (int i = tid; i < 1024; i += NTHR) { const int b = i >> 6, cc = i & 63; float s = 0.f;
#pragma unroll
            for (int w8 = 0; w8 < 8; ++w8) s += RED[(w8 * 16 + b) * 64 + cc];
            BW[(((size_t)l * 2 + site) * 16 + b) * 4096 + cb * 64 + cc] = s; }
    }
    __syncthreads();
}

__device__ __forceinline__ void vtrans_phase(unsigned char* lds, const f16* PROJ, f16* VTA, int G, int wg) {
    const int tid = ltid();
    f16* T = (f16*)lds;
    const int tok = tid >> 3, ch = tid & 7;
    const int tp = (tok & ~15) | kperm16(tok & 15);
    auto src = [&](int blk) { const int bh = blk >> 5, tb = blk & 31, b = bh >> 3, h = bh & 7; return PROJ + ((size_t)b * SEQ + tb * 64 + tok) * NPJ + C_SBV + h * 64 + ch * 8; };
    int blk = wg;
    f16x8 vn = {0, 0, 0, 0, 0, 0, 0, 0};
    if (blk < 16 * 8 * 32) vn = *(const f16x8*)src(blk);
    for (; blk < 16 * 8 * 32; blk += G) {
        const int bh = blk >> 5, tb = blk & 31;
        const f16x8 v = vn;
        if (blk + G < 16 * 8 * 32) vn = *(const f16x8*)src(blk + G);
#pragma unroll
        for (int e = 0; e < 8; ++e) T[(ch * 8 + e) * 72 + tp] = v[e];
        __syncthreads();
        { const int dim = tid >> 3, kc = (tid & 7) * 8;
          *(f16x8*)(VTA + ((size_t)bh * 64 + dim) * SEQ + tb * 64 + kc) = *(const f16x8*)(T + dim * 72 + kc); }
        __syncthreads();
    }
}

#define SB_LOAD(KF, VR, HT) do { const int _ht = (HT) < 0 ? 0 : (HT); \
    _Pragma("unroll") for (int s = 0; s < 4; ++s) KF[s] = *(const f16x8*)(kp + (size_t)_ht * 32 * NPJ + 16 * s); \
    _Pragma("unroll") for (int i = 0; i < 4; ++i) VR[i] = *(const f16x8*)(vp + (size_t)(_ht * 32 + 8 * i) * NPJ); } while (0)

#define SB_COMPUTE(KF, VR, HT) do { \
    f16x8 VF[2][2]; \
    asm volatile("" ::: "memory"); \
    _Pragma("unroll") for (int i = 0; i < 4; ++i) *(f16x8*)(VT + ((i & 1) ? vw_o : vw_e) + 1024 * i) = VR[i]; \
    asm volatile("" ::: "memory"); \
    _Pragma("unroll") for (int d = 0; d < 2; ++d) _Pragma("unroll") for (int s = 0; s < 2; ++s) { const int _o = 2048 * s + 512 * d; \
        const f16x4_t _lo = LDS_TR16(VT + vb0 + _o), _hi = LDS_TR16(VT + vb1 + _o); \
        VF[d][s] = (f16x8){_lo[0], _lo[1], _lo[2], _lo[3], _hi[0], _hi[1], _hi[2], _hi[3]}; } \
    asm volatile("" ::: "memory"); \
    f32x16 S; _Pragma("unroll") for (int r = 0; r < 16; ++r) S[r] = 0.f; \
    __builtin_amdgcn_s_setprio(1); _Pragma("unroll") for (int s = 0; s < 4; ++s) S = __builtin_amdgcn_mfma_f32_32x32x16_f16(KF[s], qf[s], S, 0, 0, 0); __builtin_amdgcn_s_setprio(0); \
    f32x16 om; \
    _Pragma("unroll") for (int r = 0; r < 16; ++r) { \
        const float zc = __builtin_amdgcn_fmed3f(S[r], -640.f, 640.f);                    \
        const float e1 = __builtin_amdgcn_exp2f(zc * (-0.125f * LOG2E));                  \
        const float be = __builtin_amdgcn_rcpf(1.0f + e1);                                \
        S[r] = be; om[r] = e1 * be; }                                                      \
    if ((HT) == rb) {                                                                      \
        const int kb = (HT) * 32 + 4 * hh; \
        _Pragma("unroll") for (int r = 0; r < 16; ++r) { const int key = kb + 8 * (r >> 2) + (r & 3); if (key >= q) { S[r] = 0.f; om[r] = 1.0f; } } } \
    float R = C; \
    _Pragma("unroll") for (int g = 3; g >= 0; --g) { \
        const float o0 = om[4 * g], o1 = om[4 * g + 1], o2 = om[4 * g + 2], o3 = om[4 * g + 3]; \
        const float gown = (o0 * o1) * (o2 * o3); \
        const float gp = __shfl_xor(gown, 32); \
        const float pre = hh ? R : R * gp; \
        const float p3 = pre, p2 = p3 * o3, p1 = p2 * o2, p0 = p1 * o1; \
        S[4 * g + 3] *= p3; S[4 * g + 2] *= p2; S[4 * g + 1] *= p1; S[4 * g] *= p0; \
        R = R * gown * gp; } \
    C = R; \
    f16x8 pf[2]; \
    _Pragma("unroll") for (int s = 0; s < 2; ++s) _Pragma("unroll") for (int e = 0; e < 8; ++e) pf[s][e] = (f16)S[8 * s + e]; \
    __builtin_amdgcn_s_setprio(1); _Pragma("unroll") for (int d = 0; d < 2; ++d) _Pragma("unroll") for (int s = 0; s < 2; ++s) accO[d] = __builtin_amdgcn_mfma_f32_32x32x16_f16(VF[d][s], pf[s], accO[d], 0, 0, 0); __builtin_amdgcn_s_setprio(0); \
    } while (0)

__device__ __forceinline__ void sb_attn_phase(unsigned char* lds, const f16* PROJ, const f16* VTA, f16* OBUF, int G, int wg) {
    const int tid = ltid(), lane = tid & 63, wv = tid >> 6, l32 = lane & 31, hh = lane >> 5;
    float* RED = (float*)(lds + 73728);
    int par = 0;
    f16x8 qn[4], kA[4], vA[4], kB[4], vB[4];
    unsigned char* VT = lds + 32768 + wv * 4096;
    const int vw_e = 512 * ((lane & 7) >> 2) + 64 * (lane >> 3) + 16 * ((lane & 3) ^ (hh)), vw_o = 512 * ((lane & 7) >> 2) + 64 * (lane >> 3) + 16 * ((lane & 3) ^ (2 + hh));
    const int tq_ = (lane & 15) >> 2, tp_ = lane & 3, tb_ = (lane >> 4) & 1;
    const int vb0 = 64 * (4 * hh + tq_) + 16 * ((2 * tb_ + (tp_ >> 1)) ^ hh) + 8 * (tp_ & 1), vb1 = 1024 + 64 * (4 * hh + tq_) + 16 * ((2 * tb_ + (tp_ >> 1)) ^ (2 + hh)) + 8 * (tp_ & 1);
#define SB_UNIT_LOAD(U) do { const int _b = 2 * ((U) & 7) + (((U) >> 3) & 1), _rb = 63 - ((U) >> 4), _bh = _b * 8 + wv; const size_t _rw = (size_t)_b * SEQ; \
        const f16* _qp = PROJ + (_rw + _rb * 32 + l32) * NPJ + C_SBQ + wv * 64 + hh * 8; \
        _Pragma("unroll") for (int s = 0; s < 4; ++s) qn[s] = *(const f16x8*)(_qp + 16 * s); \
        const f16* kp = PROJ + (_rw + l32) * NPJ + C_SBK + wv * 64 + hh * 8; const f16* vp = PROJ + (_rw + (lane >> 3)) * NPJ + C_SBV + wv * 64 + (lane & 7) * 8; (void)_bh; \
        SB_LOAD(kA, vA, _rb); } while (0)
    if (wg < 1024) SB_UNIT_LOAD(wg);
    for (int u = wg; u < 1024; u += G, par ^= 1) {
        const int b = 2 * (u & 7) + ((u >> 3) & 1), rb = 63 - (u >> 4), h = wv, bh = b * 8 + h;
        const size_t rowbase = (size_t)b * SEQ;
        const int r0 = rb * 32, q = r0 + l32;
        f16x8 qf[4];
#pragma unroll
        for (int s = 0; s < 4; ++s) qf[s] = qn[s];
        const f16* kp = PROJ + (rowbase + l32) * NPJ + C_SBK + h * 64 + hh * 8;
        const f16* vp = PROJ + (rowbase + (lane >> 3)) * NPJ + C_SBV + h * 64 + (lane & 7) * 8;
        (void)bh;
        f32x16 accO[2];
#pragma unroll
        for (int d = 0; d < 2; ++d)
#pragma unroll
            for (int r = 0; r < 16; ++r) accO[d][r] = 0.f;
        float C = 1.0f;
        int ht = rb;
        for (;;) {
            SB_LOAD(kB, vB, ht - 1);
            SB_COMPUTE(kA, vA, ht);
            if (ht == 0 || __ballot(C >= 2.9e-8f) == 0ull) break;
            --ht;
            SB_LOAD(kA, vA, ht - 1);
            SB_COMPUTE(kB, vB, ht);
            if (ht == 0 || __ballot(C >= 2.9e-8f) == 0ull) break;
            --ht;
        }
        if (u + G < 1024) SB_UNIT_LOAD(u + G);
        float ssq = 0.f;
#pragma unroll
        for (int d = 0; d < 2; ++d)
#pragma unroll
            for (int r = 0; r < 16; ++r) ssq += accO[d][r] * accO[d][r];
        ssq += __shfl_xor(ssq, 32);
        if (hh == 0) RED[(par * 8 + wv) * 32 + l32] = ssq;
        __syncthreads();
        float tot = 0.f;
#pragma unroll
        for (int w8 = 0; w8 < 8; ++w8) tot += RED[(par * 8 + w8) * 32 + l32];
        const float rstd = rsqrtf(tot * (1.0f / 512.f) + EPS);
        { f16* OT = (f16*)lds + wv * (32 * 64);
#pragma unroll
          for (int d = 0; d < 2; ++d)
#pragma unroll
            for (int g = 0; g < 4; ++g) { f16x4 o; o[0] = cvt16<ALL_BF16 != 0>(accO[d][4 * g] * rstd); o[1] = cvt16<ALL_BF16 != 0>(accO[d][4 * g + 1] * rstd); o[2] = cvt16<ALL_BF16 != 0>(accO[d][4 * g + 2] * rstd); o[3] = cvt16<ALL_BF16 != 0>(accO[d][4 * g + 3] * rstd);
                *(f16x4*)(OT + l32 * 64 + (((4 * d + g) ^ (l32 & 7)) << 3) + 4 * hh) = o; }
          asm volatile("s_waitcnt lgkmcnt(0)" ::: "memory");
          const int orow = lane >> 3, opc = lane & 7;
          f16* op = OBUF + (rowbase + r0 + orow) * DM + h * 64 + 8 * opc;
#pragma unroll
          for (int i = 0; i < 4; ++i) *(f16x8*)(op + (size_t)(8 * i) * DM) = *(const f16x8*)(OT + (orow + 8 * i) * 64 + ((opc ^ (orow & 7)) << 3));
          asm volatile("s_waitcnt lgkmcnt(0)" ::: "memory"); }
    }
}
constexpr int IDX_PITCH = 2052;
__device__ __forceinline__ unsigned radix_scan(const unsigned* hist, int lane, unsigned& digit, unsigned& rank) {
    const u32x4 b = *(const u32x4*)(hist + 4 * lane);
    const unsigned s = b[0] + b[1] + b[2] + b[3];
    unsigned p = s;
    p += (unsigned)__builtin_amdgcn_update_dpp(0, (int)p, 0x101, 0xf, 0xf, true);
    p += (unsigned)__builtin_amdgcn_update_dpp(0, (int)p, 0x102, 0xf, 0xf, true);
    p += (unsigned)__builtin_amdgcn_update_dpp(0, (int)p, 0x104, 0xf, 0xf, true);
    p += (unsigned)__builtin_amdgcn_update_dpp(0, (int)p, 0x108, 0xf, 0xf, true);
    { const unsigned t1 = __builtin_amdgcn_readlane(p, 16), t2 = __builtin_amdgcn_readlane(p, 32), t3 = __builtin_amdgcn_readlane(p, 48);
      p += (lane < 16) ? (t1 + t2 + t3) : (lane < 32) ? (t2 + t3) : (lane < 48) ? t3 : 0u; }
    const unsigned long long ge = __ballot(p >= rank);
    const int L = __popcll(ge) - 1;
    const unsigned pL = __builtin_amdgcn_readlane(p, L), sL = __builtin_amdgcn_readlane(s, L);
    unsigned r = rank - (pL - sL);
    const unsigned b3 = __builtin_amdgcn_readlane(b[3], L), b2 = __builtin_amdgcn_readlane(b[2], L), b1 = __builtin_amdgcn_readlane(b[1], L);
    unsigned k = 3, bc = b3;
    if (r > b3) { r -= b3; k = 2; bc = b2; if (r > b2) { r -= b2; k = 1; bc = b1; if (r > b1) { r -= b1; k = 0; bc = __builtin_amdgcn_readlane(b[0], L); } } }
    digit = 4u * (unsigned)L + k; rank = r; return bc;
}
__device__ __forceinline__ unsigned topk_ties(const float* row, int nadm, int lane, unsigned* hist, unsigned* hist_dummy, float sc, float cc, unsigned Tv, unsigned want) {
    constexpr int NJ = 32;
    unsigned uk[NJ];
    unsigned word = 0u;
#pragma unroll
    for (int j = 0; j < NJ; ++j) {
        unsigned bits = 0u; bool hi = false;
        if (64 * j < nadm) {
            const float x = row[64 * j + lane];
            const unsigned v = (unsigned)__builtin_fmaf(x, -sc, cc);
            hi = v < Tv;
            if (v == Tv) { bits = __float_as_uint(x); bits ^= (unsigned)(((int)bits >> 31) | 0x80000000); }
        }
        uk[j] = bits;
        const unsigned long long sel = __ballot(hi);
        asm volatile("s_nop 3\n\tv_writelane_b32 %0, %1, %3\n\tv_writelane_b32 %0, %2, %4" : "+v"(word) : "s"((unsigned)sel), "s"((unsigned)(sel >> 32)), "n"(2 * j), "n"(2 * j + 1));
    }
    unsigned rank = want, T = 0u, dg, binc = 0u;
    unsigned* dummy = hist_dummy + lane;
    unsigned umax = 0u, umin = 0xFFFFFFFFu;
#pragma unroll
    for (int j = 0; j < NJ; ++j) { umax = max(umax, uk[j]); umin = min(umin, uk[j] != 0u ? uk[j] : 0xFFFFFFFFu); }
#pragma unroll
    for (int o = 32; o >= 1; o >>= 1) { umax = max(umax, (unsigned)__shfl_xor((int)umax, o)); umin = min(umin, (unsigned)__shfl_xor((int)umin, o)); }
    const bool all_equal = (__builtin_amdgcn_readfirstlane((int)umax) == __builtin_amdgcn_readfirstlane((int)umin));
    if (all_equal) { T = (unsigned)__builtin_amdgcn_readfirstlane((int)umax); binc = want + 1u; }
    else
#pragma unroll
    for (int lv = 0; lv < 4; ++lv) {
        const int sh = 24 - 8 * lv;
        if (lv > 0 && binc == rank) break;
        *(u32x4*)(hist + 4 * lane) = (u32x4){0u, 0u, 0u, 0u};
        const unsigned pre = (lv == 0) ? 0u : (T >> (sh + 8));
#pragma unroll
        for (int j = 0; j < NJ; ++j) { unsigned* dst = (uk[j] != 0u && (lv == 0 || (uk[j] >> (sh + 8)) == pre)) ? hist + ((uk[j] >> sh) & 255u) : dummy;
            __hip_atomic_fetch_add(dst, 1u, __ATOMIC_RELAXED, __HIP_MEMORY_SCOPE_WORKGROUP); }
        binc = radix_scan(hist, lane, dg, rank); T |= dg << sh;
    }
    unsigned word2 = 0u;
    int need = (binc == rank) ? 0x7fffffff : (int)rank;
#pragma unroll
    for (int j = 0; j < NJ; ++j) {
        unsigned long long sel = __ballot(uk[j] != 0u && uk[j] > T);
        unsigned long long em = __ballot(uk[j] != 0u && ((binc == rank) ? uk[j] >= T : uk[j] == T)) & ~sel;
        if (need > 0 && em != 0ull) {
            const int pc = __popcll(em);
            if (pc <= need) { sel |= em; need -= pc; }
            else { unsigned long long keep = 0ull; for (int i = 0; i < need; ++i) { const unsigned long long lowb = em & (0ull - em); keep |= lowb; em ^= lowb; } sel |= keep; need = 0; }
        }
        asm volatile("s_nop 3\n\tv_writelane_b32 %0, %1, %3\n\tv_writelane_b32 %0, %2, %4" : "+v"(word2) : "s"((unsigned)sel), "s"((unsigned)(sel >> 32)), "n"(2 * j), "n"(2 * j + 1));
    }
    return word | word2;
}
#ifndef IDX_AMP
#define IDX_AMP 0
#endif
#define IDX_AMPB(k) long long _ta##k = 0; if (IDX_AMP == (k)) _ta##k = (long long)__builtin_amdgcn_s_memtime();
#define IDX_AMPE(k) if (IDX_AMP == (k)) { const long long _tb = (long long)__builtin_amdgcn_s_memtime(); while ((long long)__builtin_amdgcn_s_memtime() - _tb < (_tb - _ta##k)) __builtin_amdgcn_s_sleep(8); }
__device__ __forceinline__ unsigned radix_scan_up(const unsigned* hist, int lane, unsigned& digit, unsigned& rank) {
    const u32x4 b = *(const u32x4*)(hist + 4 * lane);
    const unsigned s = b[0] + b[1] + b[2] + b[3];
    unsigned p = s;
    p += (unsigned)__builtin_amdgcn_update_dpp(0, (int)p, 0x111, 0xf, 0xf, true);
    p += (unsigned)__builtin_amdgcn_update_dpp(0, (int)p, 0x112, 0xf, 0xf, true);
    p += (unsigned)__builtin_amdgcn_update_dpp(0, (int)p, 0x114, 0xf, 0xf, true);
    p += (unsigned)__builtin_amdgcn_update_dpp(0, (int)p, 0x118, 0xf, 0xf, true);
    p += (unsigned)__builtin_amdgcn_update_dpp(0, (int)p, 0x142, 0xa, 0xf, false);
    p += (unsigned)__builtin_amdgcn_update_dpp(0, (int)p, 0x143, 0xc, 0xf, false);
    const unsigned long long ge = __ballot(p >= rank) | (1ull << 63);
    const int L = __builtin_ctzll(ge);
    const unsigned pL = __builtin_amdgcn_readlane(p, L), sL = __builtin_amdgcn_readlane(s, L);
    unsigned r = rank - (pL - sL);
    const unsigned b0 = __builtin_amdgcn_readlane(b[0], L), b1 = __builtin_amdgcn_readlane(b[1], L), b2 = __builtin_amdgcn_readlane(b[2], L);
    unsigned k = 0, bc = b0;
    if (r > b0) { r -= b0; k = 1; bc = b1; if (r > b1) { r -= b1; k = 2; bc = b2; if (r > b2) { r -= b2; k = 3; bc = __builtin_amdgcn_readlane(b[3], L); } } }
    digit = 4u * (unsigned)L + k; rank = r; return bc;
}
__device__ __forceinline__ void wave_max_min(float& a, float& b) {
    asm("s_nop 1\n\t"
        "v_max_f32_dpp %0, %0, %0 quad_perm:[1,0,3,2] row_mask:0xf bank_mask:0xf\n\tv_min_f32_dpp %1, %1, %1 quad_perm:[1,0,3,2] row_mask:0xf bank_mask:0xf\n\ts_nop 0\n\t"
        "v_max_f32_dpp %0, %0, %0 quad_perm:[2,3,0,1] row_mask:0xf bank_mask:0xf\n\tv_min_f32_dpp %1, %1, %1 quad_perm:[2,3,0,1] row_mask:0xf bank_mask:0xf\n\ts_nop 0\n\t"
        "v_max_f32_dpp %0, %0, %0 row_half_mirror row_mask:0xf bank_mask:0xf\n\tv_min_f32_dpp %1, %1, %1 row_half_mirror row_mask:0xf bank_mask:0xf\n\ts_nop 0\n\t"
        "v_max_f32_dpp %0, %0, %0 row_mirror row_mask:0xf bank_mask:0xf\n\tv_min_f32_dpp %1, %1, %1 row_mirror row_mask:0xf bank_mask:0xf\n\ts_nop 0\n\t"
        "v_max_f32_dpp %0, %0, %0 row_bcast:15 row_mask:0xa bank_mask:0xf\n\tv_min_f32_dpp %1, %1, %1 row_bcast:15 row_mask:0xa bank_mask:0xf\n\ts_nop 0\n\t"
        "v_max_f32_dpp %0, %0, %0 row_bcast:31 row_mask:0xc bank_mask:0xf\n\tv_min_f32_dpp %1, %1, %1 row_bcast:31 row_mask:0xc bank_mask:0xf\n\ts_nop 1"
        : "+v"(a), "+v"(b));
    a = __int_as_float(__builtin_amdgcn_readlane(__float_as_int(a), 63));
    b = __int_as_float(__builtin_amdgcn_readlane(__float_as_int(b), 63));
}
template <int NJ> __device__ __forceinline__ unsigned topk_words(const float* row, int nadm, int lane, unsigned* hist, bool& ok, float& o_sc, float& o_cc, unsigned& o_T, unsigned& o_want) {
    const int nja = nadm >> 6;
    unsigned v[NJ];
#ifndef TK_PROBE
#define TK_PROBE 0
#endif
    int nrep = 1; if (TK_PROBE) { nrep = 2; asm volatile("" : "+s"(nrep)); }
    IDX_AMPB(5)
    for (int rep = 0; rep < ((TK_PROBE == 1) ? nrep : 1); ++rep)
    {
        float x[NJ];
#pragma unroll
        for (int j = 0; j < NJ; ++j) x[j] = row[64 * j + lane];
        float mx = x[0], mn = x[0];
#pragma unroll
        for (int j = 1; j < NJ; ++j) { const float xx = (j < NJ - 8 || j < nja) ? x[j] : x[0]; mx = __builtin_fmaxf(mx, xx); mn = __builtin_fminf(mn, xx); }
        wave_max_min(mx, mn);
        const float R = mx - mn;
        const float sc = (R > 1e-30f && __builtin_fabsf(mx) <= 8.0f * R) ? 16777000.0f * __builtin_amdgcn_rcpf(R) : 0.f;
        const float cc = __builtin_fmaf(mx, sc, 16.0f);
        const f32x2 ns2 = {-sc, -sc}, cc2 = {cc, cc};
        o_sc = sc; o_cc = cc;
#pragma unroll
        for (int j = 0; j < NJ; j += 2) {
            const f32x2 xp = {x[j], x[j + 1]};
            const f32x2 t = __builtin_elementwise_fma(xp, ns2, cc2);
            v[j] = (j < NJ - 8 || j < nja) ? (unsigned)t[0] : 0xFFFFFFFFu;
            v[j + 1] = (j + 1 < NJ - 8 || j + 1 < nja) ? (unsigned)t[1] : 0xFFFFFFFFu;
        }
    }
    IDX_AMPE(5)
    unsigned rank = 256u, base = 0u, U = 0u, dg, binc = 0u;
    const unsigned dcap = 256u + (unsigned)lane;
#pragma unroll
    for (int lv = 0; lv < 3; ++lv) {
        const int sh = 16 - 8 * lv;
        if (lv > 0 && binc == rank) break;
        unsigned rk0 = rank;
        long long _ta6 = 0; if (IDX_AMP == 6 || IDX_AMP == 7 || IDX_AMP == 9) _ta6 = (long long)__builtin_amdgcn_s_memtime();
        for (int rep = 0; rep < ((TK_PROBE == 2 && lv == 0) || (TK_PROBE == 3 && lv == 1) ? nrep : 1); ++rep) {
        *(u32x4*)(hist + 4 * lane) = (u32x4){0u, 0u, 0u, 0u};
#pragma unroll
        for (int j = 0; j < NJ; ++j) if (j < NJ - 8 || j < nja) {
            const unsigned d = (lv == 0) ? ((v[j] >> 16) & 255u) : min((v[j] - base) >> sh, dcap);
            __hip_atomic_fetch_add(hist + d, 1u, __ATOMIC_RELAXED, __HIP_MEMORY_SCOPE_WORKGROUP); }
        rank = rk0;
        binc = radix_scan_up(hist, lane, dg, rank);
        }
        base |= dg << sh; U = base + (1u << sh);
        if (IDX_AMP == 6 && lv == 0) { IDX_AMPE(6) }
        if (IDX_AMP == 7 && lv == 1) { const long long _ta7 = _ta6; IDX_AMPE(7) }
        if (IDX_AMP == 9 && lv == 2) { const long long _ta9 = _ta6; IDX_AMPE(9) }
    }
    ok = (binc == rank); o_T = base; o_want = rank;
    unsigned word = 0u;
    IDX_AMPB(8)
    for (int rep = 0; rep < ((TK_PROBE == 4) ? nrep : 1); ++rep)
#pragma unroll
    for (int j = 0; j < NJ; j += 4) {
        const unsigned long long s0 = __ballot(v[j] < U), s1 = __ballot(v[j + 1] < U), s2 = __ballot(v[j + 2] < U), s3 = __ballot(v[j + 3] < U);
        asm volatile("s_nop 3\n\tv_writelane_b32 %0, %1, %9\n\tv_writelane_b32 %0, %2, %10\n\tv_writelane_b32 %0, %3, %11\n\tv_writelane_b32 %0, %4, %12\n\t"
                     "v_writelane_b32 %0, %5, %13\n\tv_writelane_b32 %0, %6, %14\n\tv_writelane_b32 %0, %7, %15\n\tv_writelane_b32 %0, %8, %16"
                     : "+v"(word) : "s"((unsigned)s0), "s"((unsigned)(s0 >> 32)), "s"((unsigned)s1), "s"((unsigned)(s1 >> 32)), "s"((unsigned)s2), "s"((unsigned)(s2 >> 32)),
                       "s"((unsigned)s3), "s"((unsigned)(s3 >> 32)), "n"(2 * j), "n"(2 * j + 1), "n"(2 * j + 2), "n"(2 * j + 3), "n"(2 * j + 4), "n"(2 * j + 5), "n"(2 * j + 6), "n"(2 * j + 7));
    }
    IDX_AMPE(8)
    return word;
}
__device__ __forceinline__ int idx_unit_qg(int u, int G) {
    if (G == 256) { const int j = (u & 255) >> 4, i = u >> 8; return (i & 1) ? 16 * (i - 1) + j : 127 - j - 16 * i; }
    return 127 - (u >> 4);
}
__device__ __forceinline__ void indexer_phase(unsigned char* lds, const f16* PROJ, unsigned* MASK, int G, int wg, bool do_topk) {
    const int tid = ltid(), lane = tid & 63, wv = tid >> 6, l16 = lane & 15, lq = lane >> 4;
    float* SCR = (float*)lds;
    unsigned* hist = (unsigned*)(lds + 136192) + wv * 320;
    unsigned* hdum = hist + 256;
    f16x8 qa[8][2]; f16x8 w8r[4]; f16x8 ka[4][2];
#define IDX_LOAD_UNIT(U) do { const int _b = 2 * ((U) & 7) + (((U) >> 3) & 1), _q0 = idx_unit_qg((U), G) * 16; const size_t _rb = (size_t)_b * SEQ; \
        const f16* _qp = PROJ + (_rb + _q0 + l16) * NPJ + C_IQ + lq * 8; \
        _Pragma("unroll") for (int hd = 0; hd < 8; ++hd) _Pragma("unroll") for (int s_ = 0; s_ < 2; ++s_) qa[hd][s_] = *(const f16x8*)(_qp + hd * 64 + 32 * s_); \
        _Pragma("unroll") for (int r = 0; r < 4; ++r) w8r[r] = *(const f16x8*)(PROJ + (_rb + _q0 + 4 * lq + r) * NPJ + C_IW); \
        const int _c0 = (((64 * ((_q0 >> 6) + 1)) >> 4) + 7) >> 3; const f16* _kb = PROJ + (_rb + wv * 16 + l16) * NPJ + C_IK + lq * 8; \
        _Pragma("unroll") for (int j = 0; j < 4; ++j) { const int _it = (j < _c0 - 1) ? j : _c0 - 1; const f16* _kp = _kb + (size_t)_it * (128 * NPJ); ka[j][0] = *(const f16x8*)_kp; ka[j][1] = *(const f16x8*)(_kp + 32); } } while (0)
    if (wg < MT / 16) IDX_LOAD_UNIT(wg);
    for (int u = wg; u < MT / 16; u += G) {
        const int b = 2 * (u & 7) + ((u >> 3) & 1), qg = idx_unit_qg(u, G);
        const int q0 = qg * 16; const size_t rowbase = (size_t)b * SEQ;
        const int nadm = 64 * ((q0 >> 6) + 1);
        float wq[4][8];
#pragma unroll
        for (int r = 0; r < 4; ++r)
#pragma unroll
            for (int hd = 0; hd < 8; ++hd) wq[r][hd] = (float)w8r[r][hd] * (0.35355339059327373f * 0.125f);
        const int ntile = nadm >> 4;
        const int c0 = (ntile + 7) >> 3, cnt = (c0 + 3) & ~3;
        const f16* kbase = PROJ + (rowbase + wv * 16 + l16) * NPJ + C_IK + lq * 8;
        IDX_AMPB(1)
        for (int i = 0; i < cnt; i += 4) {
#pragma unroll
            for (int j = 0; j < 4; ++j) {
                const int it = (i + j < c0 - 1) ? i + j : c0 - 1;
                f32x4 sc = {0.f, 0.f, 0.f, 0.f};
                f32x4 a[8];
                __builtin_amdgcn_s_setprio(1);
#pragma unroll
                for (int hd = 0; hd < 8; ++hd) { a[hd] = (f32x4){0.f, 0.f, 0.f, 0.f}; a[hd] = __builtin_amdgcn_mfma_f32_16x16x32_f16(qa[hd][0], ka[j][0], a[hd], 0, 0, 0); }
#pragma unroll
                for (int hd = 0; hd < 8; ++hd) a[hd] = __builtin_amdgcn_mfma_f32_16x16x32_f16(qa[hd][1], ka[j][1], a[hd], 0, 0, 0);
                __builtin_amdgcn_s_setprio(0);
                __builtin_amdgcn_sched_barrier(0);
#pragma unroll
                for (int hd = 0; hd < 8; ++hd)
#pragma unroll
                    for (int r = 0; r < 4; ++r) { const int bi = __float_as_int(a[hd][r]); sc[r] += wq[r][hd] * __int_as_float(bi > 0 ? bi : 0); }
                { const int itn = (i + j + 4 < c0 - 1) ? i + j + 4 : c0 - 1; const f16* kp = kbase + (size_t)itn * (128 * NPJ); ka[j][0] = *(const f16x8*)kp; ka[j][1] = *(const f16x8*)(kp + 32); }
#pragma unroll
                for (int r = 0; r < 4; ++r) SCR[(4 * lq + r) * IDX_PITCH + (wv + 8 * it) * 16 + l16] = sc[r] + 0.0f;
            }
        }
        IDX_AMPE(1)
        IDX_AMPB(3)
        __syncthreads();
        IDX_AMPE(3)
        if (u + G < MT / 16) IDX_LOAD_UNIT(u + G);
        IDX_AMPB(2)
#ifndef TOPK_REP
#define TOPK_REP 1
#endif
        if (do_topk) for (int qs = 0; qs < 2 * TOPK_REP; ++qs) {
            const int qq = 2 * wv + (qs & 1);
            unsigned* mrow = MASK + (rowbase + q0 + qq) * 64;
            unsigned word = 0u;
            if (nadm <= 256) {
                word = (lane * 32 < nadm) ? 0xFFFFFFFFu : 0u;
            } else {
                int lk = lane; asm volatile("" : "+v"(lk));
                unsigned* hk = hist + (lk - lane);
                const float* row = SCR + qq * IDX_PITCH;
                bool ok; float m_sc, m_cc; unsigned m_T, m_want;
                if (nadm <= 512) word = topk_words<8>(row, nadm, lk, hk, ok, m_sc, m_cc, m_T, m_want);
                else if (nadm <= 1024) word = topk_words<16>(row, nadm, lk, hk, ok, m_sc, m_cc, m_T, m_want);
                else if (nadm <= 1536) word = topk_words<24>(row, nadm, lk, hk, ok, m_sc, m_cc, m_T, m_want);
                else word = topk_words<32>(row, nadm, lk, hk, ok, m_sc, m_cc, m_T, m_want);
                if (!ok) { IDX_AMPB(10) int l2 = lane; asm volatile("" : "+v"(l2)); word = topk_ties(row + (l2 - lane), nadm, l2, hk + (l2 - lane), hk + 256 + (l2 - lane), m_sc, m_cc, m_T, m_want); IDX_AMPE(10) }
            }
            mrow[lane] = word;
        }
        IDX_AMPE(2)
        IDX_AMPB(4)
        __syncthreads();
        IDX_AMPE(4)
    }
}
#ifndef DSA_AMP
#define DSA_AMP 0
#endif
#define DSA_AMPB(k) long long _da##k = 0; if (DSA_AMP == (k)) _da##k = (long long)__builtin_amdgcn_s_memtime();
#define DSA_AMPE(k) if (DSA_AMP == (k)) { const long long _tb = (long long)__builtin_amdgcn_s_memtime(); while ((long long)__builtin_amdgcn_s_memtime() - _tb < (_tb - _da##k)) __builtin_amdgcn_s_sleep(8); }
typedef __fp16 dsa_h4 __attribute__((__vector_size__(4 * sizeof(__fp16))));
__device__ __forceinline__ void dsa_attn_phase(unsigned char* lds, const f16* PROJ, const f16* KV, const f16* KVT, const unsigned* MASK, const float* BIAS2, const f16* WUVT, f16* OBUF, int G, int wg) {
    const int tid = ltid(), lane = tid & 63, wv = tid >> 6, l32 = lane & 31, hh = lane >> 5;
    unsigned char* KVB = lds;
    const int hd = wv;
    const float c1 = 0.08838834764831845f * LOG2E;
    const int skey = tid >> 3, skc = (tid & 7) * 8;
    f16x8 qraw[8], k0, k1;
    u32x4 mk;
#define DSA_UNIT_BQ(U, B_, QI_) do { if (G == 256) { const int _j = wg >> 4, _i = (U) >> 8; B_ = 2 * (wg & 7) + ((wg >> 3) & 1);     QI_ = (_i == 0) ? 63 - _j : (_i == 1) ? 32 + _j : (_i == 2) ? 31 - _j : _j; } \
        else { B_ = (U) & 15; QI_ = 63 - ((U) >> 4); } } while (0)
#define DSA_LOAD_Q(B_, QI_) do { const f16* _qp = PROJ + ((size_t)(B_) * SEQ + (QI_) * 32 + l32) * NPJ + C_DQ + hd * 128 + hh * 8; \
        _Pragma("unroll") for (int s_ = 0; s_ < 8; ++s_) qraw[s_] = *(const f16x8*)(_qp + 16 * s_); } while (0)
#define DSA_LOAD_TILE0(U) do { int _b, _qi; DSA_UNIT_BQ(U, _b, _qi); const f16* _kv = KV + ((size_t)_b * SEQ + skey) * 128 + skc; \
        k0 = *(const f16x8*)_kv; k1 = *(const f16x8*)(_kv + 64); \
        mk = *(const u32x4*)(MASK + ((size_t)_b * SEQ + _qi * 32 + (tid >> 4)) * 64 + 4 * (tid & 15)); } while (0)
    float* BL = (float*)(lds + 49152) + wv * 256;
    { const float* bsrc = BIAS2 + hd * 2112 + 2047 - 192;
#pragma unroll
      for (int i = 0; i < 4; ++i) BL[lane + 64 * i] = bsrc[lane + 64 * i]; }
    float* RED = (float*)(lds + 57344);
    int par = 0;
    if (wg < 1024) DSA_LOAD_TILE0(wg);
    for (int u = wg; u < 1024; u += G, par ^= 1) {
        DSA_AMPB(13)
        int tl = tid; asm volatile("" : "+v"(tl));
        const int skey = tl >> 3, skc = (tl & 7) * 8;
        const int ln = tl & 63, l32u = ln & 31, hhu = ln >> 5;
        const int sw_off = 2048 * (skey >> 3) + 512 * ((tl & 7) >> 2) + 64 * (skey & 7) + 16 * (((tl & 7) & 3) ^ ((skey >> 2) & 3));
        const int kb0 = 2048 * (l32u >> 3) + 64 * (l32u & 7) + 16 * ((0 + hhu) ^ ((l32u >> 2) & 3)), kb1 = 2048 * (l32u >> 3) + 64 * (l32u & 7) + 16 * ((2 + hhu) ^ ((l32u >> 2) & 3));
        const int tq = (ln & 15) >> 2, tp = ln & 3, tblk = (ln >> 4) & 1;
        const int vb0 = 64 * (4 * hhu + tq) + 16 * ((2 * tblk + (tp >> 1)) ^ (0 + hhu)) + 8 * (tp & 1), vb1 = 2048 + 64 * (4 * hhu + tq) + 16 * ((2 * tblk + (tp >> 1)) ^ (2 + hhu)) + 8 * (tp & 1);
        int b, qi; DSA_UNIT_BQ(u, b, qi);
        DSA_LOAD_Q(b, qi);
        const int q0 = qi * 32; const size_t rowbase = (size_t)b * SEQ;
        const int ntile = (q0 >> 6) + 1;
        f16x8 qf[8];
#pragma unroll
        for (int s = 0; s < 8; ++s)
#pragma unroll
            for (int e = 0; e < 8; ++e) qf[s][e] = (f16)((float)qraw[s][e] * c1);
        const unsigned char* mrowl = lds + 92160 + l32 * 272;
        const int q = q0 + l32;
        f32x16 accO[4];
#pragma unroll
        for (int d = 0; d < 4; ++d)
#pragma unroll
            for (int r = 0; r < 16; ++r) accO[d][r] = 0.f;
        float mrun = 0.f, lsum = 0.f;
        const f16* kvp = KV + (rowbase + skey) * 128 + skc;
        DSA_AMPE(13)
        DSA_AMPB(11)
        __syncthreads();
        { unsigned char* Kw = KVB + sw_off; *(f16x8*)Kw = k0; *(f16x8*)(Kw + 1024) = k1;
          *(u32x4*)(lds + 92160 + (tl >> 4) * 272 + 16 * (tl & 15)) = mk; }
        __syncthreads();
#define DSA_TR(P_) __builtin_bit_cast(f16x4, __builtin_amdgcn_ds_read_tr16_b64_v4f16((LAS dsa_h4*)(P_)))
#define DSA_QK(SX, T_, KL) do { _Pragma("unroll") for (int s4 = 0; s4 < 8; s4 += 4) { f16x8 kf[4]; \
                _Pragma("unroll") for (int s = 0; s < 4; ++s) kf[s] = *(const f16x8*)((KL) + (((s4 + s) & 1) ? kb1 : kb0) + 8192 * (T_) + 512 * ((s4 + s) >> 1)); \
                __builtin_amdgcn_sched_barrier(0); __builtin_amdgcn_s_setprio(1); \
                _Pragma("unroll") for (int s = 0; s < 4; ++s) SX = __builtin_amdgcn_mfma_f32_32x32x16_f16(kf[s], qf[s4 + s], SX, 0, 0, 0); __builtin_amdgcn_s_setprio(0); } } while (0)
#define DSA_SOFTMAX(SX, SOTHER, ADJ, T_, PF, NEAR, BP, FIRST) do { \
                if (NEAR) { _Pragma("unroll") for (int g = 0; g < 4; ++g) _Pragma("unroll") for (int e = 0; e < 4; ++e) SX[4 * g + e] += (BP)[32 * (T_) + 8 * g + e]; } \
                float tmax = -100.f; _Pragma("unroll") for (int r = 0; r < 16; ++r) tmax = fmaxf(tmax, SX[r]);        \
                const bool first = (FIRST); \
                if (first || __ballot(tmax > 8.0f) != 0ull) { \
                    const float tm2 = fmaxf(tmax, __shfl_xor(tmax, 32)); \
                    const float delta = (first || tm2 > 8.0f) ? tm2 : 0.f; \
                    const float alpha = __builtin_amdgcn_exp2f(-delta); \
                    mrun += delta; lsum *= alpha; \
                    _Pragma("unroll") for (int r = 0; r < 16; ++r) { SX[r] -= delta; if (ADJ) SOTHER[r] -= delta; }     \
                    _Pragma("unroll") for (int d = 0; d < 4; ++d) _Pragma("unroll") for (int r = 0; r < 16; ++r) accO[d][r] *= alpha; } \
                float ps = 0.f; \
                _Pragma("unroll") for (int r = 0; r < 16; ++r) { const float p = __builtin_amdgcn_exp2f(SX[r]); SX[r] = p; ps += p; }     \
                lsum += ps; \
                _Pragma("unroll") for (int s = 0; s < 2; ++s) _Pragma("unroll") for (int e = 0; e < 8; ++e) PF[s][e] = (f16)SX[8 * s + e]; } while (0)
#define DSA_PV(PF, T_, VL) do { _Pragma("unroll") for (int d2 = 0; d2 < 4; d2 += 2) { f16x8 vf[2][2]; \
                _Pragma("unroll") for (int d = 0; d < 2; ++d) _Pragma("unroll") for (int s = 0; s < 2; ++s) { const int _o = 2048 * (4 * (T_) + 2 * s) + 512 * (d2 + d); \
                    const f16x4 _lo = DSA_TR((VL) + vb0 + _o), _hi = DSA_TR((VL) + vb1 + _o); \
                    vf[d][s] = (f16x8){_lo[0], _lo[1], _lo[2], _lo[3], _hi[0], _hi[1], _hi[2], _hi[3]}; } \
                __builtin_amdgcn_sched_barrier(0); __builtin_amdgcn_s_setprio(1); \
                _Pragma("unroll") for (int d = 0; d < 2; ++d) _Pragma("unroll") for (int s = 0; s < 2; ++s) accO[d2 + d] = __builtin_amdgcn_mfma_f32_32x32x16_f16(vf[d][s], PF[s], accO[d2 + d], 0, 0, 0); __builtin_amdgcn_s_setprio(0); } } while (0)
#define DSA_SINIT(SX, MWORD) do { const unsigned _w = (MWORD) >> (4 * hh); const float _ni = -mrun, _ng = -1e30f; \
                _Pragma("unroll") for (int r = 0; r < 16; ++r) { float _o; \
                    asm("v_bfe_i32 %0, %1, %2, 1\n\tv_bfi_b32 %0, %0, %3, %4" : "=&v"(_o) : "v"(_w), "n"(8 * (r >> 2) + (r & 3)), "v"(_ni), "v"(_ng)); SX[r] = _o; } } while (0)
#define DSA_NEXT_LOADS(KT) do { if ((KT) + 1 < ntile) { const f16* a = kvp + (size_t)((KT) + 1) * 64 * 128; k0 = *(const f16x8*)a; k1 = *(const f16x8*)(a + 64); } } while (0)
#define DSA_STAGE_NEXT(KT, VR) do { if ((KT) + 1 < ntile) { unsigned char* Kw = KVB + (VR) * 16384 + sw_off; *(f16x8*)Kw = k0; *(f16x8*)(Kw + 1024) = k1; } } while (0)
        if (wv < 4) {
            int vr = 0;
            for (int kt = 0; kt < ntile; ++kt) {
                const unsigned char* Kl = KVB + vr * 16384; const unsigned char* Vl = Kl;
                const int vrn = (vr == 2) ? 0 : vr + 1;
                DSA_NEXT_LOADS(kt);
                const u32x2 mw = *(const u32x2*)(mrowl + 8 * kt);
                const bool near = (kt * 64 + 63 + 96 > q0);
                const float* bp = BL + 192 - q + kt * 64 + 4 * hh;
                f32x16 S0, S1;
                DSA_SINIT(S0, mw[0]); DSA_SINIT(S1, mw[1]);
                DSA_QK(S0, 0, Kl); DSA_QK(S1, 1, Kl);
                { f16x8 pf0[2]; DSA_SOFTMAX(S0, S1, true, 0, pf0, near, bp, kt == 0); DSA_PV(pf0, 0, Vl); }
                { f16x8 pf1[2]; DSA_SOFTMAX(S1, S0, false, 1, pf1, near, bp, false); DSA_PV(pf1, 1, Vl); }
                DSA_AMPB(27) DSA_STAGE_NEXT(kt, vrn); DSA_AMPE(27)
                DSA_AMPB(28) __syncthreads(); DSA_AMPE(28)
                vr = vrn;
            }
        } else {
            f32x16 S1;
            { DSA_NEXT_LOADS(0);
              const u32x2 mw = *(const u32x2*)mrowl;
              const bool near = (63 + 96 > q0); const float* bp = BL + 192 - q + 4 * hh;
              { f32x16 S0;
                DSA_SINIT(S0, mw[0]);
                DSA_QK(S0, 0, KVB);
                f16x8 pf0[2]; DSA_SOFTMAX(S0, S1, false, 0, pf0, near, bp, true); DSA_PV(pf0, 0, KVB); }
              DSA_SINIT(S1, mw[1]);
              DSA_QK(S1, 1, KVB);
              DSA_STAGE_NEXT(0, 1);
              __syncthreads(); }
            int vr = 1;
            for (int kt = 1; kt < ntile; ++kt) {
                const unsigned char* Kl = KVB + vr * 16384; const unsigned char* Vl = Kl; const unsigned char* Vp = KVB + ((vr == 0) ? 2 : vr - 1) * 16384;
                const int vrn = (vr == 2) ? 0 : vr + 1;
                DSA_NEXT_LOADS(kt);
                { const bool nearp = ((kt - 1) * 64 + 63 + 96 > q0); const float* bpp = BL + 192 - q + (kt - 1) * 64 + 4 * hh;
                  f16x8 pf1[2]; DSA_SOFTMAX(S1, S1, false, 1, pf1, nearp, bpp, false); DSA_PV(pf1, 1, Vp); }
                const u32x2 mw = *(const u32x2*)(mrowl + 8 * kt);
                const bool near = (kt * 64 + 63 + 96 > q0);
                const float* bp = BL + 192 - q + kt * 64 + 4 * hh;
                { f32x16 S0;
                  DSA_SINIT(S0, mw[0]);
                  DSA_QK(S0, 0, Kl);
                  f16x8 pf0[2]; DSA_SOFTMAX(S0, S1, false, 0, pf0, near, bp, false); DSA_PV(pf0, 0, Vl); }
                DSA_SINIT(S1, mw[1]);
                DSA_QK(S1, 1, Kl);
                DSA_AMPB(27) DSA_STAGE_NEXT(kt, vrn); DSA_AMPE(27)
                DSA_AMPB(28) __syncthreads(); DSA_AMPE(28)
                vr = vrn;
            }
            { const int kl = ntile - 1; const unsigned char* Vp = KVB + ((vr == 0) ? 2 : vr - 1) * 16384;
              const bool nearp = (kl * 64 + 63 + 96 > q0); const float* bpp = BL + 192 - q + kl * 64 + 4 * hh;
              f16x8 pf1[2]; DSA_SOFTMAX(S1, S1, false, 1, pf1, nearp, bpp, false); DSA_PV(pf1, 1, Vp); }
        }
#undef DSA_QK
#undef DSA_TR
#undef DSA_SOFTMAX
#undef DSA_PV
#undef DSA_NEXT_LOADS
#undef DSA_SINIT
#undef DSA_STAGE_NEXT
        DSA_AMPE(11)
        DSA_AMPB(12)
        if (u + G < 1024) DSA_LOAD_TILE0(u + G);
        int l32e = l32, hhe = hh; asm volatile("" : "+v"(l32e), "+v"(hhe));
        const float ltot = lsum + __shfl_xor(lsum, 32);
        const float inv = 1.0f / ltot;
        f32x16 Z[2];
#pragma unroll
        for (int n = 0; n < 2; ++n)
#pragma unroll
            for (int r = 0; r < 16; ++r) Z[n][r] = 0.f;
        f16x8 wf[16];
        { const f16* wp = WUVT + (size_t)hd * (16 * 512) + (hhe * 32 + l32e) * 8;
#pragma unroll
          for (int i = 0; i < 16; ++i) wf[i] = *(const f16x8*)(wp + i * 512); }
#pragma unroll
        for (int dq = 0; dq < 4; ++dq)
#pragma unroll
            for (int s = 0; s < 2; ++s) {
                f16x8 ob;
#pragma unroll
                for (int e = 0; e < 8; ++e) ob[e] = (f16)(accO[dq][8 * s + e] * inv);
#pragma unroll
                for (int n = 0; n < 2; ++n) Z[n] = __builtin_amdgcn_mfma_f32_32x32x16_f16(wf[(dq * 2 + s) * 2 + n], ob, Z[n], 0, 0, 0);
            }
        float ssq = 0.f;
#pragma unroll
        for (int n = 0; n < 2; ++n)
#pragma unroll
            for (int r = 0; r < 16; ++r) ssq += Z[n][r] * Z[n][r];
        ssq += __shfl_xor(ssq, 32);
        if (hh == 0) RED[(par * 8 + wv) * 32 + l32] = ssq;
        __syncthreads();
        float tot = 0.f;
#pragma unroll
        for (int w8 = 0; w8 < 8; ++w8) tot += RED[(par * 8 + w8) * 32 + l32];
        const float rstd = rsqrtf(tot * (1.0f / 512.f) + EPS);
        { f16* OT = (f16*)(lds + 59392) + wv * (32 * 64);
#pragma unroll
          for (int n = 0; n < 2; ++n)
#pragma unroll
            for (int g = 0; g < 4; ++g) { f16x4 o; o[0] = cvt16<ALL_BF16 != 0>(Z[n][4 * g] * rstd); o[1] = cvt16<ALL_BF16 != 0>(Z[n][4 * g + 1] * rstd); o[2] = cvt16<ALL_BF16 != 0>(Z[n][4 * g + 2] * rstd); o[3] = cvt16<ALL_BF16 != 0>(Z[n][4 * g + 3] * rstd);
                *(f16x4*)(OT + l32e * 64 + (((4 * n + g) ^ (l32e & 7)) << 3) + 4 * hhe) = o; }
          asm volatile("s_waitcnt lgkmcnt(0)" ::: "memory");
          const int lt = hhe * 32 + l32e, orow = lt >> 3, opc = lt & 7;
          f16* op = OBUF + (rowbase + q0 + orow) * DM + 512 + hd * 64 + 8 * opc;
#pragma unroll
          for (int i = 0; i < 4; ++i) *(f16x8*)(op + (size_t)(8 * i) * DM) = *(const f16x8*)(OT + (orow + 8 * i) * 64 + ((opc ^ (orow & 7)) << 3));
          asm volatile("s_waitcnt lgkmcnt(0)" ::: "memory"); }
        DSA_AMPE(12)
    }
}
constexpr int N_PHASES = 14;
struct Args { Ptrs p; int ph_lo, ph_hi; };

__global__ void __launch_bounds__(NTHR, 2) trunk_fwd(Args args) {
    extern __shared__ __attribute__((aligned(16))) unsigned char lds[];
    const Ptrs& P = args.p;
    unsigned char* ws = P.ws;
    const int G = gridDim.x, wg = blockIdx.x, tid = threadIdx.x;
    const int lo = args.ph_lo, hi = args.ph_hi;
    const bool multi = (hi - lo) > 1;
    XcdBarrier bar; bar.bar = (unsigned*)(ws + WS_CTL); bar.x = 0; bar.st = nullptr;
    if (multi) {
        if (tid < 4) ((LAS unsigned*)(lds + LDS_MISC))[tid] = 0u;
        __syncthreads();
        bar = xcd_barrier_post((unsigned*)(ws + WS_CTL), (volatile LAS unsigned*)(lds + LDS_MISC));
    }
#ifndef REP_IDX
#define REP_IDX 1
#endif
#ifndef REP_IDX_SCORE_ONLY
#define REP_IDX_SCORE_ONLY 0
#endif
#ifndef REP_SB
#define REP_SB 1
#endif
#ifndef REP_DSA
#define REP_DSA 1
#endif
#ifndef REP_GIN
#define REP_GIN 1
#endif
#ifndef REP_GUP
#define REP_GUP 1
#endif
#ifndef PHMASK
#define PHMASK 0xFFFFF
#endif
#ifndef PHASE_AMP
#define PHASE_AMP (-1)
#endif
#define IN(k) (lo <= (k) && (k) < hi)
#define AMPB(k) long long _ta = 0; if (PHASE_AMP == (k)) _ta = (long long)__builtin_amdgcn_s_memtime();
#define AMPE(k) if (PHASE_AMP == (k)) { const long long _tb = (long long)__builtin_amdgcn_s_memtime(); while ((long long)__builtin_amdgcn_s_memtime() - _tb < (_tb - _ta)) __builtin_amdgcn_s_sleep(8); }
#define PM(j) ((PHMASK >> (j)) & 1)
#define SEAM(k) do { if (IN(k) && IN((k) + 1)) xcd_barrier(bar); } while (0)
    float* MOD = (float*)(ws + WS_MOD);
    f16* H = (f16*)(ws + WS_H); f16* PROJ = (f16*)(ws + WS_PROJ); f16* OBUF = (f16*)(ws + WS_OBUF); f16* HID = (f16*)(ws + WS_HID);
    f16* KV = (f16*)(ws + WS_KV); f16* KVT = (f16*)(ws + WS_KVT); f16* VTA = (f16*)(ws + WS_VTA); unsigned* MASK = (unsigned*)(ws + WS_MASK);
    f16* X = (f16*)(ws + WS_X16);

    float* SSQ = (float*)(ws + WS_SSQ); float* BW = (float*)(ws + WS_BW);
    if (PM(0) && IN(0)) { AMPB(0) prologue_phase(lds, P, G, wg); AMPE(0) SEAM(0); }
    if (PM(1) && IN(1)) { AMPB(1)
        bw_phase(lds, P, MOD, BW, G, wg);
        prenorm0_phase(P.x, P.g_attn, MOD + 1 * DM, H, SSQ, G, wg);
        AMPE(1) SEAM(1);
    }

    for (int l = 0; l < NLAYER; ++l) {
        const int pb = 2 + 6 * l;
        const float* modl = MOD + (size_t)l * 16 * 6144;
        const float* ssq1 = SSQ + (size_t)(l == 0 ? 0 : 2) * MT;
        float* ssq2 = SSQ + (size_t)(l == 0 ? 1 : 3) * MT;
        if (PM(2) && IN(pb + 0)) { AMPB(pb + 0)
            pg8::Gemm g{H, (const f16*)(ws + WS_WIN) + (size_t)l * NPJ * DM, MT, NPJ, DM}; pg8::StaticOrder S; S.init(MT, NPJ, G, wg);
            pg8::EpiF16N<0> E{PROJ, NPJ, ssq1, BW + (size_t)(l * 2 + 0) * 16 * 4096};
            for (int rep = 0; rep < REP_GIN; ++rep) pg8::gemm_phase<pg8::EpiF16N<0>, pg8::StaticOrder, ALL_BF16 != 0>((LAS unsigned char*)lds, g, S, E);
            AMPE(pb + 0) SEAM(pb + 0);
        }
        if (PM(3) && IN(pb + 1)) { AMPB(pb + 1)
#if ENABLE_DSA
            kvnorm_phase(lds, PROJ, P.kv_norm_g + l * 128, KV, KVT, G, wg);
            __syncthreads();
#endif
#if ENABLE_DSA
            for (int rep = 0; rep < REP_IDX; ++rep) { indexer_phase(lds, PROJ, MASK, G, wg, rep == 0 || !REP_IDX_SCORE_ONLY); __syncthreads(); }
#endif
            AMPE(pb + 1) SEAM(pb + 1);
        }
        if (PM(4) && IN(pb + 2)) { AMPB(pb + 2)
            for (int rep = 0; rep < REP_SB; ++rep) { sb_attn_phase(lds, PROJ, VTA, OBUF, G, wg); }
            for (int rep = 0; rep < REP_DSA; ++rep) { __syncthreads(); dsa_attn_phase(lds, PROJ, KV, KVT, MASK, (const float*)(ws + WS_BIAS), (const f16*)(ws + WS_WUV) + (size_t)l * 8 * 64 * 128, OBUF, G, wg); }
            AMPE(pb + 2) SEAM(pb + 2);
        }
        if (PM(6) && IN(pb + 3)) { AMPB(pb + 3)
            pg8::Gemm g{OBUF, (const f16*)(ws + WS_WOUT) + (size_t)l * DM * DM, MT, DM, DM}; pg8::StaticOrder S; S.init(MT, DM, G, wg);
            if (l == 0) {
                pg8::EpiResidN<MLP_BF16 != 0, false> E{P.x, X, modl + 2 * DM, P.g_mlp + l * DM, modl + 4 * DM, H, ssq2};
                pg8::gemm_phase<pg8::EpiResidN<MLP_BF16 != 0, false>, pg8::StaticOrder, ALL_BF16 != 0>((LAS unsigned char*)lds, g, S, E);
            } else {
                pg8::EpiResidN<MLP_BF16 != 0, true> E{X, X, modl + 2 * DM, P.g_mlp + l * DM, modl + 4 * DM, H, ssq2};
                pg8::gemm_phase<pg8::EpiResidN<MLP_BF16 != 0, true>, pg8::StaticOrder, ALL_BF16 != 0>((LAS unsigned char*)lds, g, S, E);
            }
            AMPE(pb + 3) SEAM(pb + 3);
        }
        if (PM(8) && IN(pb + 4)) { AMPB(pb + 4)
            pg8::Gemm g{H, (const f16*)(ws + WS_WUP) + (size_t)l * FF * DM, MT, FF, DM}; pg8::StaticOrder S; S.init(MT, FF, G, wg);
            pg8::EpiF16N<1, MLP_BF16 != 0> E{HID, FF, ssq2, BW + (size_t)(l * 2 + 1) * 16 * 4096};
            for (int rep = 0; rep < REP_GUP; ++rep) pg8::gemm_phase<pg8::EpiF16N<1, MLP_BF16 != 0>, pg8::StaticOrder, MLP_BF16 != 0>((LAS unsigned char*)lds, g, S, E);
            AMPE(pb + 4) SEAM(pb + 4);
        }
        if (PM(9) && IN(pb + 5)) { AMPB(pb + 5)
            pg8::Gemm g{HID, (const f16*)(ws + WS_WDN) + (size_t)l * DM * FF, MT, DM, FF}; pg8::StaticOrder S; S.init(MT, DM, G, wg);
            if (l == 0) {
                pg8::EpiResidN<ALL_BF16 != 0, true> E{X, X, modl + 5 * DM, P.g_attn + DM, MOD + (size_t)16 * 6144 + 1 * DM, H, SSQ + (size_t)2 * MT};
                pg8::gemm_phase<pg8::EpiResidN<ALL_BF16 != 0, true>, pg8::StaticOrder, MLP_BF16 != 0>((LAS unsigned char*)lds, g, S, E);
            } else {
                pg8::EpiFinal E{X, P.out, modl + 5 * DM, P.g_final, SSQ + (size_t)4 * MT, (unsigned*)(ws + WS_CTL) + 4096, (unsigned*)(ws + WS_CTL) + 4096 + 256};
                pg8::gemm_phase<pg8::EpiFinal, pg8::StaticOrder, MLP_BF16 != 0>((LAS unsigned char*)lds, g, S, E);
            }
            AMPE(pb + 5) SEAM(pb + 5);
        }
    }
#undef IN
#undef SEAM
}

extern "C" void kernel_launch(void* const* d_in, const int* in_sizes, int n_in, void* d_out, int out_size, void* d_ws, size_t ws_size, hipStream_t stream) {
    static int grid = 0;
    if (grid == 0) {
        if (n_in != 16 || in_sizes[0] != MT * DM || out_size != MT * DM || ws_size < WS_END) {
            fprintf(stderr, "kernel_launch: unexpected shapes: n_in %d in0 %d out %d ws %zu (need %zu)\n", n_in, n_in > 0 ? in_sizes[0] : -1, out_size, ws_size, (size_t)WS_END); grid = -1; return; }
        int dev = 0, cus = 0, per_cu = 0;
        if (hipGetDevice(&dev) != hipSuccess || hipDeviceGetAttribute(&cus, hipDeviceAttributeMultiprocessorCount, dev) != hipSuccess) { grid = -1; return; }
        if (hipFuncSetAttribute((const void*)trunk_fwd, hipFuncAttributeMaxDynamicSharedMemorySize, LDS_BYTES) != hipSuccess) { fprintf(stderr, "kernel_launch: hipFuncSetAttribute failed\n"); grid = -1; return; }
        if (hipOccupancyMaxActiveBlocksPerMultiprocessor(&per_cu, (const void*)trunk_fwd, NTHR, LDS_BYTES) != hipSuccess || per_cu < 1) fprintf(stderr, "kernel_launch: occupancy query says %d\n", per_cu);
        (void)hipGetLastError();
        grid = cus;
    }
    if (grid < 0) return;
    (void)hipMemsetAsync((char*)d_ws + WS_CTL, 0, CTL_BYTES, stream);
    Args a{};
    a.p.x = (const float*)d_in[0]; a.p.c = (const float*)d_in[1]; a.p.w_mod = (const float*)d_in[2]; a.p.b_mod = (const float*)d_in[3]; a.p.g_attn = (const float*)d_in[4];
    a.p.w_in = (const float*)d_in[5]; a.p.kv_norm_g = (const float*)d_in[6]; a.p.w_uv = (const float*)d_in[7]; a.p.g_out_a = (const float*)d_in[8]; a.p.g_out_b = (const float*)d_in[9];
    a.p.w_out = (const float*)d_in[10]; a.p.g_mlp = (const float*)d_in[11]; a.p.w_up = (const float*)d_in[12]; a.p.w_down = (const float*)d_in[13]; a.p.rel_bias = (const float*)d_in[14];
    a.p.g_final = (const float*)d_in[15]; a.p.out = (float*)d_out; a.p.ws = (unsigned char*)d_ws;
#if N_LAUNCH_MODE == 1
    a.ph_lo = 0; a.ph_hi = N_PHASES;
    hipLaunchKernelGGL(trunk_fwd, dim3(grid), dim3(NTHR), LDS_BYTES, stream, a);
#else
    for (int ph = 0; ph < N_PHASES; ++ph) { a.ph_lo = ph; a.ph_hi = ph + 1; hipLaunchKernelGGL(trunk_fwd, dim3(grid), dim3(NTHR), LDS_BYTES, stream, a); }
#endif
}
```
